# Optimizing an MI355X kernel written in HIP

```python
import jax, jax.numpy as jnp
from jax import lax
import numpy as np

D_MODEL = 2048
BATCH = 4
SEQ = 4096
DEPTH = 4
DEC_BATCH = 8
DEC_SEQ = 16
PAST_LEN = 4096

CHUNK = 64
MA_HEADS = 8
MA_HEAD_DIM = 256
MA_WIDTH = MA_HEADS * MA_HEAD_DIM
CONV_W = 4
HB_HEADS = 16
HB_KEY_DIM = 128
HB_VAL_DIM = 128
HB_WIDTH = HB_HEADS * HB_KEY_DIM
HB_VWIDTH = HB_HEADS * HB_VAL_DIM
D_FF = 4 * D_MODEL
N_IN = 4 * MA_WIDTH + 2 * HB_WIDTH + 2 * HB_VWIDTH + 2 * D_MODEL + 2 * MA_HEADS
EPS = 1e-6
NEG = -1e30

kernel_name = 'hybrid_mlstm_hgrn2_streaming_step'


def rmsnorm(x, g):
    xf = x.astype(jnp.float32)
    y = xf * lax.rsqrt(jnp.mean(xf * xf, axis=-1, keepdims=True) + EPS)
    return (y * g.astype(jnp.float32)).astype(x.dtype)


def head_rmsnorm(h, g):
    y = h * lax.rsqrt(jnp.mean(h * h, axis=-1, keepdims=True) + EPS)
    return y.reshape(h.shape[:2] + (-1,)) * g.astype(jnp.float32)


def to_chunks(a, L):
    B, T = a.shape[:2]
    return jnp.swapaxes(a.reshape((B, T // L, L) + a.shape[2:]), 0, 1)


def from_chunks(a):
    a = jnp.swapaxes(a, 0, 1)
    return a.reshape((a.shape[0], a.shape[1] * a.shape[2]) + a.shape[3:])


def causal_dwconv(buf, u, w, b):
    full = jnp.concatenate([buf.astype(jnp.float32), u], axis=1)
    T = u.shape[1]
    wf = w.astype(jnp.float32)
    y = b.astype(jnp.float32) + full[:, 0:T] * wf[0]
    for j in range(1, CONV_W):
        y = y + full[:, j:j + T] * wf[j]
    return y, full[:, -(CONV_W - 1):]


def mlstm_step(carry, inp):
    c_mat, n_vec, m_run = carry
    q, k, v, ig, lf = inp
    L = q.shape[1]
    mask = jnp.tril(jnp.ones((L, L), dtype=bool))
    b = jnp.swapaxes(jnp.cumsum(lf, axis=1), 1, 2)
    igt = jnp.swapaxes(ig, 1, 2)
    log_d = jnp.where(mask, b[..., :, None] - b[..., None, :] + igt[..., None, :], NEG)
    log_inter = b + m_run[..., None]
    m_t = jnp.maximum(log_inter, jnp.max(log_d, axis=-1))
    d = jnp.exp(log_d - m_t[..., None])
    w_inter = jnp.exp(log_inter - m_t)
    s = jnp.einsum('blhd,bshd->bhls', q, k) * d
    num = (jnp.einsum('bhls,bshv->blhv', s, v)
           + jnp.swapaxes(w_inter, 1, 2)[..., None] * jnp.einsum('blhd,bhdv->blhv', q, c_mat))
    qn = jnp.sum(s, axis=-1) + w_inter * jnp.einsum('blhd,bhd->bhl', q, n_vec)
    denom = jnp.maximum(jnp.abs(qn), jnp.exp(-m_t))
    h = num / jnp.swapaxes(denom, 1, 2)[..., None]
    w_last = jnp.swapaxes(d[..., -1, :], 1, 2)[..., None]
    decay = w_inter[..., -1]
    c_new = decay[..., None, None] * c_mat + jnp.einsum('bshd,bshv->bhdv', k * w_last, v)
    n_new = decay[..., None] * n_vec + jnp.sum(k * w_last, axis=1)
    return (c_new, n_new, m_t[..., -1]), h


def mlstm_scan(q, k, v, ig, lf, c0, n0, m0):
    L = min(CHUNK, q.shape[1])
    xs = (to_chunks(q, L), to_chunks(k, L), to_chunks(v, L), to_chunks(ig, L), to_chunks(lf, L))
    init = (c0.astype(jnp.float32), n0.astype(jnp.float32), m0.astype(jnp.float32))
    (c1, n1, m1), h = lax.scan(mlstm_step, init, xs)
    return from_chunks(h), c1, n1, m1


def hgrn_step(s_mat, inp):
    q, k, v, lf = inp
    L = q.shape[1]
    mask = jnp.tril(jnp.ones((L, L), dtype=bool))[:, :, None, None]
    b = jnp.cumsum(lf, axis=1)
    decay = jnp.exp(jnp.where(mask, b[:, :, None] - b[:, None, :], NEG))
    a = jnp.einsum('btshd,bshd->bhts', decay * q[:, :, None], k)
    o = jnp.einsum('bhts,bshv->bthv', a, v) + jnp.einsum('bthd,bhdv->bthv', q * jnp.exp(b), s_mat)
    b_last = b[:, -1]
    s_new = (jnp.exp(b_last)[..., None] * s_mat
             + jnp.einsum('bshd,bshv->bhdv', k * jnp.exp(b_last[:, None] - b), v))
    return s_new, o


def hgrn_scan(q, k, v, lf, s0):
    L = min(CHUNK, q.shape[1])
    xs = (to_chunks(q, L), to_chunks(k, L), to_chunks(v, L), to_chunks(lf, L))
    s1, o = lax.scan(hgrn_step, s0.astype(jnp.float32), xs)
    return from_chunks(o), s1


def mixer_block(h, conv_buf, c0, n0, m0, s0, lb, w_in, b_in, conv_w, conv_b,
                ma_norm, hb_norm, w_br_a, w_br_b, w_o):
    B, T, _ = h.shape
    dt = h.dtype
    z = (h @ w_in + b_in).astype(jnp.float32)
    cuts = [int(i) for i in np.cumsum([2 * MA_WIDTH, MA_WIDTH, MA_WIDTH, HB_WIDTH, HB_WIDTH,
                                      HB_VWIDTH, HB_VWIDTH, D_MODEL, D_MODEL, MA_HEADS])]
    qk_a, v_a, o_a, q_b, f_b, i_b, og_b, g_a, g_b, ig_a, fg_a = jnp.split(z, cuts, axis=-1)
    qk_a, new_buf = causal_dwconv(conv_buf, qk_a, conv_w, conv_b)
    q_a, k_a = jnp.split(jax.nn.silu(qk_a), 2, axis=-1)
    q_a = q_a.reshape(B, T, MA_HEADS, MA_HEAD_DIM)
    k_a = k_a.reshape(B, T, MA_HEADS, MA_HEAD_DIM) * (MA_HEAD_DIM ** -0.5)
    v_a = v_a.reshape(B, T, MA_HEADS, MA_HEAD_DIM)
    h_a, c1, n1, m1 = mlstm_scan(q_a, k_a, v_a, ig_a, jax.nn.log_sigmoid(fg_a), c0, n0, m0)
    y_a = head_rmsnorm(h_a, ma_norm) * jax.nn.sigmoid(o_a)
    lb = lb.astype(jnp.float32)
    f_gate = lb + (1.0 - lb) * jax.nn.sigmoid(f_b)
    log_f = jnp.log(f_gate)
    k_b = (1.0 - lb) * jax.nn.sigmoid(-f_b)
    q_b = jax.nn.silu(q_b)
    hshape = (B, T, HB_HEADS, HB_KEY_DIM)
    h_b, s1 = hgrn_scan(q_b.reshape(hshape), k_b.reshape(hshape),
                        i_b.reshape(B, T, HB_HEADS, HB_VAL_DIM), log_f.reshape(hshape), s0)
    y_b = head_rmsnorm(h_b, hb_norm) * jax.nn.sigmoid(og_b)
    merged = (jax.nn.sigmoid(g_a) * (y_a.astype(dt) @ w_br_a)
              + jax.nn.sigmoid(g_b) * (y_b.astype(dt) @ w_br_b))
    out = merged.astype(dt) @ w_o
    return out, new_buf, c1, n1, m1, s1


def trunk(x, c, conv_c, st_c, st_n, st_m, st_s, lb_all, ada_w, ada_b, norm1_g, norm2_g,
          w_in, b_in, conv_w, conv_b, ma_norm, hb_norm, w_br_a, w_br_b, w_o, w_up, w_down, final_g):
    cs = jax.nn.silu(c)
    bufs, cms, nvs, mrs, sms = [], [], [], [], []
    for l in range(DEPTH):
        mod = (cs @ ada_w[l] + ada_b[l])[:, None, :]
        sh1, sc1, g1, sh2, sc2, g2 = jnp.split(mod, 6, axis=-1)
        h = rmsnorm(x, norm1_g[l]) * (1 + sc1) + sh1
        out, buf, c1, n1, m1, s1 = mixer_block(h, conv_c[l], st_c[l], st_n[l], st_m[l], st_s[l], lb_all[l],
                                               w_in[l], b_in[l], conv_w[l], conv_b[l], ma_norm[l], hb_norm[l],
                                               w_br_a[l], w_br_b[l], w_o[l])
        x = x + (g1 * out).astype(x.dtype)
        h = rmsnorm(x, norm2_g[l]) * (1 + sc2) + sh2
        u = jnp.square(jax.nn.relu(h @ w_up[l]))
        x = x + (g2 * (u @ w_down[l])).astype(x.dtype)
        bufs.append(buf); cms.append(c1); nvs.append(n1); mrs.append(m1); sms.append(s1)
    y = rmsnorm(x, final_g)
    return y, jnp.stack(bufs), jnp.stack(cms), jnp.stack(nvs), jnp.stack(mrs), jnp.stack(sms)


def setup_inputs(seed: int = 0) -> dict:
    key = jax.random.key(seed)
    ks = jax.random.split(key, 32)
    f32 = jnp.float32

    def nrm(k, shape, s):
        return jax.random.normal(k, shape, f32) * s

    D = D_MODEL
    b_in = nrm(ks[13], (DEPTH, N_IN), 0.02)
    fg_off = jax.random.uniform(ks[14], (DEPTH, MA_HEADS), f32, minval=3.0, maxval=6.0)
    b_in = b_in.at[:, N_IN - MA_HEADS:].add(fg_off)
    return {
        'x_prompt': nrm(ks[0], (BATCH, SEQ, D), 1.0),
        'x_sample': nrm(ks[1], (DEC_BATCH, DEC_SEQ, D), 1.0),
        'cache_conv': nrm(ks[2], (DEPTH, DEC_BATCH, CONV_W - 1, 2 * MA_WIDTH), 1.0),
        'state_mlstm_C': nrm(ks[3], (DEPTH, DEC_BATCH, MA_HEADS, MA_HEAD_DIM, MA_HEAD_DIM), 0.1),
        'state_mlstm_n': nrm(ks[4], (DEPTH, DEC_BATCH, MA_HEADS, MA_HEAD_DIM), 0.1),
        'state_mlstm_m': nrm(ks[5], (DEPTH, DEC_BATCH, MA_HEADS), 1.0),
        'state_hgrn': nrm(ks[6], (DEPTH, DEC_BATCH, HB_HEADS, HB_KEY_DIM, HB_VAL_DIM), 0.3),
        'c_prompt': nrm(ks[7], (BATCH, D), 1.0),
        'c_sample': nrm(ks[8], (DEC_BATCH, D), 1.0),
        'ada_w': nrm(ks[9], (DEPTH, D, 6 * D), 0.5 * D ** -0.5),
        'ada_b': nrm(ks[10], (DEPTH, 6 * D), 0.02),
        'norm1_g': 1.0 + nrm(ks[11], (DEPTH, D), 0.02),
        'norm2_g': 1.0 + nrm(ks[12], (DEPTH, D), 0.02),
        'w_in': nrm(ks[15], (DEPTH, D, N_IN), D ** -0.5),
        'b_in': b_in,
        'conv_w': nrm(ks[16], (DEPTH, CONV_W, 2 * MA_WIDTH), 0.5),
        'conv_b': nrm(ks[17], (DEPTH, 2 * MA_WIDTH), 0.02),
        'ma_norm': 1.0 + nrm(ks[18], (DEPTH, MA_WIDTH), 0.02),
        'hgrn_lb_raw': nrm(ks[19], (DEPTH, HB_WIDTH), 1.0),
        'hb_norm': 1.0 + nrm(ks[20], (DEPTH, HB_VWIDTH), 0.02),
        'w_br_a': nrm(ks[21], (DEPTH, MA_WIDTH, D), MA_WIDTH ** -0.5),
        'w_br_b': nrm(ks[22], (DEPTH, HB_VWIDTH, D), HB_VWIDTH ** -0.5),
        'w_o': nrm(ks[23], (DEPTH, D, D), D ** -0.5),
        'w_up': nrm(ks[24], (DEPTH, D, D_FF), D ** -0.5),
        'w_down': nrm(ks[25], (DEPTH, D_FF, D), D_FF ** -0.5),
        'final_g': 1.0 + nrm(ks[26], (D,), 0.02),
    }


def reference(x_prompt, x_sample, cache_conv, state_mlstm_C, state_mlstm_n, state_mlstm_m, state_hgrn,
              c_prompt, c_sample, ada_w, ada_b, norm1_g, norm2_g, w_in, b_in, conv_w, conv_b, ma_norm,
              hgrn_lb_raw, hb_norm, w_br_a, w_br_b, w_o, w_up, w_down, final_g):
    lb_sm = jax.nn.softmax(hgrn_lb_raw.astype(jnp.float32), axis=0)
    lb_all = jnp.cumsum(lb_sm, axis=0) - lb_sm[0]
    weights = (ada_w, ada_b, norm1_g, norm2_g, w_in, b_in, conv_w, conv_b, ma_norm, hb_norm,
               w_br_a, w_br_b, w_o, w_up, w_down, final_g)
    bp = x_prompt.shape[0]
    f32 = jnp.float32
    z_conv = jnp.zeros((DEPTH, bp, CONV_W - 1, 2 * MA_WIDTH), f32)
    z_c = jnp.zeros((DEPTH, bp, MA_HEADS, MA_HEAD_DIM, MA_HEAD_DIM), f32)
    z_n = jnp.zeros((DEPTH, bp, MA_HEADS, MA_HEAD_DIM), f32)
    z_m = jnp.zeros((DEPTH, bp, MA_HEADS), f32)
    z_s = jnp.zeros((DEPTH, bp, HB_HEADS, HB_KEY_DIM, HB_VAL_DIM), f32)
    y_prompt, conv_p, c_p, n_p, m_p, s_p = trunk(x_prompt, c_prompt, z_conv, z_c, z_n, z_m, z_s,
                                                 lb_all, *weights)
    y_sample, conv_s, c_s, n_s, m_s, s_s = trunk(x_sample, c_sample, cache_conv, state_mlstm_C,
                                                 state_mlstm_n, state_mlstm_m, state_hgrn,
                                                 lb_all, *weights)
    return (y_prompt, y_sample, conv_p, c_p, n_p, m_p, s_p, conv_s, c_s, n_s, m_s, s_s)
```

```cpp
#include <hip/hip_runtime.h>
#include <cstdio>
#include <cstdint>
#ifndef MK_PER_PHASE
#define MK_PER_PHASE 0
#endif
namespace pg8 {
#define PG8_LAS __attribute__((address_space(3)))
typedef unsigned short bf16_t;
typedef short bf16x8 __attribute__((ext_vector_type(8)));
typedef float f32x4 __attribute__((ext_vector_type(4)));
typedef unsigned u32x4 __attribute__((ext_vector_type(4)));
constexpr int BM = 256, BK = 64, HALF = 128, HTB = HALF * BK * 2  , STAGE_BYTES = 8 * HTB, NXCD = 8, WGM = 8;

__host__ __device__ __forceinline__ int lds_byte(int r, int c) { const int st = (r >> 4) * 2 + (c >> 5), rr = r & 15, cc = c & 31, ob = rr * 64 + cc * 2; return st * 1024 + (ob ^ (((ob >> 9) & 1) << 5)); }
__host__ __device__ __forceinline__ void stage_rc(int b, int& R, int& C) { const int st = b / 1024, sb = b % 1024, swz = sb ^ (((sb >> 9) & 1) << 5); R = (st >> 1) * 16 + swz / 64; C = (st & 1) * 32 + (swz % 64) / 2; }
__host__ __device__ __forceinline__ int perm32(int rho) { const int n = rho >> 4, i = rho & 15; return 8 * (i >> 2) + 4 * n + (i & 3); }

struct Unit { int pm, pn; };
struct Gemm { const bf16_t* A; const bf16_t* Bt; int M, N, K; };

struct StaticOrder {
    int nM, nN, nwg, G, c;
    __host__ __device__ void init(int M, int N, int G_, int c_) { nM = M / BM; nN = N / BM; nwg = nM * nN; G = G_; c = c_; }
    __host__ __device__ bool next(int i, Unit& u) const {
        const long L = (long)i * G + c; if (L >= nwg) return false;
        int wgid = (int)L; { const int q = nwg / NXCD, r = nwg % NXCD, xcd = wgid % NXCD, off = wgid / NXCD; wgid = (xcd < r ? xcd * (q + 1) : r * (q + 1) + (xcd - r) * q) + off; }
        const int nig = WGM * nN, gid = wgid / nig, fm = gid * WGM, gsz = (nM - fm) < WGM ? (nM - fm) : WGM;
        u.pm = fm + ((wgid % nig) % gsz); u.pn = (wgid % nig) / gsz; return true;
    }
    __device__ __forceinline__ void a_ready(const Unit&) const {}
    __device__ __forceinline__ void done(const Unit&) const {}
};

__device__ __forceinline__ unsigned cvt_pk_bf16(float lo, float hi) { unsigned r; asm volatile("v_cvt_pk_bf16_f32 %0, %1, %2" : "=v"(r) : "v"(lo), "v"(hi)); return r; }
typedef float f32x2 __attribute__((ext_vector_type(2)));
template <class Epi, class Sched, bool ALIGN_EPI = false, bool SP2 = false>
__device__ __forceinline__ void gemm_phase(PG8_LAS unsigned char* lds, const Gemm g, const Sched& S, const Epi& E) {
    int tid_ = threadIdx.x; asm volatile("" : "+v"(tid_));
    const int tid = tid_, wid = __builtin_amdgcn_readfirstlane(tid >> 6), lane = tid & 63, wr = wid >> 2, wc = wid & 3, fr = lane & 15, fq = lane >> 4;
    const int K = g.K, nt = K / BK;
    unsigned voffA[2], voffB[2];
#pragma unroll
    for (int i = 0; i < 2; ++i) { int R, C; stage_rc(tid * 16 + i * 8192, R, C); const int Rb = Epi::PERM ? ((R & ~31) + perm32(R & 31)) : R;
        voffA[i] = (unsigned)(R * K + C) * 2u; voffB[i] = (unsigned)(Rb * K + C) * 2u; }
    const size_t kstep = (size_t)(BK * 2);
    const size_t hstep = (size_t)HALF * K * 2;
    const size_t tstep = 2 * hstep;
    const unsigned ldsw = (unsigned)wid * 1024u;
    const int aoff = lds_byte(wr * 64 + fr, fq * 8), boff = lds_byte(wc * 32 + fr, fq * 8);
#define PG8_SA(b, h) (((b) * 2 + (h)) * HTB)
#define PG8_SB(b, h) ((4 + (b) * 2 + (h)) * HTB)
#define PG8_STAGE(bufoff, gbase, voff) do { _Pragma("unroll") for (int _i = 0; _i < 2; ++_i) \
        __builtin_amdgcn_global_load_lds((const unsigned*)((const char*)(gbase) + (voff)[_i]), (PG8_LAS unsigned*)(lds + (bufoff) + ldsw + _i * 8192), 16, 0, 0); } while (0)
#define PG8_LDA(dst, b, h) do { _Pragma("unroll") for (int m = 0; m < 4; ++m) _Pragma("unroll") for (int k = 0; k < 2; ++k) dst[m][k] = *(const PG8_LAS bf16x8*)(lds + PG8_SA(b, h) + aoff + m * 2048 + k * 1024); } while (0)
#define PG8_LDB(dst, b, h) do { _Pragma("unroll") for (int n = 0; n < 2; ++n) _Pragma("unroll") for (int k = 0; k < 2; ++k) dst[n][k] = *(const PG8_LAS bf16x8*)(lds + PG8_SB(b, h) + boff + n * 2048 + k * 1024); } while (0)
#define PG8_MMA(ai, bj, At, Bt) do { __builtin_amdgcn_s_setprio(1); _Pragma("unroll") for (int m = 0; m < 4; ++m) _Pragma("unroll") for (int n = 0; n < 2; ++n) _Pragma("unroll") for (int k = 0; k < 2; ++k) \
        acc[ai][bj][m][n] = __builtin_amdgcn_mfma_f32_16x16x32_bf16(Bt[n][k], At[m][k], acc[ai][bj][m][n], 0, 0, 0); __builtin_amdgcn_s_setprio(0); } while (0)
#define PG8_WAIT_V(n) asm volatile("s_waitcnt vmcnt(" #n ")" ::: "memory")
#define PG8_WAIT_L(n) asm volatile("s_waitcnt lgkmcnt(" #n ")" ::: "memory")
#define PG8_BAR __builtin_amdgcn_s_barrier()
#define PG8_SCHED __builtin_amdgcn_sched_barrier(0)
    Unit cur, nxt; int ui = 0;
    if (!S.next(0, cur)) return;
    f32x4 acc[2][2][4][2];
#pragma unroll
    for (int a = 0; a < 2; ++a)
#pragma unroll
        for (int b = 0; b < 2; ++b)
#pragma unroll
            for (int m = 0; m < 4; ++m)
#pragma unroll
                for (int n = 0; n < 2; ++n) acc[a][b][m][n] = (f32x4){0.f, 0.f, 0.f, 0.f};
    bf16x8 At[4][2], B0[2][2], B1[2][2];
    const char* cA = (const char*)g.A + (size_t)cur.pm * tstep; const char* cB = (const char*)g.Bt + (size_t)cur.pn * tstep;
    S.a_ready(cur);
    if constexpr (SP2) {
        PG8_STAGE(PG8_SB(0, 0), cB, voffB); PG8_STAGE(PG8_SB(0, 1), cB + hstep, voffB); PG8_STAGE(PG8_SA(0, 0), cA, voffA); PG8_STAGE(PG8_SA(0, 1), cA + hstep, voffA);
        if (wr == 1) PG8_BAR;
        PG8_WAIT_V(2); PG8_BAR;
        PG8_STAGE(PG8_SB(1, 0), cB + kstep, voffB); PG8_STAGE(PG8_SA(1, 0), cA + kstep, voffA); PG8_STAGE(PG8_SB(1, 1), cB + hstep + kstep, voffB);
        PG8_WAIT_V(6); PG8_BAR;
    } else {
        PG8_STAGE(PG8_SB(0, 0), cB, voffB); PG8_STAGE(PG8_SA(0, 0), cA, voffA); PG8_STAGE(PG8_SB(0, 1), cB + hstep, voffB); PG8_STAGE(PG8_SA(0, 1), cA + hstep, voffA);
        if (wr == 1) PG8_BAR;
        PG8_WAIT_V(4); PG8_BAR;
        PG8_STAGE(PG8_SB(1, 0), cB + kstep, voffB); PG8_STAGE(PG8_SA(1, 0), cA + kstep, voffA); PG8_STAGE(PG8_SB(1, 1), cB + hstep + kstep, voffB);
        PG8_WAIT_V(6); PG8_BAR;
    }
    for (;;) {
        const bool has_next = S.next(ui + 1, nxt);
        const char* nA = has_next ? (const char*)g.A + (size_t)nxt.pm * tstep : cA; const char* nB = has_next ? (const char*)g.Bt + (size_t)nxt.pn * tstep : cB;
        for (int t = 0; t < nt; t += 2) {
            const bool last = (t == nt - 2);
            const char* a1 = cA + (size_t)(t + 1) * kstep;
            const char* a2 = last ? nA : cA + (size_t)(t + 2) * kstep; const char* b2 = last ? nB : cB + (size_t)(t + 2) * kstep;
            const char* a3 = a2 + kstep; const char* b3 = b2 + kstep;
            if (last && has_next) S.a_ready(nxt);
            if constexpr (SP2) {
            PG8_LDB(B0, 0, 0); PG8_LDB(B1, 0, 1); PG8_SCHED; PG8_LDA(At, 0, 0); PG8_STAGE(PG8_SA(1, 1), a1 + hstep, voffA);
            PG8_WAIT_V(8); PG8_WAIT_L(0); PG8_BAR; PG8_MMA(0, 0, At, B0); PG8_MMA(0, 1, At, B1); PG8_BAR; PG8_SCHED;
            PG8_LDA(At, 0, 1); PG8_STAGE(PG8_SB(0, 0), b2, voffB); PG8_STAGE(PG8_SB(0, 1), b2 + hstep, voffB); PG8_STAGE(PG8_SA(0, 0), a2, voffA);
            PG8_WAIT_V(8); PG8_WAIT_L(0); PG8_BAR; PG8_MMA(1, 0, At, B0); PG8_MMA(1, 1, At, B1); PG8_BAR; PG8_SCHED;
            PG8_LDB(B0, 1, 0); PG8_LDB(B1, 1, 1); PG8_SCHED; PG8_LDA(At, 1, 0); PG8_STAGE(PG8_SA(0, 1), a2 + hstep, voffA);
            PG8_WAIT_V(8); PG8_WAIT_L(0); PG8_BAR; PG8_MMA(0, 0, At, B0); PG8_MMA(0, 1, At, B1); PG8_BAR; PG8_SCHED;
            PG8_LDA(At, 1, 1); PG8_STAGE(PG8_SB(1, 0), b3, voffB); PG8_STAGE(PG8_SB(1, 1), b3 + hstep, voffB); PG8_STAGE(PG8_SA(1, 0), a3, voffA);
            PG8_WAIT_V(8); PG8_WAIT_L(0); PG8_BAR; PG8_MMA(1, 0, At, B0); PG8_MMA(1, 1, At, B1); PG8_BAR; PG8_SCHED;
            } else {
            PG8_LDB(B0, 0, 0); PG8_SCHED; PG8_LDA(At, 0, 0); PG8_STAGE(PG8_SA(1, 1), a1 + hstep, voffA);
            PG8_WAIT_L(8); PG8_BAR; PG8_WAIT_L(0); PG8_MMA(0, 0, At, B0); PG8_BAR; PG8_SCHED;
            PG8_LDB(B1, 0, 1); PG8_STAGE(PG8_SB(0, 0), b2, voffB);
            PG8_BAR; PG8_WAIT_L(0); PG8_MMA(0, 1, At, B1); PG8_BAR;
            PG8_LDA(At, 0, 1); PG8_STAGE(PG8_SA(0, 0), a2, voffA);
            PG8_BAR; PG8_WAIT_L(0); PG8_MMA(1, 0, At, B0); PG8_BAR; PG8_SCHED;
            PG8_STAGE(PG8_SB(0, 1), b2 + hstep, voffB);
            PG8_WAIT_V(6); PG8_BAR; PG8_MMA(1, 1, At, B1); PG8_BAR;
            PG8_LDB(B0, 1, 0); PG8_SCHED; PG8_LDA(At, 1, 0); PG8_STAGE(PG8_SA(0, 1), a2 + hstep, voffA);
            PG8_WAIT_L(8); PG8_BAR; PG8_WAIT_L(0); PG8_MMA(0, 0, At, B0); PG8_BAR; PG8_SCHED;
            PG8_LDB(B1, 1, 1); PG8_STAGE(PG8_SB(1, 0), b3, voffB);
            PG8_BAR; PG8_WAIT_L(0); PG8_MMA(0, 1, At, B1); PG8_BAR;
            PG8_LDA(At, 1, 1); PG8_STAGE(PG8_SA(1, 0), a3, voffA);
            PG8_BAR; PG8_WAIT_L(0); PG8_MMA(1, 0, At, B0); PG8_BAR; PG8_SCHED;
            PG8_STAGE(PG8_SB(1, 1), b3 + hstep, voffB);
            PG8_WAIT_V(6); PG8_BAR; PG8_MMA(1, 1, At, B1); PG8_BAR;
            }
        }
        if constexpr (ALIGN_EPI) { if (wr == 0) PG8_BAR; }
        if constexpr (!Epi::AFTER_DRAIN) { E(acc, cur, wr, wc, fr, fq); S.done(cur); }
        if (!has_next) break;
#pragma unroll
        for (int a = 0; a < 2; ++a)
#pragma unroll
            for (int b = 0; b < 2; ++b)
#pragma unroll
                for (int m = 0; m < 4; ++m)
#pragma unroll
                    for (int n = 0; n < 2; ++n) acc[a][b][m][n] = (f32x4){0.f, 0.f, 0.f, 0.f};
        cur = nxt; cA = nA; cB = nB; ++ui;
        if constexpr (ALIGN_EPI) { if (wr == 1) PG8_BAR; }
    }
    PG8_WAIT_V(0);
    if constexpr (!ALIGN_EPI) { if (wr == 0) PG8_BAR; }
    PG8_BAR;
    if constexpr (Epi::AFTER_DRAIN) { E.fused(acc, cur, wr, wc, fr, fq, lds, wid, lane); S.done(cur); }
#undef PG8_SA
#undef PG8_SB
#undef PG8_STAGE
#undef PG8_LDA
#undef PG8_LDB
#undef PG8_MMA
#undef PG8_WAIT_V
#undef PG8_WAIT_L
#undef PG8_BAR
#undef PG8_SCHED
}
}

constexpr int D = 2048, NB = 4, SEQ = 4096, DEPTH = 4, NSB = 8, SSEQ = 16;
constexpr int MPR = NB * SEQ;
constexpr int MS = NSB * SSEQ;
constexpr int M = MPR + MS;
constexpr int MP = 16640;
constexpr int NIN = 20496, NINP = 20736;
constexpr int DFF = 8192;
constexpr int ZQK = 0, ZVA = 4096, ZOA = 6144, ZQB = 8192, ZFB = 10240, ZIB = 12288, ZOGB = 14336, ZGA = 16384, ZGB = 18432, ZGT = 20480;
constexpr int MODW = 6 * D;
constexpr float EPS = 1e-6f;
constexpr int NCHUNKS = NB * (SEQ / 64) + NSB;

__device__ __forceinline__ int row_batch(int r) { int b = r < MPR ? (r >> 12) : 4 + ((r - MPR) >> 4); return b > 11 ? 11 : b; }
__device__ __forceinline__ float bf2f(unsigned short b) { return __uint_as_float(((unsigned)b) << 16); }
__device__ __forceinline__ float sigm(float x) { return 1.0f / (1.0f + __expf(-x)); }

namespace pg8 {
__device__ __forceinline__ void unpack8(const u32x4 w, float (&f)[8]) {
    f[0] = __uint_as_float(w.x << 16); f[1] = __uint_as_float(w.x & 0xffff0000u); f[2] = __uint_as_float(w.y << 16); f[3] = __uint_as_float(w.y & 0xffff0000u);
    f[4] = __uint_as_float(w.z << 16); f[5] = __uint_as_float(w.z & 0xffff0000u); f[6] = __uint_as_float(w.w << 16); f[7] = __uint_as_float(w.w & 0xffff0000u);
}
struct EpiZ {
    static constexpr bool PERM = true, AFTER_DRAIN = false;
    bf16_t* Z; const float* bias; float* G;
    __device__ __forceinline__ void operator()(const f32x4 (&acc)[2][2][4][2], const Unit& u, int wr, int wc, int fr, int fq) const {
        const int row0 = u.pm * BM + wr * 64 + fr, col0 = u.pn * BM + wc * 32 + 8 * fq;
        f32x4 bv[2][2];
#pragma unroll
        for (int bj = 0; bj < 2; ++bj)
#pragma unroll
            for (int n = 0; n < 2; ++n) bv[bj][n] = *(const f32x4*)(bias + col0 + bj * HALF + 4 * n);
        const bool gates = (u.pn == 80) && (wc == 0) && (fq < 2);
#pragma unroll
        for (int ai = 0; ai < 2; ++ai)
#pragma unroll
            for (int m = 0; m < 4; ++m) { const int row = row0 + ai * HALF + m * 16; bf16_t* rowp = Z + (size_t)row * NINP + col0;
#pragma unroll
                for (int bj = 0; bj < 2; ++bj) { const f32x4 v0 = acc[ai][bj][m][0] + bv[bj][0], v1 = acc[ai][bj][m][1] + bv[bj][1];
                    u32x4 w; w.x = cvt_pk_bf16(v0[0], v0[1]); w.y = cvt_pk_bf16(v0[2], v0[3]); w.z = cvt_pk_bf16(v1[0], v1[1]); w.w = cvt_pk_bf16(v1[2], v1[3]);
                    *(u32x4*)(rowp + bj * HALF) = w;
                    if (bj == 0 && gates) { float* gp = G + (size_t)row * 16 + 8 * fq; *(f32x4*)gp = v0; *(f32x4*)(gp + 4) = v1; } } }
    }
};
struct EpiGateTmp {
    static constexpr bool PERM = true, AFTER_DRAIN = false;
    const bf16_t* Zg; float* T;
    __device__ __forceinline__ void operator()(const f32x4 (&acc)[2][2][4][2], const Unit& u, int wr, int wc, int fr, int fq) const {
        const int row0 = u.pm * BM + wr * 64 + fr, col0 = u.pn * BM + wc * 32 + 8 * fq;
#pragma unroll
        for (int ai = 0; ai < 2; ++ai)
#pragma unroll
            for (int m = 0; m < 4; ++m) { const int row = row0 + ai * HALF + m * 16;
#pragma unroll
                for (int bj = 0; bj < 2; ++bj) { const int c = col0 + bj * HALF; float gz[8]; unpack8(*(const u32x4*)(Zg + (size_t)row * NINP + c), gz);
                    f32x4 v0 = acc[ai][bj][m][0], v1 = acc[ai][bj][m][1];
#pragma unroll
                    for (int j = 0; j < 4; ++j) { v0[j] *= sigm(gz[j]); v1[j] *= sigm(gz[4 + j]); }
                    float* tp = T + (size_t)row * D + c; *(f32x4*)tp = v0; *(f32x4*)(tp + 4) = v1; } }
    }
};
struct EpiMerge {
    static constexpr bool PERM = true, AFTER_DRAIN = false;
    const bf16_t* Zg; const float* T; bf16_t* O;
    __device__ __forceinline__ void operator()(const f32x4 (&acc)[2][2][4][2], const Unit& u, int wr, int wc, int fr, int fq) const {
        const int row0 = u.pm * BM + wr * 64 + fr, col0 = u.pn * BM + wc * 32 + 8 * fq;
#pragma unroll
        for (int ai = 0; ai < 2; ++ai)
#pragma unroll
            for (int m = 0; m < 4; ++m) { const int row = row0 + ai * HALF + m * 16;
#pragma unroll
                for (int bj = 0; bj < 2; ++bj) { const int c = col0 + bj * HALF; float gz[8]; unpack8(*(const u32x4*)(Zg + (size_t)row * NINP + c), gz);
                    const float* tp = T + (size_t)row * D + c; f32x4 v0 = *(const f32x4*)tp, v1 = *(const f32x4*)(tp + 4);
#pragma unroll
                    for (int j = 0; j < 4; ++j) { v0[j] += acc[ai][bj][m][0][j] * sigm(gz[j]); v1[j] += acc[ai][bj][m][1][j] * sigm(gz[4 + j]); }
                    u32x4 w; w.x = cvt_pk_bf16(v0[0], v0[1]); w.y = cvt_pk_bf16(v0[2], v0[3]); w.z = cvt_pk_bf16(v1[0], v1[1]); w.w = cvt_pk_bf16(v1[2], v1[3]);
                    *(u32x4*)(O + (size_t)row * D + c) = w; } }
    }
};
struct EpiResid {
    static constexpr bool PERM = false, AFTER_DRAIN = false;
    float* X; const float* gate;
    __device__ __forceinline__ void operator()(const f32x4 (&acc)[2][2][4][2], const Unit& u, int wr, int wc, int fr, int fq) const {
        const int row0 = u.pm * BM + wr * 64 + fr, col0 = u.pn * BM + wc * 32 + 4 * fq;
#pragma unroll
        for (int ai = 0; ai < 2; ++ai)
#pragma unroll
            for (int m = 0; m < 4; ++m) { const int row = row0 + ai * HALF + m * 16; const float* gp = gate + (size_t)row_batch(row) * MODW + col0; float* xp = X + (size_t)row * D + col0;
#pragma unroll
                for (int bj = 0; bj < 2; ++bj)
#pragma unroll
                    for (int n = 0; n < 2; ++n) { const int o = bj * HALF + n * 16; const f32x4 gv = *(const f32x4*)(gp + o), xv = *(const f32x4*)(xp + o); *(f32x4*)(xp + o) = xv + gv * acc[ai][bj][m][n]; }
                asm volatile("" ::: "memory"); }
    }
};
struct EpiRelu2 {
    static constexpr bool PERM = true, AFTER_DRAIN = false;
    bf16_t* O; int ldc;
    __device__ __forceinline__ void operator()(const f32x4 (&acc)[2][2][4][2], const Unit& u, int wr, int wc, int fr, int fq) const {
        const int row0 = u.pm * BM + wr * 64 + fr, col0 = u.pn * BM + wc * 32 + 8 * fq;
#pragma unroll
        for (int ai = 0; ai < 2; ++ai)
#pragma unroll
            for (int m = 0; m < 4; ++m) { bf16_t* rowp = O + (size_t)(row0 + ai * HALF + m * 16) * ldc + col0;
#pragma unroll
                for (int bj = 0; bj < 2; ++bj) { f32x4 v0 = acc[ai][bj][m][0], v1 = acc[ai][bj][m][1];
#pragma unroll
                    for (int j = 0; j < 4; ++j) { const float a = fmaxf(v0[j], 0.f), b = fmaxf(v1[j], 0.f); v0[j] = a * a; v1[j] = b * b; }
                    u32x4 w; w.x = cvt_pk_bf16(v0[0], v0[1]); w.y = cvt_pk_bf16(v0[2], v0[3]); w.z = cvt_pk_bf16(v1[0], v1[1]); w.w = cvt_pk_bf16(v1[2], v1[3]);
                    *(u32x4*)(rowp + bj * HALF) = w; } }
    }
};
}

constexpr size_t MiB = 1u << 20;
constexpr size_t WS_CTL = 0, CTL_ZERO_BYTES = 1 * MiB;
constexpr size_t WS_MOD = 1 * MiB;
constexpr size_t WS_LB = 4 * MiB;
constexpr size_t WS_BIN = 4 * MiB + 65536;
constexpr size_t WS_E1 = 5 * MiB, WS_E2 = 8 * MiB;
constexpr size_t WS_G = 11 * MiB;
constexpr size_t WS_W = 16 * MiB;
constexpr size_t W_WIN = 0, W_WBA = 81 * MiB, W_WBB = 89 * MiB, W_WO = 97 * MiB, W_WUP = 105 * MiB, W_WDN = 137 * MiB, W_LAYER = 169 * MiB;
constexpr size_t WS_X = 692 * MiB;
constexpr size_t WS_H = 822 * MiB;
constexpr size_t WS_Z = 887 * MiB;
constexpr size_t WS_QA = 1546 * MiB;
constexpr size_t WS_KA = 1611 * MiB;
constexpr size_t WS_QB = 1676 * MiB;
constexpr size_t WS_KB = 1741 * MiB;
constexpr size_t WS_HA = 1806 * MiB;
constexpr size_t WS_HB = 1936 * MiB;
constexpr size_t WS_END = 2066 * MiB;
static_assert((size_t)NINP * D * 2 <= 81 * MiB && (size_t)MP * NINP * 2 <= (WS_QA - WS_Z) && (size_t)MP * D * 2 == 65 * MiB && WS_W + 4 * W_LAYER <= WS_X, "ws map");
constexpr int CW_BAR = 4096;

constexpr size_t O_YP = 0, O_YS = O_YP + (size_t)MPR * D, O_CONVP = O_YS + (size_t)MS * D, O_CP = O_CONVP + (size_t)DEPTH * NB * 3 * 4096,
    O_NP = O_CP + (size_t)DEPTH * NB * 8 * 65536, O_MP = O_NP + (size_t)DEPTH * NB * 8 * 256, O_SP = O_MP + (size_t)DEPTH * NB * 8,
    O_CONVS = O_SP + (size_t)DEPTH * NB * 16 * 16384, O_CS = O_CONVS + (size_t)DEPTH * NSB * 3 * 4096, O_NS = O_CS + (size_t)DEPTH * NSB * 8 * 65536,
    O_MS = O_NS + (size_t)DEPTH * NSB * 8 * 256, O_SS = O_MS + (size_t)DEPTH * NSB * 8, O_END = O_SS + (size_t)DEPTH * NSB * 16 * 16384;

constexpr int RING_OFF = 0, RING_BYTES = 131072;
constexpr int LDS_BYTES = 147456;
constexpr int MISC_OFF = LDS_BYTES - 256;
constexpr int SC_Q = 0, SC_K = 33792, SC_VT = 67584, SC_VW = 79104, SC_CT = 90624, SC_P = 132864, SC_END = 142080;
constexpr int LQB = 528;
constexpr int LVB = 144;
constexpr int HS_Q = 0, HS_K = 17408, HS_VT = 34816, HS_ST = 44032, HS_P = 61440;
constexpr int LHB = 272;
static_assert(SC_END <= MISC_OFF, "LDS map");

#define GAS __attribute__((address_space(1)))
#define LAS __attribute__((address_space(3)))
#define DI __device__ __forceinline__
typedef unsigned short bf16;
typedef float f32x4 __attribute__((ext_vector_type(4)));
typedef unsigned u32x2 __attribute__((ext_vector_type(2)));
typedef unsigned u32x4 __attribute__((ext_vector_type(4)));
typedef short bf16x8 __attribute__((ext_vector_type(8)));
typedef GAS unsigned gu32;
#define RLX_AGENT __ATOMIC_RELAXED, __HIP_MEMORY_SCOPE_AGENT
#define LDS_WAIT() asm volatile("s_waitcnt lgkmcnt(0)" ::: "memory")
#define VM_WAIT() asm volatile("s_waitcnt vmcnt(0)" ::: "memory")
DI unsigned f2bf(float f) { unsigned u = __float_as_uint(f); return (u + 0x7fffu + ((u >> 16) & 1u)) >> 16; }
DI unsigned pk2(float lo, float hi) { return f2bf(lo) | (f2bf(hi) << 16); }
DI float wave_sum(float v) {
#pragma unroll
    for (int o = 1; o < 64; o <<= 1) v += __shfl_xor(v, o);
    return v;
}
DI float logsig(float x) { return fminf(x, 0.f) - __logf(1.0f + __expf(-fabsf(x))); }
#define XB_TMO      128
#define XB_XCNT(j)  (256  + 64 * (j))
#define XB_XSUB(j)  (1280 + 64 * (j))
#define XB_XGEN(j)  (2304 + 64 * (j))
#define XB_TOP      3328
#define XB_TOPGEN   3392
#define XCD_BAR_WORDS 3456
#define XB_SPIN_CAP (1u << 18)

__device__ __forceinline__ unsigned xb_ld(unsigned* p)              { return __hip_atomic_load(p, __ATOMIC_RELAXED, __HIP_MEMORY_SCOPE_AGENT); }
__device__ __forceinline__ unsigned xb_add(unsigned* p, unsigned v) { return __hip_atomic_fetch_add(p, v, __ATOMIC_RELAXED, __HIP_MEMORY_SCOPE_AGENT); }
__device__ __forceinline__ unsigned xb_xcc_id() { return (unsigned)__builtin_amdgcn_s_getreg((3 << 11) | 20) & 0xFu; }
#define XB_SPIN(cond, bar) do { unsigned _sp = 0; while (cond) { __builtin_amdgcn_s_sleep(1); \
    if ((++_sp & 255u) == 0u) { if (xb_ld(&(bar)[XB_TMO])) break; if (_sp > XB_SPIN_CAP) { atomicAdd(&(bar)[XB_TMO], 1u); break; } } } } while (0)

struct XcdBarrier {
    unsigned* bar; unsigned x;
    volatile LAS unsigned* st;
};

__device__ __forceinline__ XcdBarrier xcd_barrier_post(unsigned* bar, volatile LAS unsigned* st) {
    XcdBarrier b; b.bar = bar; b.x = xb_xcc_id(); b.st = st;
    if (threadIdx.x == 0) (void)xb_add(&bar[XB_XCNT(b.x)], 1u);
    return b;
}
__device__ __forceinline__ void xcd_barrier_complete(unsigned* bar, unsigned x, unsigned& nloc, unsigned& nx) {
    const unsigned G = gridDim.x * gridDim.y * gridDim.z;
    unsigned sum, cnt, mine, sp = 0u;
    for (;;) {
        sum = 0u; cnt = 0u; mine = 0u;
#pragma unroll
        for (unsigned j = 0; j < 16; ++j) { const unsigned c = xb_ld(&bar[XB_XCNT(j)]); sum += c; cnt += (c > 0u) ? 1u : 0u; mine = (j == x) ? c : mine; }
        if (sum == G) break;
        __builtin_amdgcn_s_sleep(1);
        if ((++sp & 255u) == 0u) { if (xb_ld(&bar[XB_TMO])) break; if (sp > XB_SPIN_CAP) { atomicAdd(&bar[XB_TMO], 1u); break; } }
    }
    nloc = mine > 0u ? mine : 1u; nx = cnt > 0u ? cnt : 1u;
}

__device__ __forceinline__ void xcd_barrier(const XcdBarrier& b) {
    asm volatile("s_waitcnt vmcnt(0)" ::: "memory");
    __syncthreads();
    if (threadIdx.x == 0) {
        unsigned* bar = b.bar;
        __builtin_amdgcn_s_waitcnt(0);
        unsigned nloc = b.st[0], nx = b.st[1];
        if (nloc == 0u) { xcd_barrier_complete(bar, b.x, nloc, nx); b.st[0] = nloc; b.st[1] = nx; }
        const unsigned old = xb_add(&bar[XB_XSUB(b.x)], 1u);
        const unsigned gen = old / nloc;
        if (old + 1u == (gen + 1u) * nloc) {
            __builtin_amdgcn_fence(__ATOMIC_RELEASE, "agent");
            asm volatile("s_waitcnt vmcnt(0)" ::: "memory");
            const unsigned og = xb_add(&bar[XB_TOP], 1u);
            const unsigned tg = og / nx;
            if (og + 1u == (tg + 1u) * nx) xb_add(&bar[XB_TOPGEN], 1u);
            else XB_SPIN(xb_ld(&bar[XB_TOPGEN]) == tg, bar);
            __builtin_amdgcn_fence(__ATOMIC_ACQUIRE, "agent");
            xb_add(&bar[XB_XGEN(b.x)], 1u);
            asm volatile("s_waitcnt vmcnt(0)" ::: "memory");
        } else {
            XB_SPIN(xb_ld(&bar[XB_XGEN(b.x)]) == gen, bar);
            __builtin_amdgcn_fence(__ATOMIC_ACQUIRE, "agent");
            asm volatile("s_waitcnt vmcnt(0)" ::: "memory");
        }
    }
    __syncthreads();
}

struct Ctx { LAS unsigned char* lds; unsigned char* ws; const float* const* in; float* out; int tid, lane, wave, G, bid; };

DI void p0_transpose_item(const float* W, int K, int Nsrc, int Npad, bf16* WT, LAS float* scr, int item, int lane) {
    const int nblk = Npad / 32, kb = item / nblk, nb = item % nblk, k0 = 64 * kb, n0 = 32 * nb;
    const int n = n0 + (lane & 31); const bool ok = n < Nsrc;
#pragma unroll 8
    for (int i = 0; i < 32; ++i) { const int kk = 2 * i + (lane >> 5); scr[kk * 33 + (lane & 31)] = ok ? W[(size_t)(k0 + kk) * Nsrc + n] : 0.f; }
    LDS_WAIT(); asm volatile("" ::: "memory");
    const int c = lane & 7;
#pragma unroll
    for (int j = 0; j < 4; ++j) { const int nn = (lane >> 3) + 8 * j; const LAS float* s = scr + (8 * c) * 33 + nn;
        u32x4 o; o.x = pk2(s[0 * 33], s[1 * 33]); o.y = pk2(s[2 * 33], s[3 * 33]); o.z = pk2(s[4 * 33], s[5 * 33]); o.w = pk2(s[6 * 33], s[7 * 33]);
        *(GAS u32x4*)(WT + (size_t)(n0 + nn) * K + k0 + 8 * c) = o; }
    LDS_WAIT(); asm volatile("" ::: "memory");
}

DI void p0_prologue(const Ctx& F) {
    const float* const* in = F.in;
    const int gw = F.bid * 8 + F.wave, NGW = F.G * 8;
    const int gt = F.bid * 512 + F.tid, NGT = F.G * 512;
    {
        LAS float* scr = (LAS float*)(F.lds + F.wave * 16384);
        constexpr int I0 = 32 * (NINP / 32), I1 = 32 * 64, I4 = 32 * 256, I5 = 128 * 64, IL = I0 + 3 * I1 + I4 + I5;
        for (int it = gw; it < DEPTH * IL; it += NGW) {
            const int l = it / IL; int r = it % IL;
            unsigned char* wl = F.ws + WS_W + (size_t)l * W_LAYER;
            if (r < I0) { p0_transpose_item(in[13] + (size_t)l * D * NIN, D, NIN, NINP, (bf16*)(wl + W_WIN), scr, r, F.lane); continue; } r -= I0;
            if (r < I1) { p0_transpose_item(in[20] + (size_t)l * D * D, D, D, D, (bf16*)(wl + W_WBA), scr, r, F.lane); continue; } r -= I1;
            if (r < I1) { p0_transpose_item(in[21] + (size_t)l * D * D, D, D, D, (bf16*)(wl + W_WBB), scr, r, F.lane); continue; } r -= I1;
            if (r < I1) { p0_transpose_item(in[22] + (size_t)l * D * D, D, D, D, (bf16*)(wl + W_WO), scr, r, F.lane); continue; } r -= I1;
            if (r < I4) { p0_transpose_item(in[23] + (size_t)l * D * DFF, D, DFF, DFF, (bf16*)(wl + W_WUP), scr, r, F.lane); continue; } r -= I4;
            p0_transpose_item(in[24] + (size_t)l * DFF * D, DFF, D, D, (bf16*)(wl + W_WDN), scr, r, F.lane);
        }
    }
    __syncthreads();
    {
        LAS float* csT = (LAS float*)F.lds;
        LAS float* red = (LAS float*)(F.lds + 98304);
        for (int i = F.tid; i < 12 * D; i += 512) { const int r = i / D, k = i % D; const float c = r < 4 ? in[7][r * D + k] : in[8][(r - 4) * D + k]; csT[k * 12 + r] = c * sigm(c); }
        __syncthreads();
        float* MOD = (float*)(F.ws + WS_MOD);
        for (int u = F.bid; u < DEPTH * (MODW / 64); u += F.G) {
            const int l = u / (MODW / 64), j = (u % (MODW / 64)) * 64 + F.lane;
            const float* wp = in[9] + (size_t)l * D * MODW + (size_t)(256 * F.wave) * MODW + j;
            float acc[12];
#pragma unroll
            for (int r = 0; r < 12; ++r) acc[r] = 0.f;
#pragma unroll 8
            for (int k = 0; k < 256; ++k) { const float w = wp[(size_t)k * MODW]; const LAS f32x4* cp = (const LAS f32x4*)(csT + (256 * F.wave + k) * 12);
                const f32x4 c0 = cp[0], c1 = cp[1], c2 = cp[2];
                acc[0] += c0[0] * w; acc[1] += c0[1] * w; acc[2] += c0[2] * w; acc[3] += c0[3] * w; acc[4] += c1[0] * w; acc[5] += c1[1] * w; acc[6] += c1[2] * w; acc[7] += c1[3] * w;
                acc[8] += c2[0] * w; acc[9] += c2[1] * w; acc[10] += c2[2] * w; acc[11] += c2[3] * w; }
#pragma unroll
            for (int r = 0; r < 12; ++r) red[(F.wave * 12 + r) * 64 + F.lane] = acc[r];
            __syncthreads();
            for (int i = F.tid; i < 12 * 64; i += 512) { const int r = i / 64, c = i % 64; float s = 0.f;
#pragma unroll
                for (int w = 0; w < 8; ++w) s += red[(w * 12 + r) * 64 + c];
                const int jj = (u % (MODW / 64)) * 64 + c; MOD[((size_t)l * 12 + r) * MODW + jj] = s + in[10][(size_t)l * MODW + jj]; }
            __syncthreads();
        }
    }
    {
        f32x4* X4 = (f32x4*)(F.ws + WS_X); const f32x4* xp = (const f32x4*)in[0]; const f32x4* xs = (const f32x4*)in[1];
        const size_t n_p = (size_t)MPR * D / 4, n_s = (size_t)MS * D / 4, n_all = (size_t)MP * D / 4;
        for (size_t i = gt; i < n_all; i += NGT) X4[i] = i < n_p ? xp[i] : (i < n_p + n_s ? xs[i - n_p] : (f32x4){0.f, 0.f, 0.f, 0.f});
        const size_t pad0 = (size_t)M * D * 2 / 16, pad1 = (size_t)MP * D * 2 / 16;
        u32x4* h4 = (u32x4*)(F.ws + WS_H); u32x4* a4 = (u32x4*)(F.ws + WS_QA); u32x4* b4 = (u32x4*)(F.ws + WS_KA);
        for (size_t i = pad0 + gt; i < pad1; i += NGT) { const u32x4 z = {0u, 0u, 0u, 0u}; h4[i] = z; a4[i] = z; b4[i] = z; }
    }
    {
        float* LB = (float*)(F.ws + WS_LB);
        for (int d = gt; d < 2048; d += NGT) { float r[4], mx = -1e30f;
#pragma unroll
            for (int l = 0; l < 4; ++l) { r[l] = in[18][l * 2048 + d]; mx = fmaxf(mx, r[l]); }
            float e[4], s = 0.f;
#pragma unroll
            for (int l = 0; l < 4; ++l) { e[l] = __expf(r[l] - mx); s += e[l]; }
            const float inv = 1.0f / s; float cum = 0.f;
#pragma unroll
            for (int l = 0; l < 4; ++l) { if (l > 0) cum += e[l] * inv; LB[l * 2048 + d] = cum; } }
        float* BIN = (float*)(F.ws + WS_BIN);
        for (int i = gt; i < DEPTH * NINP; i += NGT) { const int l = i / NINP, c = i % NINP; BIN[i] = c < NIN ? in[14][(size_t)l * NIN + c] : 0.f; }
    }
}

DI void norm_phase(const Ctx& F, const float* gain, const float* modl  , int sh_off, int sc_off) {
    const int gw = F.bid * 8 + F.wave, NGW = F.G * 8;
    const float* X = (const float*)(F.ws + WS_X); bf16* H = (bf16*)(F.ws + WS_H);
    for (int row = gw; row < M; row += NGW) {
        const GAS f32x4* xr = (const GAS f32x4*)(X + (size_t)row * D) + F.lane;
        f32x4 v[8]; float ss = 0.f;
#pragma unroll
        for (int j = 0; j < 8; ++j) { v[j] = xr[64 * j]; ss += (v[j].x * v[j].x + v[j].y * v[j].y) + (v[j].z * v[j].z + v[j].w * v[j].w); }
        const float rs = rsqrtf(wave_sum(ss) * (1.0f / D) + EPS);
        const float* mb = modl + (size_t)row_batch(row) * MODW;
        GAS u32x2* o8 = (GAS u32x2*)(H + (size_t)row * D) + F.lane;
#pragma unroll
        for (int j = 0; j < 8; ++j) { const int c = 4 * F.lane + 256 * j; const f32x4 g = *(const f32x4*)(gain + c), sc = *(const f32x4*)(mb + sc_off + c), sh = *(const f32x4*)(mb + sh_off + c);
            const f32x4 y = (v[j] * rs) * g * (sc + 1.0f) + sh; u32x2 w; w.x = pk2(y.x, y.y); w.y = pk2(y.z, y.w); o8[64 * j] = w; }
    }
}
DI void final_norm_phase(const Ctx& F) {
    const int gw = F.bid * 8 + F.wave, NGW = F.G * 8;
    const float* X = (const float*)(F.ws + WS_X); const float* gain = F.in[25];
    for (int row = gw; row < M; row += NGW) {
        const GAS f32x4* xr = (const GAS f32x4*)(X + (size_t)row * D) + F.lane;
        f32x4 v[8]; float ss = 0.f;
#pragma unroll
        for (int j = 0; j < 8; ++j) { v[j] = xr[64 * j]; ss += (v[j].x * v[j].x + v[j].y * v[j].y) + (v[j].z * v[j].z + v[j].w * v[j].w); }
        const float rs = rsqrtf(wave_sum(ss) * (1.0f / D) + EPS);
        GAS f32x4* o = (GAS f32x4*)(F.out + (size_t)row * D) + F.lane;
#pragma unroll
        for (int j = 0; j < 8; ++j) { const f32x4 g = *(const f32x4*)(gain + 4 * F.lane + 256 * j); o[64 * j] = (v[j] * rs) * g; }
    }
}

DI void prep_phase(const Ctx& F, int l) {
    const bf16* Z = (const bf16*)(F.ws + WS_Z);
    bf16* QA = (bf16*)(F.ws + WS_QA); bf16* KA = (bf16*)(F.ws + WS_KA); bf16* QB = (bf16*)(F.ws + WS_QB); bf16* KB = (bf16*)(F.ws + WS_KB);
    float* E1 = (float*)(F.ws + WS_E1); float* E2 = (float*)(F.ws + WS_E2);
    const float* LB = (const float*)(F.ws + WS_LB) + l * 2048;
    constexpr int NCONV = M / 16, NHG = NCHUNKS * 4;
    for (int it = F.bid; it < NCONV + NHG; it += F.G) {
        if (it < NCONV) {
            const int r0 = it * 16, c0 = 8 * F.tid; const bool sample = r0 >= MPR;
            const int t0 = sample ? 0 : (r0 & (SEQ - 1)); const int bs = sample ? (r0 - MPR) >> 4 : (r0 >> 12);
            float w[4][8], cb[8];
#pragma unroll
            for (int j = 0; j < 4; ++j) { const f32x4 a = *(const f32x4*)(F.in[15] + ((size_t)l * 4 + j) * 4096 + c0), b = *(const f32x4*)(F.in[15] + ((size_t)l * 4 + j) * 4096 + c0 + 4);
                w[j][0] = a.x; w[j][1] = a.y; w[j][2] = a.z; w[j][3] = a.w; w[j][4] = b.x; w[j][5] = b.y; w[j][6] = b.z; w[j][7] = b.w; }
            { const f32x4 a = *(const f32x4*)(F.in[16] + (size_t)l * 4096 + c0), b = *(const f32x4*)(F.in[16] + (size_t)l * 4096 + c0 + 4);
                cb[0] = a.x; cb[1] = a.y; cb[2] = a.z; cb[3] = a.w; cb[4] = b.x; cb[5] = b.y; cb[6] = b.z; cb[7] = b.w; }
            float z0[8], z1[8], z2[8];
            if (t0 == 0) {
                if (sample) { const float* cc = F.in[2] + (((size_t)l * NSB + bs) * 3) * 4096 + c0;
#pragma unroll
                    for (int e = 0; e < 8; ++e) { z0[e] = cc[e]; z1[e] = cc[4096 + e]; z2[e] = cc[8192 + e]; } }
                else {
#pragma unroll
                    for (int e = 0; e < 8; ++e) { z0[e] = 0.f; z1[e] = 0.f; z2[e] = 0.f; } }
            } else {
                pg8::unpack8(*(const u32x4*)(Z + (size_t)(r0 - 3) * NINP + c0), z0); pg8::unpack8(*(const u32x4*)(Z + (size_t)(r0 - 2) * NINP + c0), z1); pg8::unpack8(*(const u32x4*)(Z + (size_t)(r0 - 1) * NINP + c0), z2);
            }
            const bool last = sample || (t0 + 16 == SEQ);
            float* cout = F.out + (sample ? O_CONVS + (((size_t)l * NSB + bs) * 3) * 4096 : O_CONVP + (((size_t)l * NB + bs) * 3) * 4096) + c0;
#pragma unroll
            for (int rr = 0; rr < 16; ++rr) {
                float z3[8]; pg8::unpack8(*(const u32x4*)(Z + (size_t)(r0 + rr) * NINP + c0), z3);
                float y[8];
#pragma unroll
                for (int e = 0; e < 8; ++e) { const float a = cb[e] + w[0][e] * z0[e] + w[1][e] * z1[e] + w[2][e] * z2[e] + w[3][e] * z3[e]; y[e] = a * sigm(a); }
                if (c0 < 2048) { u32x4 o; o.x = pk2(y[0], y[1]); o.y = pk2(y[2], y[3]); o.z = pk2(y[4], y[5]); o.w = pk2(y[6], y[7]); *(u32x4*)(QA + (size_t)(r0 + rr) * D + c0) = o; }
                else { u32x4 o; o.x = pk2(y[0] * 0.0625f, y[1] * 0.0625f); o.y = pk2(y[2] * 0.0625f, y[3] * 0.0625f); o.z = pk2(y[4] * 0.0625f, y[5] * 0.0625f); o.w = pk2(y[6] * 0.0625f, y[7] * 0.0625f);
                    *(u32x4*)(KA + (size_t)(r0 + rr) * D + (c0 - 2048)) = o; }
                if (last && rr >= 13) { float* cp = cout + (size_t)(rr - 13) * 4096; *(f32x4*)cp = (f32x4){z3[0], z3[1], z3[2], z3[3]}; *(f32x4*)(cp + 4) = (f32x4){z3[4], z3[5], z3[6], z3[7]}; }
#pragma unroll
                for (int e = 0; e < 8; ++e) { z0[e] = z1[e]; z1[e] = z2[e]; z2[e] = z3[e]; }
            }
        } else {
            const int hi = it - NCONV, ci = hi >> 2, d = (hi & 3) * 512 + F.tid;
            const bool sample = ci >= NB * 64; const int r0 = sample ? MPR + (ci - NB * 64) * 16 : ci * 64; const int Tv = sample ? 16 : 64;
            const float lb = LB[d], oml = 1.0f - lb;
            float bcum[64]; float run = 0.f;
#pragma unroll
            for (int t = 0; t < 64; ++t) { if (t < Tv) { const float fb = bf2f(Z[(size_t)(r0 + t) * NINP + ZFB + d]); const float f = lb + oml * sigm(fb); run += fmaxf(__logf(f), -60.0f); } bcum[t] = run; }
            const float bR = bcum[31], bE = bcum[63];
            E1[(size_t)ci * 2048 + d] = __expf(bR); E2[(size_t)ci * 2048 + d] = __expf(bE - bR);
#pragma unroll
            for (int t = 0; t < 64; ++t) { if (t < Tv) { const size_t zr = (size_t)(r0 + t) * NINP; const float fb = bf2f(Z[zr + ZFB + d]), qv = bf2f(Z[zr + ZQB + d]);
                    const float q = qv * sigm(qv) * __expf(bcum[t] - bR), k = oml * sigm(-fb) * __expf(bR - bcum[t]);
                    QB[(size_t)(r0 + t) * D + d] = (bf16)f2bf(q); KB[(size_t)(r0 + t) * D + d] = (bf16)f2bf(k); } }
        }
    }
}

DI void headnorm_phase(const Ctx& F, int l) {
    const int gw = F.bid * 8 + F.wave, NGW = F.G * 8;
    const bf16* Z = (const bf16*)(F.ws + WS_Z); const float* HA = (const float*)(F.ws + WS_HA); const float* HB = (const float*)(F.ws + WS_HB);
    bf16* YA = (bf16*)(F.ws + WS_QA); bf16* YB = (bf16*)(F.ws + WS_KA);
    const float* ga = F.in[17] + (size_t)l * 2048; const float* gb = F.in[19] + (size_t)l * 2048;
    for (int row = gw; row < M; row += NGW) {
#pragma unroll
        for (int j = 0; j < 8; ++j) {
            const int c = 256 * j + 4 * F.lane;
            { const f32x4 hv = *(const GAS f32x4*)(HA + (size_t)row * D + c); float ss = (hv.x * hv.x + hv.y * hv.y) + (hv.z * hv.z + hv.w * hv.w); ss = wave_sum(ss);
              const float rs = rsqrtf(ss * (1.0f / 256.0f) + EPS); const u32x2 oz = *(const GAS u32x2*)(Z + (size_t)row * NINP + ZOA + c); const f32x4 g = *(const f32x4*)(ga + c);
              const float o0 = sigm(__uint_as_float(oz.x << 16)), o1 = sigm(__uint_as_float(oz.x & 0xffff0000u)), o2 = sigm(__uint_as_float(oz.y << 16)), o3 = sigm(__uint_as_float(oz.y & 0xffff0000u));
              u32x2 w; w.x = pk2(hv.x * rs * g.x * o0, hv.y * rs * g.y * o1); w.y = pk2(hv.z * rs * g.z * o2, hv.w * rs * g.w * o3); *(GAS u32x2*)(YA + (size_t)row * D + c) = w; }
            { const f32x4 hv = *(const GAS f32x4*)(HB + (size_t)row * D + c); float ss = (hv.x * hv.x + hv.y * hv.y) + (hv.z * hv.z + hv.w * hv.w);
#pragma unroll
              for (int o = 1; o < 32; o <<= 1) ss += __shfl_xor(ss, o);
              const float rs = rsqrtf(ss * (1.0f / 128.0f) + EPS); const u32x2 oz = *(const GAS u32x2*)(Z + (size_t)row * NINP + ZOGB + c); const f32x4 g = *(const f32x4*)(gb + c);
              const float o0 = sigm(__uint_as_float(oz.x << 16)), o1 = sigm(__uint_as_float(oz.x & 0xffff0000u)), o2 = sigm(__uint_as_float(oz.y << 16)), o3 = sigm(__uint_as_float(oz.y & 0xffff0000u));
              u32x2 w; w.x = pk2(hv.x * rs * g.x * o0, hv.y * rs * g.y * o1); w.y = pk2(hv.z * rs * g.z * o2, hv.w * rs * g.w * o3); *(GAS u32x2*)(YB + (size_t)row * D + c) = w; }
        }
    }
}

DI bf16x8 frag(const LAS unsigned char* base, int row, int ldb, int kbyte) { return *(const LAS bf16x8*)(base + row * ldb + kbyte); }
DI bf16x8 frag_t(const LAS unsigned char* base, int k0, int ldb, int col) {
    const LAS unsigned short* p = (const LAS unsigned short*)(base + k0 * ldb + col * 2); bf16x8 r;
#pragma unroll
    for (int j = 0; j < 8; ++j) r[j] = (short)p[j * (ldb / 2)];
    return r;
}
#define MFMA16(a, b, c) __builtin_amdgcn_mfma_f32_16x16x32_bf16((a), (b), (c), 0, 0, 0)

DI void mlstm_unit(LAS unsigned char* lds, const bf16* QA, const bf16* KA, const bf16* Z, const float* G, float* HA,
                   int row0, int nchunk, int Tv, int h, int vs, const float* C0, const float* n0, const float* m0p, float* Cout, float* nout, float* mout) {
    int tid_ = threadIdx.x; asm volatile("" : "+v"(tid_));
    const int tid = tid_, lane = tid & 63, W = __builtin_amdgcn_readfirstlane(tid >> 6), g = lane >> 4, li = lane & 15;
    LAS unsigned char* Qs = lds + SC_Q; LAS unsigned char* Ks = lds + SC_K; LAS unsigned char* VT = lds + SC_VT; LAS unsigned char* VW = lds + SC_VW;
    LAS unsigned char* CTs = lds + SC_CT; LAS unsigned char* Ps = lds + SC_P;
    f32x4 cacc[2][5];
#pragma unroll
    for (int di = 0; di < 2; ++di)
#pragma unroll
        for (int vi = 0; vi < 5; ++vi)
#pragma unroll
            for (int r = 0; r < 4; ++r) { const int d = 16 * (2 * W + di) + 4 * g + r; float v = 0.f;
                if (C0) { if (vi < 4) v = C0[(size_t)d * 256 + 64 * vs + 16 * vi + li]; else if (li == 0) v = n0[d]; }
                cacc[di][vi][r] = v; }
    float m_prev = m0p ? *m0p : 0.f;
    for (int i = tid; i < 16 * 72; i += 512) { const int rr = 64 + i / 72, cc = i % 72;
        *(LAS unsigned short*)(VT + rr * LVB + cc * 2) = (rr == 64 && cc < 64) ? (unsigned short)0x3F80 : (unsigned short)0; *(LAS unsigned short*)(VW + rr * LVB + cc * 2) = 0; }
    u32x4 pq[4], pk[4], pv; float pig, pfg;
#define ML_PREFETCH(c) do { const int r0_ = row0 + 64 * (c); \
        _Pragma("unroll") for (int i = 0; i < 4; ++i) { const int idx = tid + 512 * i, rr = idx >> 5, sg = idx & 31; \
            if (rr < Tv) { pq[i] = *(const GAS u32x4*)(QA + (size_t)(r0_ + rr) * D + 256 * h + 8 * sg); pk[i] = *(const GAS u32x4*)(KA + (size_t)(r0_ + rr) * D + 256 * h + 8 * sg); } \
            else { pq[i] = (u32x4){0u, 0u, 0u, 0u}; pk[i] = (u32x4){0u, 0u, 0u, 0u}; } } \
        { const int rr = tid >> 3, sg = tid & 7; pv = rr < Tv ? *(const GAS u32x4*)(Z + (size_t)(r0_ + rr) * NINP + ZVA + 256 * h + 64 * vs + 8 * sg) : (u32x4){0u, 0u, 0u, 0u}; } \
        pig = lane < Tv ? G[(size_t)(r0_ + lane) * 16 + h] : -1e30f; pfg = lane < Tv ? G[(size_t)(r0_ + lane) * 16 + 8 + h] : 0.f; } while (0)
    ML_PREFETCH(0);
    for (int c = 0; c < nchunk; ++c) {
        const int r0 = row0 + 64 * c;
        const float igv = pig; const float lfv = lane < Tv ? logsig(pfg) : 0.f;
        float bc = lfv;
#pragma unroll
        for (int o = 1; o < 64; o <<= 1) { const float y = __shfl_up(bc, o); if (lane >= o) bc += y; }
        float gm = igv - bc;
#pragma unroll
        for (int o = 1; o < 64; o <<= 1) { const float y = __shfl_up(gm, o); if (lane >= o) gm = fmaxf(gm, y); }
        const float mt = bc + fmaxf(gm, m_prev);
        const float winter = __expf(bc + m_prev - mt), enm = __expf(-mt);
        const float m_last = __shfl(mt, 63), b_last = __shfl(bc, 63);
        const float wlast = __expf(b_last - bc + igv - m_last);
        const float decay = __shfl(winter, 63);
#pragma unroll
        for (int i = 0; i < 4; ++i) { const int idx = tid + 512 * i, rr = idx >> 5, sg = idx & 31; *(LAS u32x4*)(Qs + rr * LQB + sg * 16) = pq[i]; *(LAS u32x4*)(Ks + rr * LQB + sg * 16) = pk[i]; }
        { const int rr = tid >> 3, sg = tid & 7; const float wl = __shfl(wlast, rr); float vv[8]; pg8::unpack8(pv, vv);
#pragma unroll
          for (int j = 0; j < 8; ++j) { *(LAS unsigned short*)(VT + (8 * sg + j) * LVB + rr * 2) = (unsigned short)f2bf(vv[j]); *(LAS unsigned short*)(VW + (8 * sg + j) * LVB + rr * 2) = (unsigned short)f2bf(vv[j] * wl); } }
        if (W == 0) *(LAS unsigned short*)(VW + 64 * LVB + lane * 2) = (unsigned short)f2bf(wlast);
#pragma unroll
        for (int di = 0; di < 2; ++di)
#pragma unroll
            for (int vi = 0; vi < 5; ++vi) { u32x2 w; w.x = pk2(cacc[di][vi][0], cacc[di][vi][1]); w.y = pk2(cacc[di][vi][2], cacc[di][vi][3]);
                *(LAS u32x2*)(CTs + (16 * vi + li) * LQB + (16 * (2 * W + di) + 4 * g) * 2) = w; }
        __syncthreads();
        if (c + 1 < nchunk) ML_PREFETCH(c + 1);
        {
            const int tt = W & 3, sh = W >> 2;
            f32x4 sacc[2] = {{0.f, 0.f, 0.f, 0.f}, {0.f, 0.f, 0.f, 0.f}};
#pragma unroll
            for (int kk = 0; kk < 8; ++kk) { const bf16x8 bq = frag(Qs, 16 * tt + li, LQB, 64 * kk + 16 * g);
#pragma unroll
                for (int i = 0; i < 2; ++i) { const bf16x8 ak = frag(Ks, 16 * (2 * sh + i) + li, LQB, 64 * kk + 16 * g); sacc[i] = MFMA16(ak, bq, sacc[i]); } }
            const int t = 16 * tt + li; const float bt = __shfl(bc, t), mtt = __shfl(mt, t);
#pragma unroll
            for (int i = 0; i < 2; ++i) { float p[4];
#pragma unroll
                for (int r = 0; r < 4; ++r) { const int s = 16 * (2 * sh + i) + 4 * g + r; const float bs = __shfl(bc, s), igs = __shfl(igv, s);
                    p[r] = (s <= t) ? sacc[i][r] * __expf(bt - bs + igs - mtt) : 0.f; }
                u32x2 w; w.x = pk2(p[0], p[1]); w.y = pk2(p[2], p[3]); *(LAS u32x2*)(Ps + t * LVB + (16 * (2 * sh + i) + 4 * g) * 2) = w; }
        }
        __syncthreads();
        {
            const int tt = W & 3, vh = W >> 2; const int vt0 = 2 * vh, vt1 = 2 * vh + 1;
            f32x4 a1[3], a2[3];
#pragma unroll
            for (int i = 0; i < 3; ++i) { a1[i] = (f32x4){0.f, 0.f, 0.f, 0.f}; a2[i] = (f32x4){0.f, 0.f, 0.f, 0.f}; }
#pragma unroll
            for (int kk = 0; kk < 2; ++kk) { const bf16x8 ap = frag(Ps, 16 * tt + li, LVB, 64 * kk + 16 * g);
                a1[0] = MFMA16(ap, frag(VT, 16 * vt0 + li, LVB, 64 * kk + 16 * g), a1[0]); a1[1] = MFMA16(ap, frag(VT, 16 * vt1 + li, LVB, 64 * kk + 16 * g), a1[1]);
                a1[2] = MFMA16(ap, frag(VT, 64 + li, LVB, 64 * kk + 16 * g), a1[2]); }
#pragma unroll
            for (int kk = 0; kk < 8; ++kk) { const bf16x8 aq = frag(Qs, 16 * tt + li, LQB, 64 * kk + 16 * g);
                a2[0] = MFMA16(aq, frag(CTs, 16 * vt0 + li, LQB, 64 * kk + 16 * g), a2[0]); a2[1] = MFMA16(aq, frag(CTs, 16 * vt1 + li, LQB, 64 * kk + 16 * g), a2[1]);
                a2[2] = MFMA16(aq, frag(CTs, 64 + li, LQB, 64 * kk + 16 * g), a2[2]); }
#pragma unroll
            for (int r = 0; r < 4; ++r) { const int t = 16 * tt + 4 * g + r; const float wi = __shfl(winter, t), en = __shfl(enm, t);
                const float o2 = a1[2][r] + wi * a2[2][r]; const float qn = __shfl(o2, lane & 48); const float inv = 1.0f / fmaxf(fabsf(qn), en);
                if (t < Tv) { float* hp = HA + (size_t)(r0 + t) * D + 256 * h + 64 * vs + li; hp[16 * vt0] = (a1[0][r] + wi * a2[0][r]) * inv; hp[16 * vt1] = (a1[1][r] + wi * a2[1][r]) * inv; } }
        }
#pragma unroll
        for (int di = 0; di < 2; ++di)
#pragma unroll
            for (int vi = 0; vi < 5; ++vi) cacc[di][vi] = cacc[di][vi] * decay;
#pragma unroll
        for (int kk = 0; kk < 2; ++kk) { bf16x8 ak[2];
#pragma unroll
            for (int di = 0; di < 2; ++di) ak[di] = frag_t(Ks, 32 * kk + 8 * g, LQB, 16 * (2 * W + di) + li);
#pragma unroll
            for (int vi = 0; vi < 5; ++vi) { const bf16x8 bv = frag(VW, 16 * vi + li, LVB, 64 * kk + 16 * g);
#pragma unroll
                for (int di = 0; di < 2; ++di) cacc[di][vi] = MFMA16(ak[di], bv, cacc[di][vi]); } }
        m_prev = m_last;
        __syncthreads();
    }
#undef ML_PREFETCH
#pragma unroll
    for (int di = 0; di < 2; ++di)
#pragma unroll
        for (int r = 0; r < 4; ++r) { const int d = 16 * (2 * W + di) + 4 * g + r;
#pragma unroll
            for (int vi = 0; vi < 4; ++vi) Cout[(size_t)d * 256 + 64 * vs + 16 * vi + li] = cacc[di][vi][r];
            if (vs == 0 && li == 0) nout[d] = cacc[di][4][r]; }
    if (vs == 0 && tid == 0) *mout = m_prev;
}

DI void hgrn_unit(LAS unsigned char* lds, const bf16* QB, const bf16* KB, const bf16* Z, const float* E1, const float* E2, float* HB,
                  int row0, int nchunk, int Tv, int h, int vs, int ci0, const float* S0, float* Sout) {
    int tid_ = threadIdx.x; asm volatile("" : "+v"(tid_));
    const int tid = tid_, lane = tid & 63, W = __builtin_amdgcn_readfirstlane(tid >> 6), g = lane >> 4, li = lane & 15;
    LAS unsigned char* Qs = lds + HS_Q; LAS unsigned char* Ks = lds + HS_K; LAS unsigned char* VT = lds + HS_VT; LAS unsigned char* STs = lds + HS_ST; LAS unsigned char* Ps = lds + HS_P;
    f32x4 sacc[4];
#pragma unroll
    for (int vi = 0; vi < 4; ++vi)
#pragma unroll
        for (int r = 0; r < 4; ++r) sacc[vi][r] = S0 ? S0[(size_t)(16 * W + 4 * g + r) * 128 + 64 * vs + 16 * vi + li] : 0.f;
    u32x4 pq[2], pk[2], pv; f32x4 pe1, pe2;
#define HG_PREFETCH(c) do { const int r0_ = row0 + 64 * (c); \
        _Pragma("unroll") for (int i = 0; i < 2; ++i) { const int idx = tid + 512 * i, rr = idx >> 4, sg = idx & 15; \
            if (rr < Tv) { pq[i] = *(const GAS u32x4*)(QB + (size_t)(r0_ + rr) * D + 128 * h + 8 * sg); pk[i] = *(const GAS u32x4*)(KB + (size_t)(r0_ + rr) * D + 128 * h + 8 * sg); } \
            else { pq[i] = (u32x4){0u, 0u, 0u, 0u}; pk[i] = (u32x4){0u, 0u, 0u, 0u}; } } \
        { const int rr = tid >> 3, sg = tid & 7; pv = rr < Tv ? *(const GAS u32x4*)(Z + (size_t)(r0_ + rr) * NINP + ZIB + 128 * h + 64 * vs + 8 * sg) : (u32x4){0u, 0u, 0u, 0u}; } \
        pe1 = *(const GAS f32x4*)(E1 + (size_t)(ci0 + (c)) * 2048 + 128 * h + 16 * W + 4 * g); pe2 = *(const GAS f32x4*)(E2 + (size_t)(ci0 + (c)) * 2048 + 128 * h + 16 * W + 4 * g); } while (0)
    HG_PREFETCH(0);
    for (int c = 0; c < nchunk; ++c) {
        const int r0 = row0 + 64 * c;
        const f32x4 e2 = pe2;
        f32x4 smid[4];
#pragma unroll
        for (int vi = 0; vi < 4; ++vi) smid[vi] = sacc[vi] * pe1;
#pragma unroll
        for (int i = 0; i < 2; ++i) { const int idx = tid + 512 * i, rr = idx >> 4, sg = idx & 15; *(LAS u32x4*)(Qs + rr * LHB + sg * 16) = pq[i]; *(LAS u32x4*)(Ks + rr * LHB + sg * 16) = pk[i]; }
        { const int rr = tid >> 3, sg = tid & 7; const unsigned wv[4] = {pv.x, pv.y, pv.z, pv.w};
#pragma unroll
          for (int j = 0; j < 8; ++j) *(LAS unsigned short*)(VT + (8 * sg + j) * LVB + rr * 2) = (unsigned short)((j & 1) ? (wv[j >> 1] >> 16) : (wv[j >> 1] & 0xffffu)); }
#pragma unroll
        for (int vi = 0; vi < 4; ++vi) { u32x2 w; w.x = pk2(smid[vi][0], smid[vi][1]); w.y = pk2(smid[vi][2], smid[vi][3]); *(LAS u32x2*)(STs + (16 * vi + li) * LHB + (16 * W + 4 * g) * 2) = w; }
        __syncthreads();
        if (c + 1 < nchunk) HG_PREFETCH(c + 1);
        {
            const int tt = W & 3, sh = W >> 2;
            f32x4 a[2] = {{0.f, 0.f, 0.f, 0.f}, {0.f, 0.f, 0.f, 0.f}};
#pragma unroll
            for (int kk = 0; kk < 4; ++kk) { const bf16x8 bq = frag(Qs, 16 * tt + li, LHB, 64 * kk + 16 * g);
#pragma unroll
                for (int i = 0; i < 2; ++i) a[i] = MFMA16(frag(Ks, 16 * (2 * sh + i) + li, LHB, 64 * kk + 16 * g), bq, a[i]); }
            const int t = 16 * tt + li;
#pragma unroll
            for (int i = 0; i < 2; ++i) { float p[4];
#pragma unroll
                for (int r = 0; r < 4; ++r) { const int s = 16 * (2 * sh + i) + 4 * g + r; p[r] = (s <= t) ? a[i][r] : 0.f; }
                u32x2 w; w.x = pk2(p[0], p[1]); w.y = pk2(p[2], p[3]); *(LAS u32x2*)(Ps + t * LVB + (16 * (2 * sh + i) + 4 * g) * 2) = w; }
        }
        __syncthreads();
        {
            const int tt = W & 3, vh = W >> 2;
            f32x4 o[2] = {{0.f, 0.f, 0.f, 0.f}, {0.f, 0.f, 0.f, 0.f}};
#pragma unroll
            for (int kk = 0; kk < 2; ++kk) { const bf16x8 ap = frag(Ps, 16 * tt + li, LVB, 64 * kk + 16 * g);
#pragma unroll
                for (int i = 0; i < 2; ++i) o[i] = MFMA16(ap, frag(VT, 16 * (2 * vh + i) + li, LVB, 64 * kk + 16 * g), o[i]); }
#pragma unroll
            for (int kk = 0; kk < 4; ++kk) { const bf16x8 aq = frag(Qs, 16 * tt + li, LHB, 64 * kk + 16 * g);
#pragma unroll
                for (int i = 0; i < 2; ++i) o[i] = MFMA16(aq, frag(STs, 16 * (2 * vh + i) + li, LHB, 64 * kk + 16 * g), o[i]); }
#pragma unroll
            for (int r = 0; r < 4; ++r) { const int t = 16 * tt + 4 * g + r;
                if (t < Tv) { float* hp = HB + (size_t)(r0 + t) * D + 128 * h + 64 * vs + li; hp[16 * (2 * vh)] = o[0][r]; hp[16 * (2 * vh + 1)] = o[1][r]; } }
        }
#pragma unroll
        for (int vi = 0; vi < 4; ++vi) sacc[vi] = smid[vi];
#pragma unroll
        for (int kk = 0; kk < 2; ++kk) { const bf16x8 ak = frag_t(Ks, 32 * kk + 8 * g, LHB, 16 * W + li);
#pragma unroll
            for (int vi = 0; vi < 4; ++vi) sacc[vi] = MFMA16(ak, frag(VT, 16 * vi + li, LVB, 64 * kk + 16 * g), sacc[vi]); }
#pragma unroll
        for (int vi = 0; vi < 4; ++vi) sacc[vi] = sacc[vi] * e2;
        __syncthreads();
    }
#undef HG_PREFETCH
#pragma unroll
    for (int vi = 0; vi < 4; ++vi)
#pragma unroll
        for (int r = 0; r < 4; ++r) Sout[(size_t)(16 * W + 4 * g + r) * 128 + 64 * vs + 16 * vi + li] = sacc[vi][r];
}

DI void scan_phase(const Ctx& F, int l) {
    const bf16* Z = (const bf16*)(F.ws + WS_Z);
    const bf16* QA = (const bf16*)(F.ws + WS_QA); const bf16* KA = (const bf16*)(F.ws + WS_KA); const bf16* QB = (const bf16*)(F.ws + WS_QB); const bf16* KB = (const bf16*)(F.ws + WS_KB);
    const float* G = (const float*)(F.ws + WS_G); const float* E1 = (const float*)(F.ws + WS_E1); const float* E2 = (const float*)(F.ws + WS_E2);
    float* HA = (float*)(F.ws + WS_HA); float* HB = (float*)(F.ws + WS_HB);
    for (int u = F.bid; u < 768; u += F.G) {
        int type, idx, sample;
        if (u < 128) { type = 0; idx = u; sample = 0; } else if (u < 256) { type = 1; idx = u - 128; sample = 0; }
        else if (u < 384) { type = 1; idx = u - 256; sample = 1; } else if (u < 512) { type = 0; idx = u - 384; sample = 1; }
        else if (u < 640) { type = 1; idx = u - 512 + 128; sample = 1; } else { type = 0; idx = u - 640 + 128; sample = 1; }
        if (type == 0) {
            const int b = idx >> 5, h = (idx >> 2) & 7, vs = idx & 3;
            const size_t so = sample ? (size_t)l * NSB + b : (size_t)l * NB + b;
            const float* C0 = sample ? F.in[3] + (so * 8 + h) * 65536 : nullptr; const float* n0 = sample ? F.in[4] + (so * 8 + h) * 256 : nullptr; const float* m0 = sample ? F.in[5] + so * 8 + h : nullptr;
            float* Co = F.out + (sample ? O_CS : O_CP) + (so * 8 + h) * 65536; float* no = F.out + (sample ? O_NS : O_NP) + (so * 8 + h) * 256; float* mo = F.out + (sample ? O_MS : O_MP) + so * 8 + h;
            mlstm_unit(F.lds, QA, KA, Z, G, HA, sample ? MPR + b * SSEQ : b * SEQ, sample ? 1 : SEQ / 64, sample ? SSEQ : 64, h, vs, C0, n0, m0, Co, no, mo);
        } else {
            const int b = idx >> 5, h = (idx >> 1) & 15, vs = idx & 1;
            const size_t so = sample ? (size_t)l * NSB + b : (size_t)l * NB + b;
            const float* S0 = sample ? F.in[6] + (so * 16 + h) * 16384 : nullptr; float* So = F.out + (sample ? O_SS : O_SP) + (so * 16 + h) * 16384;
            hgrn_unit(F.lds, QB, KB, Z, E1, E2, HB, sample ? MPR + b * SSEQ : b * SEQ, sample ? 1 : SEQ / 64, sample ? SSEQ : 64, h, vs, sample ? NB * 64 + b : b * 64, S0, So);
        }
        __syncthreads();
    }
}

constexpr int NPH_LAYER = 10, NPHASES = 1 + DEPTH * NPH_LAYER + 1;
struct Args { const float* in[26]; float* out; unsigned char* ws; int ph_lo, ph_hi; };
static_assert(sizeof(Args) == 26 * 8 + 8 + 8 + 8, "Args has no padding");

__global__ void __launch_bounds__(512, 2) trunk_fwd(Args args) {
    extern __shared__ __attribute__((aligned(16))) unsigned char lds_raw[];
    Ctx F;
    F.lds = (LAS unsigned char*)lds_raw; F.ws = args.ws; F.in = args.in; F.out = args.out;
    F.tid = threadIdx.x; F.lane = F.tid & 63; F.wave = __builtin_amdgcn_readfirstlane(F.tid >> 6); F.G = gridDim.x; F.bid = blockIdx.x;
    volatile LAS unsigned* MISC = (volatile LAS unsigned*)(F.lds + MISC_OFF);
    if (F.tid < 64) MISC[F.tid] = 0u;
    __syncthreads();
    gu32* ctl = (gu32*)(F.ws + WS_CTL);
#if MK_PER_PHASE
#define GRID_BAR() do { } while (0)
#else
    XcdBarrier bar = xcd_barrier_post((unsigned*)(ctl + CW_BAR), MISC + 8);
#define GRID_BAR() xcd_barrier(bar)
#endif
    const int lo = args.ph_lo, hi = args.ph_hi;
#ifndef PH_MASK
#define PH_MASK 0xFFFFu
#endif
#define IN(k) (lo <= (k) && (k) < hi)
#define EN(j) ((PH_MASK >> (j)) & 1u)
#define BOTH(k) (IN(k) && IN((k) + 1))
    if (EN(10) && IN(0)) { p0_prologue(F); if (BOTH(0)) GRID_BAR(); }
    for (int l = 0; l < DEPTH; ++l) {
        const int pb = 1 + NPH_LAYER * l;
        { int t_ = threadIdx.x; asm volatile("" : "+v"(t_)); F.tid = t_; F.lane = t_ & 63; F.wave = __builtin_amdgcn_readfirstlane(t_ >> 6); }
        unsigned char* wl = F.ws + WS_W + (size_t)l * W_LAYER;
        const float* modl = (const float*)(F.ws + WS_MOD) + (size_t)l * 12 * MODW;
        if (EN(0) && IN(pb + 0)) { norm_phase(F, F.in[11] + (size_t)l * D, modl, 0, D); if (BOTH(pb + 0)) GRID_BAR(); }
        if (EN(1) && IN(pb + 1)) {
            pg8::Gemm gm{(const pg8::bf16_t*)(F.ws + WS_H), (const pg8::bf16_t*)(wl + W_WIN), MP, NINP, D}; pg8::StaticOrder S; S.init(MP, NINP, F.G, F.bid);
            pg8::EpiZ E{(pg8::bf16_t*)(F.ws + WS_Z), (const float*)(F.ws + WS_BIN) + (size_t)l * NINP, (float*)(F.ws + WS_G)};
            pg8::gemm_phase<pg8::EpiZ, pg8::StaticOrder, true, true>(F.lds + RING_OFF, gm, S, E);
            if (BOTH(pb + 1)) GRID_BAR();
        }
        if (EN(2) && IN(pb + 2)) { prep_phase(F, l); if (BOTH(pb + 2)) GRID_BAR(); }
        if (EN(3) && IN(pb + 3)) { scan_phase(F, l); if (BOTH(pb + 3)) GRID_BAR(); }
        if (EN(4) && IN(pb + 4)) { headnorm_phase(F, l); if (BOTH(pb + 4)) GRID_BAR(); }
        if (EN(5) && IN(pb + 5)) {
            { pg8::Gemm gm{(const pg8::bf16_t*)(F.ws + WS_KA), (const pg8::bf16_t*)(wl + W_WBB), MP, D, D}; pg8::StaticOrder S; S.init(MP, D, F.G, F.bid);
              pg8::EpiGateTmp E{(const pg8::bf16_t*)(F.ws + WS_Z) + ZGB, (float*)(F.ws + WS_HA)};
              pg8::gemm_phase<pg8::EpiGateTmp, pg8::StaticOrder, true, true>(F.lds + RING_OFF, gm, S, E); }
            VM_WAIT(); __syncthreads();
            { pg8::Gemm gm{(const pg8::bf16_t*)(F.ws + WS_QA), (const pg8::bf16_t*)(wl + W_WBA), MP, D, D}; pg8::StaticOrder S; S.init(MP, D, F.G, F.bid);
              pg8::EpiMerge E{(const pg8::bf16_t*)(F.ws + WS_Z) + ZGA, (const float*)(F.ws + WS_HA), (pg8::bf16_t*)(F.ws + WS_QB)};
              pg8::gemm_phase<pg8::EpiMerge, pg8::StaticOrder, true, true>(F.lds + RING_OFF, gm, S, E); }
            if (BOTH(pb + 5)) GRID_BAR();
        }
        if (EN(6) && IN(pb + 6)) {
            pg8::Gemm gm{(const pg8::bf16_t*)(F.ws + WS_QB), (const pg8::bf16_t*)(wl + W_WO), MP, D, D}; pg8::StaticOrder S; S.init(MP, D, F.G, F.bid);
            pg8::EpiResid E{(float*)(F.ws + WS_X), modl + 2 * D};
            pg8::gemm_phase<pg8::EpiResid, pg8::StaticOrder, true, true>(F.lds + RING_OFF, gm, S, E);
            if (BOTH(pb + 6)) GRID_BAR();
        }
        if (EN(7) && IN(pb + 7)) { norm_phase(F, F.in[12] + (size_t)l * D, modl, 3 * D, 4 * D); if (BOTH(pb + 7)) GRID_BAR(); }
        if (EN(8) && IN(pb + 8)) {
            pg8::Gemm gm{(const pg8::bf16_t*)(F.ws + WS_H), (const pg8::bf16_t*)(wl + W_WUP), MP, DFF, D}; pg8::StaticOrder S; S.init(MP, DFF, F.G, F.bid);
            pg8::EpiRelu2 E{(pg8::bf16_t*)(F.ws + WS_Z), DFF};
            pg8::gemm_phase<pg8::EpiRelu2, pg8::StaticOrder, true, true>(F.lds + RING_OFF, gm, S, E);
            if (BOTH(pb + 8)) GRID_BAR();
        }
        if (EN(9) && IN(pb + 9)) {
            pg8::Gemm gm{(const pg8::bf16_t*)(F.ws + WS_Z), (const pg8::bf16_t*)(wl + W_WDN), MP, D, DFF}; pg8::StaticOrder S; S.init(MP, D, F.G, F.bid);
            pg8::EpiResid E{(float*)(F.ws + WS_X), modl + 5 * D};
            pg8::gemm_phase<pg8::EpiResid, pg8::StaticOrder, true, true>(F.lds + RING_OFF, gm, S, E);
            if (BOTH(pb + 9)) GRID_BAR();
        }
    }
    if (EN(11) && IN(NPHASES - 1)) final_norm_phase(F);
#undef IN
#undef BOTH
}

extern "C" void kernel_launch(void* const* d_in, const int* in_sizes, int n_in, void* d_out, int out_size, void* d_ws, size_t ws_size, hipStream_t stream) {
    static int grid = 0;
    if (grid == 0) {
        if (n_in != 26 || (size_t)out_size != O_END || ws_size < WS_END) { fprintf(stderr, "kernel_launch: shape mismatch: n_in %d out %d (want %zu) ws %zu (want %zu)\n", n_in, out_size, (size_t)O_END, ws_size, (size_t)WS_END); grid = -1; return; }
        int dev = 0, cus = 0, per_cu = 0;
        if (hipGetDevice(&dev) != hipSuccess || hipDeviceGetAttribute(&cus, hipDeviceAttributeMultiprocessorCount, dev) != hipSuccess) { grid = -1; return; }
        if (hipFuncSetAttribute((const void*)trunk_fwd, hipFuncAttributeMaxDynamicSharedMemorySize, LDS_BYTES) != hipSuccess) { fprintf(stderr, "kernel_launch: hipFuncSetAttribute failed\n"); grid = -1; return; }
        if (hipOccupancyMaxActiveBlocksPerMultiprocessor(&per_cu, (const void*)trunk_fwd, 512, LDS_BYTES) != hipSuccess || per_cu < 1) fprintf(stderr, "kernel_launch: occupancy query says %d\n", per_cu);
        (void)hipGetLastError();
        grid = cus;
    }
    if (grid < 0) return;
    (void)in_sizes;
    if (hipMemsetAsync((char*)d_ws + WS_CTL, 0, CTL_ZERO_BYTES, stream) != hipSuccess) { fprintf(stderr, "kernel_launch: memset failed\n"); return; }
    Args a{};
    for (int i = 0; i < 26; ++i) a.in[i] = (const float*)d_in[i];
    a.out = (float*)d_out; a.ws = (unsigned char*)d_ws;
#if MK_PER_PHASE
    for (int p = 0; p < NPHASES; ++p) { a.ph_lo = p; a.ph_hi = p + 1; hipLaunchKernelGGL(trunk_fwd, dim3(grid), dim3(512), LDS_BYTES, stream, a); }
#else
    a.ph_lo = 0; a.ph_hi = NPHASES;
    hipLaunchKernelGGL(trunk_fwd, dim3(grid), dim3(512), LDS_BYTES, stream, a);
#endif
    const hipError_t le = hipPeekAtLastError();
    if (le != hipSuccess) fprintf(stderr, "kernel_launch: launch failed: %s\n", hipGetErrorName(le));
}
```

```cpp
#include <hip/hip_runtime.h>
#include <cstdio>
#include <cstdint>
#ifndef MK_PER_PHASE
#define MK_PER_PHASE 0
#endif
namespace pg8 {
#define PG8_LAS __attribute__((address_space(3)))
typedef unsigned short bf16_t;
typedef short bf16x8 __attribute__((ext_vector_type(8)));
typedef float f32x4 __attribute__((ext_vector_type(4)));
typedef unsigned u32x4 __attribute__((ext_vector_type(4)));
constexpr int BM = 256, BK = 64, HALF = 128, HTB = HALF * BK * 2  , STAGE_BYTES = 8 * HTB, NXCD = 8, WGM = 8;

__host__ __device__ __forceinline__ int lds_byte(int r, int c) { const int st = (r >> 4) * 2 + (c >> 5), rr = r & 15, cc = c & 31, ob = rr * 64 + cc * 2; return st * 1024 + (ob ^ (((ob >> 9) & 1) << 5)); }
__host__ __device__ __forceinline__ void stage_rc(int b, int& R, int& C) { const int st = b / 1024, sb = b % 1024, swz = sb ^ (((sb >> 9) & 1) << 5); R = (st >> 1) * 16 + swz / 64; C = (st & 1) * 32 + (swz % 64) / 2; }
__host__ __device__ __forceinline__ int perm32(int rho) { const int n = rho >> 4, i = rho & 15; return 8 * (i >> 2) + 4 * n + (i & 3); }

struct Unit { int pm, pn; };
struct Gemm { const bf16_t* A; const bf16_t* Bt; int M, N, K; };

struct StaticOrder {
    int nM, nN, nwg, G, c;
    __host__ __device__ void init(int M, int N, int G_, int c_) { nM = M / BM; nN = N / BM; nwg = nM * nN; G = G_; c = c_; }
    __host__ __device__ bool next(int i, Unit& u) const {
        const long L = (long)i * G + c; if (L >= nwg) return false;
        int wgid = (int)L; { const int q = nwg / NXCD, r = nwg % NXCD, xcd = wgid % NXCD, off = wgid / NXCD; wgid = (xcd < r ? xcd * (q + 1) : r * (q + 1) + (xcd - r) * q) + off; }
        const int nig = WGM * nN, gid = wgid / nig, fm = gid * WGM, gsz = (nM - fm) < WGM ? (nM - fm) : WGM;
        u.pm = fm + ((wgid % nig) % gsz); u.pn = (wgid % nig) / gsz; return true;
    }
    __device__ __forceinline__ void a_ready(const Unit&) const {}
    __device__ __forceinline__ void done(const Unit&) const {}
};

__device__ __forceinline__ unsigned cvt_pk_bf16(float lo, float hi) { unsigned r; asm volatile("v_cvt_pk_bf16_f32 %0, %1, %2" : "=v"(r) : "v"(lo), "v"(hi)); return r; }
typedef float f32x2 __attribute__((ext_vector_type(2)));
template <class Epi, class Sched, bool ALIGN_EPI = false, bool SP2 = false>
__device__ __forceinline__ void gemm_phase(PG8_LAS unsigned char* lds, const Gemm g, const Sched& S, const Epi& E) {
    int tid_ = threadIdx.x; asm volatile("" : "+v"(tid_));
    const int tid = tid_, wid = __builtin_amdgcn_readfirstlane(tid >> 6), lane = tid & 63, wr = wid >> 2, wc = wid & 3, fr = lane & 15, fq = lane >> 4;
    const int K = g.K, nt = K / BK;
    unsigned voffA[2], voffB[2];
#pragma unroll
    for (int i = 0; i < 2; ++i) { int R, C; stage_rc(tid * 16 + i * 8192, R, C); const int Rb = Epi::PERM ? ((R & ~31) + perm32(R & 31)) : R;
        voffA[i] = (unsigned)(R * K + C) * 2u; voffB[i] = (unsigned)(Rb * K + C) * 2u; }
    const size_t kstep = (size_t)(BK * 2);
    const size_t hstep = (size_t)HALF * K * 2;
    const size_t tstep = 2 * hstep;
    const unsigned ldsw = (unsigned)wid * 1024u;
    const int aoff = lds_byte(wr * 64 + fr, fq * 8), boff = lds_byte(wc * 32 + fr, fq * 8);
#define PG8_SA(b, h) (((b) * 2 + (h)) * HTB)
#define PG8_SB(b, h) ((4 + (b) * 2 + (h)) * HTB)
#define PG8_STAGE(bufoff, gbase, voff) do { _Pragma("unroll") for (int _i = 0; _i < 2; ++_i) \
        __builtin_amdgcn_global_load_lds((const unsigned*)((const char*)(gbase) + (voff)[_i]), (PG8_LAS unsigned*)(lds + (bufoff) + ldsw + _i * 8192), 16, 0, 0); } while (0)
#define PG8_LDA(dst, b, h) do { _Pragma("unroll") for (int m = 0; m < 4; ++m) _Pragma("unroll") for (int k = 0; k < 2; ++k) dst[m][k] = *(const PG8_LAS bf16x8*)(lds + PG8_SA(b, h) + aoff + m * 2048 + k * 1024); } while (0)
#define PG8_LDB(dst, b, h) do { _Pragma("unroll") for (int n = 0; n < 2; ++n) _Pragma("unroll") for (int k = 0; k < 2; ++k) dst[n][k] = *(const PG8_LAS bf16x8*)(lds + PG8_SB(b, h) + boff + n * 2048 + k * 1024); } while (0)
#define PG8_MMA(ai, bj, At, Bt) do { __builtin_amdgcn_s_setprio(1); _Pragma("unroll") for (int m = 0; m < 4; ++m) _Pragma("unroll") for (int n = 0; n < 2; ++n) _Pragma("unroll") for (int k = 0; k < 2; ++k) \
        acc[ai][bj][m][n] = __builtin_amdgcn_mfma_f32_16x16x32_bf16(Bt[n][k], At[m][k], acc[ai][bj][m][n], 0, 0, 0); __builtin_amdgcn_s_setprio(0); } while (0)
#define PG8_WAIT_V(n) asm volatile("s_waitcnt vmcnt(" #n ")" ::: "memory")
#define PG8_WAIT_L(n) asm volatile("s_waitcnt lgkmcnt(" #n ")" ::: "memory")
#define PG8_BAR __builtin_amdgcn_s_barrier()
#define PG8_SCHED __builtin_amdgcn_sched_barrier(0)
    Unit cur, nxt; int ui = 0;
    if (!S.next(0, cur)) return;
    f32x4 acc[2][2][4][2];
#pragma unroll
    for (int a = 0; a < 2; ++a)
#pragma unroll
        for (int b = 0; b < 2; ++b)
#pragma unroll
            for (int m = 0; m < 4; ++m)
#pragma unroll
                for (int n = 0; n < 2; ++n) acc[a][b][m][n] = (f32x4){0.f, 0.f, 0.f, 0.f};
    bf16x8 At[4][2], B0[2][2], B1[2][2];
    const char* cA = (const char*)g.A + (size_t)cur.pm * tstep; const char* cB = (const char*)g.Bt + (size_t)cur.pn * tstep;
    S.a_ready(cur);
    if constexpr (SP2) {
        PG8_STAGE(PG8_SB(0, 0), cB, voffB); PG8_STAGE(PG8_SB(0, 1), cB + hstep, voffB); PG8_STAGE(PG8_SA(0, 0), cA, voffA); PG8_STAGE(PG8_SA(0, 1), cA + hstep, voffA);
        if (wr == 1) PG8_BAR;
        PG8_WAIT_V(2); PG8_BAR;
        PG8_STAGE(PG8_SB(1, 0), cB + kstep, voffB); PG8_STAGE(PG8_SA(1, 0), cA + kstep, voffA); PG8_STAGE(PG8_SB(1, 1), cB + hstep + kstep, voffB);
        PG8_WAIT_V(6); PG8_BAR;
    } else {
        PG8_STAGE(PG8_SB(0, 0), cB, voffB); PG8_STAGE(PG8_SA(0, 0), cA, voffA); PG8_STAGE(PG8_SB(0, 1), cB + hstep, voffB); PG8_STAGE(PG8_SA(0, 1), cA + hstep, voffA);
        if (wr == 1) PG8_BAR;
        PG8_WAIT_V(4); PG8_BAR;
        PG8_STAGE(PG8_SB(1, 0), cB + kstep, voffB); PG8_STAGE(PG8_SA(1, 0), cA + kstep, voffA); PG8_STAGE(PG8_SB(1, 1), cB + hstep + kstep, voffB);
        PG8_WAIT_V(6); PG8_BAR;
    }
    for (;;) {
        const bool has_next = S.next(ui + 1, nxt);
        const char* nA = has_next ? (const char*)g.A + (size_t)nxt.pm * tstep : cA; const char* nB = has_next ? (const char*)g.Bt + (size_t)nxt.pn * tstep : cB;
        for (int t = 0; t < nt; t += 2) {
            const bool last = (t == nt - 2);
            const char* a1 = cA + (size_t)(t + 1) * kstep;
            const char* a2 = last ? nA : cA + (size_t)(t + 2) * kstep; const char* b2 = last ? nB : cB + (size_t)(t + 2) * kstep;
            const char* a3 = a2 + kstep; const char* b3 = b2 + kstep;
            if (last && has_next) S.a_ready(nxt);
            if constexpr (SP2) {
            PG8_LDB(B0, 0, 0); PG8_LDB(B1, 0, 1); PG8_SCHED; PG8_LDA(At, 0, 0); PG8_STAGE(PG8_SA(1, 1), a1 + hstep, voffA);
            PG8_WAIT_V(8); PG8_WAIT_L(0); PG8_BAR; PG8_MMA(0, 0, At, B0); PG8_MMA(0, 1, At, B1); PG8_BAR; PG8_SCHED;
            PG8_LDA(At, 0, 1); PG8_STAGE(PG8_SB(0, 0), b2, voffB); PG8_STAGE(PG8_SB(0, 1), b2 + hstep, voffB); PG8_STAGE(PG8_SA(0, 0), a2, voffA);
            PG8_WAIT_V(8); PG8_WAIT_L(0); PG8_BAR; PG8_MMA(1, 0, At, B0); PG8_MMA(1, 1, At, B1); PG8_BAR; PG8_SCHED;
            PG8_LDB(B0, 1, 0); PG8_LDB(B1, 1, 1); PG8_SCHED; PG8_LDA(At, 1, 0); PG8_STAGE(PG8_SA(0, 1), a2 + hstep, voffA);
            PG8_WAIT_V(8); PG8_WAIT_L(0); PG8_BAR; PG8_MMA(0, 0, At, B0); PG8_MMA(0, 1, At, B1); PG8_BAR; PG8_SCHED;
            PG8_LDA(At, 1, 1); PG8_STAGE(PG8_SB(1, 0), b3, voffB); PG8_STAGE(PG8_SB(1, 1), b3 + hstep, voffB); PG8_STAGE(PG8_SA(1, 0), a3, voffA);
            PG8_WAIT_V(8); PG8_WAIT_L(0); PG8_BAR; PG8_MMA(1, 0, At, B0); PG8_MMA(1, 1, At, B1); PG8_BAR; PG8_SCHED;
            } else {
            PG8_LDB(B0, 0, 0); PG8_SCHED; PG8_LDA(At, 0, 0); PG8_STAGE(PG8_SA(1, 1), a1 + hstep, voffA);
            PG8_WAIT_L(8); PG8_BAR; PG8_WAIT_L(0); PG8_MMA(0, 0, At, B0); PG8_BAR; PG8_SCHED;
            PG8_LDB(B1, 0, 1); PG8_STAGE(PG8_SB(0, 0), b2, voffB);
            PG8_BAR; PG8_WAIT_L(0); PG8_MMA(0, 1, At, B1); PG8_BAR;
            PG8_LDA(At, 0, 1); PG8_STAGE(PG8_SA(0, 0), a2, voffA);
            PG8_BAR; PG8_WAIT_L(0); PG8_MMA(1, 0, At, B0); PG8_BAR; PG8_SCHED;
            PG8_STAGE(PG8_SB(0, 1), b2 + hstep, voffB);
            PG8_WAIT_V(6); PG8_BAR; PG8_MMA(1, 1, At, B1); PG8_BAR;
            PG8_LDB(B0, 1, 0); PG8_SCHED; PG8_LDA(At, 1, 0); PG8_STAGE(PG8_SA(0, 1), a2 + hstep, voffA);
            PG8_WAIT_L(8); PG8_BAR; PG8_WAIT_L(0); PG8_MMA(0, 0, At, B0); PG8_BAR; PG8_SCHED;
            PG8_LDB(B1, 1, 1); PG8_STAGE(PG8_SB(1, 0), b3, voffB);
            PG8_BAR; PG8_WAIT_L(0); PG8_MMA(0, 1, At, B1); PG8_BAR;
            PG8_LDA(At, 1, 1); PG8_STAGE(PG8_SA(1, 0), a3, voffA);
            PG8_BAR; PG8_WAIT_L(0); PG8_MMA(1, 0, At, B0); PG8_BAR; PG8_SCHED;
            PG8_STAGE(PG8_SB(1, 1), b3 + hstep, voffB);
            PG8_WAIT_V(6); PG8_BAR; PG8_MMA(1, 1, At, B1); PG8_BAR;
            }
        }
        if constexpr (ALIGN_EPI) { if (wr == 0) PG8_BAR; }
        if constexpr (!Epi::AFTER_DRAIN) { E(acc, cur, wr, wc, fr, fq); S.done(cur); }
        if (!has_next) break;
#pragma unroll
        for (int a = 0; a < 2; ++a)
#pragma unroll
            for (int b = 0; b < 2; ++b)
#pragma unroll
                for (int m = 0; m < 4; ++m)
#pragma unroll
                    for (int n = 0; n < 2; ++n) acc[a][b][m][n] = (f32x4){0.f, 0.f, 0.f, 0.f};
        cur = nxt; cA = nA; cB = nB; ++ui;
        if constexpr (ALIGN_EPI) { if (wr == 1) PG8_BAR; }
    }
    PG8_WAIT_V(0);
    if constexpr (!ALIGN_EPI) { if (wr == 0) PG8_BAR; }
    PG8_BAR;
    if constexpr (Epi::AFTER_DRAIN) { E.fused(acc, cur, wr, wc, fr, fq, lds, wid, lane); S.done(cur); }
#undef PG8_SA
#undef PG8_SB
#undef PG8_STAGE
#undef PG8_LDA
#undef PG8_LDB
#undef PG8_MMA
#undef PG8_WAIT_V
#undef PG8_WAIT_L
#undef PG8_BAR
#undef PG8_SCHED
}
}

constexpr int D = 2048, NB = 4, SEQ = 4096, DEPTH = 4, NSB = 8, SSEQ = 16;
constexpr int MPR = NB * SEQ;
constexpr int MS = NSB * SSEQ;
constexpr int M = MPR + MS;
constexpr int MP = 16640;
constexpr int NIN = 20496, NINP = 20736;
constexpr int DFF = 8192;
constexpr int ZQK = 0, ZVA = 4096, ZOA = 6144, ZQB = 8192, ZFB = 10240, ZIB = 12288, ZOGB = 14336, ZGA = 16384, ZGB = 18432, ZGT = 20480;
constexpr int MODW = 6 * D;
constexpr float EPS = 1e-6f;
constexpr int NCHUNKS = NB * (SEQ / 64) + NSB;

__device__ __forceinline__ int row_batch(int r) { int b = r < MPR ? (r >> 12) : 4 + ((r - MPR) >> 4); return b > 11 ? 11 : b; }
__device__ __forceinline__ float bf2f(unsigned short b) { return __uint_as_float(((unsigned)b) << 16); }
__device__ __forceinline__ float sigm(float x) { return 1.0f / (1.0f + __expf(-x)); }

namespace pg8 {
__device__ __forceinline__ void unpack8(const u32x4 w, float (&f)[8]) {
    f[0] = __uint_as_float(w.x << 16); f[1] = __uint_as_float(w.x & 0xffff0000u); f[2] = __uint_as_float(w.y << 16); f[3] = __uint_as_float(w.y & 0xffff0000u);
    f[4] = __uint_as_float(w.z << 16); f[5] = __uint_as_float(w.z & 0xffff0000u); f[6] = __uint_as_float(w.w << 16); f[7] = __uint_as_float(w.w & 0xffff0000u);
}
struct EpiZ {
    static constexpr bool PERM = true, AFTER_DRAIN = false;
    bf16_t* Z; const float* bias; float* G;
    __device__ __forceinline__ void operator()(const f32x4 (&acc)[2][2][4][2], const Unit& u, int wr, int wc, int fr, int fq) const {
        const int row0 = u.pm * BM + wr * 64 + fr, col0 = u.pn * BM + wc * 32 + 8 * fq;
        f32x4 bv[2][2];
#pragma unroll
        for (int bj = 0; bj < 2; ++bj)
#pragma unroll
            for (int n = 0; n < 2; ++n) bv[bj][n] = *(const f32x4*)(bias + col0 + bj * HALF + 4 * n);
        const bool gates = (u.pn == 80) && (wc == 0) && (fq < 2);
#pragma unroll
        for (int ai = 0; ai < 2; ++ai)
#pragma unroll
            for (int m = 0; m < 4; ++m) { const int row = row0 + ai * HALF + m * 16; bf16_t* rowp = Z + (size_t)row * NINP + col0;
#pragma unroll
                for (int bj = 0; bj < 2; ++bj) { const f32x4 v0 = acc[ai][bj][m][0] + bv[bj][0], v1 = acc[ai][bj][m][1] + bv[bj][1];
                    u32x4 w; w.x = cvt_pk_bf16(v0[0], v0[1]); w.y = cvt_pk_bf16(v0[2], v0[3]); w.z = cvt_pk_bf16(v1[0], v1[1]); w.w = cvt_pk_bf16(v1[2], v1[3]);
                    *(u32x4*)(rowp + bj * HALF) = w;
                    if (bj == 0 && gates) { float* gp = G + (size_t)row * 16 + 8 * fq; *(f32x4*)gp = v0; *(f32x4*)(gp + 4) = v1; } } }
    }
};
struct EpiGateTmp {
    static constexpr bool PERM = true, AFTER_DRAIN = false;
    const bf16_t* Zg; float* T;
    __device__ __forceinline__ void operator()(const f32x4 (&acc)[2][2][4][2], const Unit& u, int wr, int wc, int fr, int fq) const {
        const int row0 = u.pm * BM + wr * 64 + fr, col0 = u.pn * BM + wc * 32 + 8 * fq;
#pragma unroll
        for (int ai = 0; ai < 2; ++ai)
#pragma unroll
            for (int m = 0; m < 4; ++m) { const int row = row0 + ai * HALF + m * 16;
#pragma unroll
                for (int bj = 0; bj < 2; ++bj) { const int c = col0 + bj * HALF; float gz[8]; unpack8(*(const u32x4*)(Zg + (size_t)row * NINP + c), gz);
                    f32x4 v0 = acc[ai][bj][m][0], v1 = acc[ai][bj][m][1];
#pragma unroll
                    for (int j = 0; j < 4; ++j) { v0[j] *= sigm(gz[j]); v1[j] *= sigm(gz[4 + j]); }
                    float* tp = T + (size_t)row * D + c; *(f32x4*)tp = v0; *(f32x4*)(tp + 4) = v1; } }
    }
};
struct EpiMerge {
    static constexpr bool PERM = true, AFTER_DRAIN = false;
    const bf16_t* Zg; const float* T; bf16_t* O;
    __device__ __forceinline__ void operator()(const f32x4 (&acc)[2][2][4][2], const Unit& u, int wr, int wc, int fr, int fq) const {
        const int row0 = u.pm * BM + wr * 64 + fr, col0 = u.pn * BM + wc * 32 + 8 * fq;
#pragma unroll
        for (int ai = 0; ai < 2; ++ai)
#pragma unroll
            for (int m = 0; m < 4; ++m) { const int row = row0 + ai * HALF + m * 16;
#pragma unroll
                for (int bj = 0; bj < 2; ++bj) { const int c = col0 + bj * HALF; float gz[8]; unpack8(*(const u32x4*)(Zg + (size_t)row * NINP + c), gz);
                    const float* tp = T + (size_t)row * D + c; f32x4 v0 = *(const f32x4*)tp, v1 = *(const f32x4*)(tp + 4);
#pragma unroll
                    for (int j = 0; j < 4; ++j) { v0[j] += acc[ai][bj][m][0][j] * sigm(gz[j]); v1[j] += acc[ai][bj][m][1][j] * sigm(gz[4 + j]); }
                    u32x4 w; w.x = cvt_pk_bf16(v0[0], v0[1]); w.y = cvt_pk_bf16(v0[2], v0[3]); w.z = cvt_pk_bf16(v1[0], v1[1]); w.w = cvt_pk_bf16(v1[2], v1[3]);
                    *(u32x4*)(O + (size_t)row * D + c) = w; } }
    }
};
struct EpiResid {
    static constexpr bool PERM = false, AFTER_DRAIN = false;
    float* X; const float* gate;
    __device__ __forceinline__ void operator()(const f32x4 (&acc)[2][2][4][2], const Unit& u, int wr, int wc, int fr, int fq) const {
        const int row0 = u.pm * BM + wr * 64 + fr, col0 = u.pn * BM + wc * 32 + 4 * fq;
#pragma unroll
        for (int ai = 0; ai < 2; ++ai)
#pragma unroll
            for (int m = 0; m < 4; ++m) { const int row = row0 + ai * HALF + m * 16; const float* gp = gate + (size_t)row_batch(row) * MODW + col0; float* xp = X + (size_t)row * D + col0;
#pragma unroll
                for (int bj = 0; bj < 2; ++bj)
#pragma unroll
                    for (int n = 0; n < 2; ++n) { const int o = bj * HALF + n * 16; const f32x4 gv = *(const f32x4*)(gp + o), xv = *(const f32x4*)(xp + o); *(f32x4*)(xp + o) = xv + gv * acc[ai][bj][m][n]; }
                asm volatile("" ::: "memory"); }
    }
};
struct EpiRelu2 {
    static constexpr bool PERM = true, AFTER_DRAIN = false;
    bf16_t* O; int ldc;
    __device__ __forceinline__ void operator()(const f32x4 (&acc)[2][2][4][2], const Unit& u, int wr, int wc, int fr, int fq) const {
        const int row0 = u.pm * BM + wr * 64 + fr, col0 = u.pn * BM + wc * 32 + 8 * fq;
#pragma unroll
        for (int ai = 0; ai < 2; ++ai)
#pragma unroll
            for (int m = 0; m < 4; ++m) { bf16_t* rowp = O + (size_t)(row0 + ai * HALF + m * 16) * ldc + col0;
#pragma unroll
                for (int bj = 0; bj < 2; ++bj) { f32x4 v0 = acc[ai][bj][m][0], v1 = acc[ai][bj][m][1];
#pragma unroll
                    for (int j = 0; j < 4; ++j) { const float a = fmaxf(v0[j], 0.f), b = fmaxf(v1[j], 0.f); v0[j] = a * a; v1[j] = b * b; }
                    u32x4 w; w.x = cvt_pk_bf16(v0[0], v0[1]); w.y = cvt_pk_bf16(v0[2], v0[3]); w.z = cvt_pk_bf16(v1[0], v1[1]); w.w = cvt_pk_bf16(v1[2], v1[3]);
                    *(u32x4*)(rowp + bj * HALF) = w; } }
    }
};
}

constexpr size_t MiB = 1u << 20;
constexpr size_t WS_CTL = 0, CTL_ZERO_BYTES = 1 * MiB;
constexpr size_t WS_MOD = 1 * MiB;
constexpr size_t WS_LB = 4 * MiB;
constexpr size_t WS_BIN = 4 * MiB + 65536;
constexpr size_t WS_E1 = 5 * MiB, WS_E2 = 8 * MiB;
constexpr size_t WS_G = 11 * MiB;
constexpr size_t WS_W = 16 * MiB;
constexpr size_t W_WIN = 0, W_WBA = 81 * MiB, W_WBB = 89 * MiB, W_WO = 97 * MiB, W_WUP = 105 * MiB, W_WDN = 137 * MiB, W_LAYER = 169 * MiB;
constexpr size_t WS_X = 692 * MiB;
constexpr size_t WS_H = 822 * MiB;
constexpr size_t WS_Z = 887 * MiB;
constexpr size_t WS_QA = 1546 * MiB;
constexpr size_t WS_KA = 1611 * MiB;
constexpr size_t WS_QB = 1676 * MiB;
constexpr size_t WS_KB = 1741 * MiB;
constexpr size_t WS_HA = 1806 * MiB;
constexpr size_t WS_HB = 1936 * MiB;
constexpr size_t WS_END = 2066 * MiB;
static_assert((size_t)NINP * D * 2 <= 81 * MiB && (size_t)MP * NINP * 2 <= (WS_QA - WS_Z) && (size_t)MP * D * 2 == 65 * MiB && WS_W + 4 * W_LAYER <= WS_X, "ws map");
constexpr int CW_BAR = 4096;

constexpr size_t O_YP = 0, O_YS = O_YP + (size_t)MPR * D, O_CONVP = O_YS + (size_t)MS * D, O_CP = O_CONVP + (size_t)DEPTH * NB * 3 * 4096,
    O_NP = O_CP + (size_t)DEPTH * NB * 8 * 65536, O_MP = O_NP + (size_t)DEPTH * NB * 8 * 256, O_SP = O_MP + (size_t)DEPTH * NB * 8,
    O_CONVS = O_SP + (size_t)DEPTH * NB * 16 * 16384, O_CS = O_CONVS + (size_t)DEPTH * NSB * 3 * 4096, O_NS = O_CS + (size_t)DEPTH * NSB * 8 * 65536,
    O_MS = O_NS + (size_t)DEPTH * NSB * 8 * 256, O_SS = O_MS + (size_t)DEPTH * NSB * 8, O_END = O_SS + (size_t)DEPTH * NSB * 16 * 16384;

constexpr int RING_OFF = 0, RING_BYTES = 131072;
constexpr int LDS_BYTES = 155648;
constexpr int MISC_OFF = LDS_BYTES - 256;
constexpr int SC_Q = 0, SC_K = 33792, SC_VT = 67584, SC_VW = 79104, SC_CT = 90624, SC_P = 132864, SC_H = 142080, SC_END = 151296;
constexpr int LQB = 528;
constexpr int LVB = 144;
constexpr int HS_Q = 0, HS_K = 17408, HS_VT = 34816, HS_ST = 44032, HS_P = 61440, HS_H = 70656;
constexpr int LHB = 272;
static_assert(SC_END <= MISC_OFF, "LDS map");

#define GAS __attribute__((address_space(1)))
#define LAS __attribute__((address_space(3)))
#define DI __device__ __forceinline__
typedef unsigned short bf16;
typedef float f32x4 __attribute__((ext_vector_type(4)));
typedef unsigned u32x2 __attribute__((ext_vector_type(2)));
typedef unsigned u32x4 __attribute__((ext_vector_type(4)));
typedef short bf16x8 __attribute__((ext_vector_type(8)));
typedef GAS unsigned gu32;
#define RLX_AGENT __ATOMIC_RELAXED, __HIP_MEMORY_SCOPE_AGENT
#define LDS_WAIT() asm volatile("s_waitcnt lgkmcnt(0)" ::: "memory")
#define VM_WAIT() asm volatile("s_waitcnt vmcnt(0)" ::: "memory")
DI unsigned f2bf(float f) { unsigned u = __float_as_uint(f); return (u + 0x7fffu + ((u >> 16) & 1u)) >> 16; }
DI unsigned pk2(float lo, float hi) { return f2bf(lo) | (f2bf(hi) << 16); }
DI float wave_sum(float v) {
#pragma unroll
    for (int o = 1; o < 64; o <<= 1) v += __shfl_xor(v, o);
    return v;
}
DI float logsig(float x) { return fminf(x, 0.f) - __logf(1.0f + __expf(-fabsf(x))); }
#define XB_TMO      128
#define XB_XCNT(j)  (256  + 64 * (j))
#define XB_XSUB(j)  (1280 + 64 * (j))
#define XB_XGEN(j)  (2304 + 64 * (j))
#define XB_TOP      3328
#define XB_TOPGEN   3392
#define XCD_BAR_WORDS 3456
#define XB_SPIN_CAP (1u << 18)

__device__ __forceinline__ unsigned xb_ld(unsigned* p)              { return __hip_atomic_load(p, __ATOMIC_RELAXED, __HIP_MEMORY_SCOPE_AGENT); }
__device__ __forceinline__ unsigned xb_add(unsigned* p, unsigned v) { return __hip_atomic_fetch_add(p, v, __ATOMIC_RELAXED, __HIP_MEMORY_SCOPE_AGENT); }
__device__ __forceinline__ unsigned xb_xcc_id() { return (unsigned)__builtin_amdgcn_s_getreg((3 << 11) | 20) & 0xFu; }
#define XB_SPIN(cond, bar) do { unsigned _sp = 0; while (cond) { __builtin_amdgcn_s_sleep(1); \
    if ((++_sp & 255u) == 0u) { if (xb_ld(&(bar)[XB_TMO])) break; if (_sp > XB_SPIN_CAP) { atomicAdd(&(bar)[XB_TMO], 1u); break; } } } } while (0)

struct XcdBarrier {
    unsigned* bar; unsigned x;
    volatile LAS unsigned* st;
};

__device__ __forceinline__ XcdBarrier xcd_barrier_post(unsigned* bar, volatile LAS unsigned* st) {
    XcdBarrier b; b.bar = bar; b.x = xb_xcc_id(); b.st = st;
    if (threadIdx.x == 0) (void)xb_add(&bar[XB_XCNT(b.x)], 1u);
    return b;
}
__device__ __forceinline__ void xcd_barrier_complete(unsigned* bar, unsigned x, unsigned& nloc, unsigned& nx) {
    const unsigned G = gridDim.x * gridDim.y * gridDim.z;
    unsigned sum, cnt, mine, sp = 0u;
    for (;;) {
        sum = 0u; cnt = 0u; mine = 0u;
#pragma unroll
        for (unsigned j = 0; j < 16; ++j) { const unsigned c = xb_ld(&bar[XB_XCNT(j)]); sum += c; cnt += (c > 0u) ? 1u : 0u; mine = (j == x) ? c : mine; }
        if (sum == G) break;
        __builtin_amdgcn_s_sleep(1);
        if ((++sp & 255u) == 0u) { if (xb_ld(&bar[XB_TMO])) break; if (sp > XB_SPIN_CAP) { atomicAdd(&bar[XB_TMO], 1u); break; } }
    }
    nloc = mine > 0u ? mine : 1u; nx = cnt > 0u ? cnt : 1u;
}

__device__ __forceinline__ void xcd_barrier(const XcdBarrier& b) {
    asm volatile("s_waitcnt vmcnt(0)" ::: "memory");
    __syncthreads();
    if (threadIdx.x == 0) {
        unsigned* bar = b.bar;
        __builtin_amdgcn_s_waitcnt(0);
        unsigned nloc = b.st[0], nx = b.st[1];
        if (nloc == 0u) { xcd_barrier_complete(bar, b.x, nloc, nx); b.st[0] = nloc; b.st[1] = nx; }
        const unsigned old = xb_add(&bar[XB_XSUB(b.x)], 1u);
        const unsigned gen = old / nloc;
        if (old + 1u == (gen + 1u) * nloc) {
            __builtin_amdgcn_fence(__ATOMIC_RELEASE, "agent");
            asm volatile("s_waitcnt vmcnt(0)" ::: "memory");
            const unsigned og = xb_add(&bar[XB_TOP], 1u);
            const unsigned tg = og / nx;
            if (og + 1u == (tg + 1u) * nx) xb_add(&bar[XB_TOPGEN], 1u);
            else XB_SPIN(xb_ld(&bar[XB_TOPGEN]) == tg, bar);
            __builtin_amdgcn_fence(__ATOMIC_ACQUIRE, "agent");
            xb_add(&bar[XB_XGEN(b.x)], 1u);
            asm volatile("s_waitcnt vmcnt(0)" ::: "memory");
        } else {
            XB_SPIN(xb_ld(&bar[XB_XGEN(b.x)]) == gen, bar);
            __builtin_amdgcn_fence(__ATOMIC_ACQUIRE, "agent");
            asm volatile("s_waitcnt vmcnt(0)" ::: "memory");
        }
    }
    __syncthreads();
}

struct Ctx { LAS unsigned char* lds; unsigned char* ws; const float* const* in; float* out; int tid, lane, wave, G, bid; };

DI void p0_transpose_item(const float* W, int K, int Nsrc, int Npad, bf16* WT, LAS float* scr, int item, int lane) {
    const int nblk = Npad / 64, kb = item / nblk, nb = item % nblk, k0 = 64 * kb, n0 = 64 * nb;
    const int nq = lane & 15, kr = lane >> 4; const int n = n0 + 4 * nq; const bool ok = n < Nsrc;
    f32x4 v[16];
#pragma unroll
    for (int i = 0; i < 16; ++i) v[i] = ok ? *(const GAS f32x4*)(W + (size_t)(k0 + 4 * i + kr) * Nsrc + n) : (f32x4){0.f, 0.f, 0.f, 0.f};
#pragma unroll
    for (int i = 0; i < 16; ++i) { LAS float* s = scr + (4 * i + kr) * 65 + 4 * nq; s[0] = v[i].x; s[1] = v[i].y; s[2] = v[i].z; s[3] = v[i].w; }
    LDS_WAIT(); asm volatile("" ::: "memory");
#pragma unroll
    for (int j = 0; j < 8; ++j) { const int pr = lane + 64 * j, nn = pr >> 3, c = pr & 7; const LAS float* s = scr + (8 * c) * 65 + nn;
        u32x4 o; o.x = pk2(s[0 * 65], s[1 * 65]); o.y = pk2(s[2 * 65], s[3 * 65]); o.z = pk2(s[4 * 65], s[5 * 65]); o.w = pk2(s[6 * 65], s[7 * 65]);
        *(GAS u32x4*)(WT + (size_t)(n0 + nn) * K + k0 + 8 * c) = o; }
    LDS_WAIT(); asm volatile("" ::: "memory");
}

DI void p0_prologue(const Ctx& F) {
    const float* const* in = F.in;
    const int gw = F.bid * 8 + F.wave, NGW = F.G * 8;
    const int gt = F.bid * 512 + F.tid, NGT = F.G * 512;
    {
        LAS float* scr = (LAS float*)(F.lds + F.wave * 16640);
        constexpr int I0 = 32 * (NINP / 64), I1 = 32 * 32, I4 = 32 * 128, I5 = 128 * 32, IL = I0 + 3 * I1 + I4 + I5;
        for (int it = gw; it < DEPTH * IL; it += NGW) {
            const int l = it / IL; int r = it % IL;
            unsigned char* wl = F.ws + WS_W + (size_t)l * W_LAYER;
            if (r < I0) { p0_transpose_item(in[13] + (size_t)l * D * NIN, D, NIN, NINP, (bf16*)(wl + W_WIN), scr, r, F.lane); continue; } r -= I0;
            if (r < I1) { p0_transpose_item(in[20] + (size_t)l * D * D, D, D, D, (bf16*)(wl + W_WBA), scr, r, F.lane); continue; } r -= I1;
            if (r < I1) { p0_transpose_item(in[21] + (size_t)l * D * D, D, D, D, (bf16*)(wl + W_WBB), scr, r, F.lane); continue; } r -= I1;
            if (r < I1) { p0_transpose_item(in[22] + (size_t)l * D * D, D, D, D, (bf16*)(wl + W_WO), scr, r, F.lane); continue; } r -= I1;
            if (r < I4) { p0_transpose_item(in[23] + (size_t)l * D * DFF, D, DFF, DFF, (bf16*)(wl + W_WUP), scr, r, F.lane); continue; } r -= I4;
            p0_transpose_item(in[24] + (size_t)l * DFF * D, DFF, D, D, (bf16*)(wl + W_WDN), scr, r, F.lane);
        }
    }
    __syncthreads();
    {
        LAS float* csT = (LAS float*)F.lds;
        LAS float* red = (LAS float*)(F.lds + 98304);
        for (int i = F.tid; i < 12 * D; i += 512) { const int r = i / D, k = i % D; const float c = r < 4 ? in[7][r * D + k] : in[8][(r - 4) * D + k]; csT[k * 12 + r] = c * sigm(c); }
        __syncthreads();
        float* MOD = (float*)(F.ws + WS_MOD);
        for (int u = F.bid; u < DEPTH * (MODW / 64); u += F.G) {
            const int l = u / (MODW / 64), j = (u % (MODW / 64)) * 64 + F.lane;
            const float* wp = in[9] + (size_t)l * D * MODW + (size_t)(256 * F.wave) * MODW + j;
            float acc[12];
#pragma unroll
            for (int r = 0; r < 12; ++r) acc[r] = 0.f;
#pragma unroll 32
            for (int k = 0; k < 256; ++k) { const float w = wp[(size_t)k * MODW]; const LAS f32x4* cp = (const LAS f32x4*)(csT + (256 * F.wave + k) * 12);
                const f32x4 c0 = cp[0], c1 = cp[1], c2 = cp[2];
                acc[0] += c0[0] * w; acc[1] += c0[1] * w; acc[2] += c0[2] * w; acc[3] += c0[3] * w; acc[4] += c1[0] * w; acc[5] += c1[1] * w; acc[6] += c1[2] * w; acc[7] += c1[3] * w;
                acc[8] += c2[0] * w; acc[9] += c2[1] * w; acc[10] += c2[2] * w; acc[11] += c2[3] * w; }
#pragma unroll
            for (int r = 0; r < 12; ++r) red[(F.wave * 12 + r) * 64 + F.lane] = acc[r];
            __syncthreads();
            for (int i = F.tid; i < 12 * 64; i += 512) { const int r = i / 64, c = i % 64; float s = 0.f;
#pragma unroll
                for (int w = 0; w < 8; ++w) s += red[(w * 12 + r) * 64 + c];
                const int jj = (u % (MODW / 64)) * 64 + c; MOD[((size_t)l * 12 + r) * MODW + jj] = s + in[10][(size_t)l * MODW + jj]; }
            __syncthreads();
        }
    }
    {
        f32x4* X4 = (f32x4*)(F.ws + WS_X); const f32x4* xp = (const f32x4*)in[0]; const f32x4* xs = (const f32x4*)in[1];
        const size_t n_p = (size_t)MPR * D / 4, n_s = (size_t)MS * D / 4, n_all = (size_t)MP * D / 4;
        for (size_t i = gt; i < n_all; i += NGT) X4[i] = i < n_p ? xp[i] : (i < n_p + n_s ? xs[i - n_p] : (f32x4){0.f, 0.f, 0.f, 0.f});
        const size_t pad0 = (size_t)M * D * 2 / 16, pad1 = (size_t)MP * D * 2 / 16;
        u32x4* h4 = (u32x4*)(F.ws + WS_H); u32x4* a4 = (u32x4*)(F.ws + WS_QA); u32x4* b4 = (u32x4*)(F.ws + WS_KA);
        for (size_t i = pad0 + gt; i < pad1; i += NGT) { const u32x4 z = {0u, 0u, 0u, 0u}; h4[i] = z; a4[i] = z; b4[i] = z; }
    }
    {
        float* LB = (float*)(F.ws + WS_LB);
        for (int d = gt; d < 2048; d += NGT) { float r[4], mx = -1e30f;
#pragma unroll
            for (int l = 0; l < 4; ++l) { r[l] = in[18][l * 2048 + d]; mx = fmaxf(mx, r[l]); }
            float e[4], s = 0.f;
#pragma unroll
            for (int l = 0; l < 4; ++l) { e[l] = __expf(r[l] - mx); s += e[l]; }
            const float inv = 1.0f / s; float cum = 0.f;
#pragma unroll
            for (int l = 0; l < 4; ++l) { if (l > 0) cum += e[l] * inv; LB[l * 2048 + d] = cum; } }
        float* BIN = (float*)(F.ws + WS_BIN);
        for (int i = gt; i < DEPTH * NINP; i += NGT) { const int l = i / NINP, c = i % NINP; BIN[i] = c < NIN ? in[14][(size_t)l * NIN + c] : 0.f; }
    }
}

DI void norm_phase(const Ctx& F, const float* gain, const float* modl  , int sh_off, int sc_off) {
    const int gw = F.bid * 8 + F.wave, NGW = F.G * 8;
    const float* X = (const float*)(F.ws + WS_X); bf16* H = (bf16*)(F.ws + WS_H);
    for (int row = gw; row < M; row += NGW) {
        const GAS f32x4* xr = (const GAS f32x4*)(X + (size_t)row * D) + F.lane;
        f32x4 v[8]; float ss = 0.f;
#pragma unroll
        for (int j = 0; j < 8; ++j) { v[j] = xr[64 * j]; ss += (v[j].x * v[j].x + v[j].y * v[j].y) + (v[j].z * v[j].z + v[j].w * v[j].w); }
        const float rs = rsqrtf(wave_sum(ss) * (1.0f / D) + EPS);
        const float* mb = modl + (size_t)row_batch(row) * MODW;
        GAS u32x2* o8 = (GAS u32x2*)(H + (size_t)row * D) + F.lane;
#pragma unroll
        for (int j = 0; j < 8; ++j) { const int c = 4 * F.lane + 256 * j; const f32x4 g = *(const f32x4*)(gain + c), sc = *(const f32x4*)(mb + sc_off + c), sh = *(const f32x4*)(mb + sh_off + c);
            const f32x4 y = (v[j] * rs) * g * (sc + 1.0f) + sh; u32x2 w; w.x = pk2(y.x, y.y); w.y = pk2(y.z, y.w); o8[64 * j] = w; }
    }
}
DI void final_norm_phase(const Ctx& F) {
    const int gw = F.bid * 8 + F.wave, NGW = F.G * 8;
    const float* X = (const float*)(F.ws + WS_X); const float* gain = F.in[25];
    for (int row = gw; row < M; row += NGW) {
        const GAS f32x4* xr = (const GAS f32x4*)(X + (size_t)row * D) + F.lane;
        f32x4 v[8]; float ss = 0.f;
#pragma unroll
        for (int j = 0; j < 8; ++j) { v[j] = xr[64 * j]; ss += (v[j].x * v[j].x + v[j].y * v[j].y) + (v[j].z * v[j].z + v[j].w * v[j].w); }
        const float rs = rsqrtf(wave_sum(ss) * (1.0f / D) + EPS);
        GAS f32x4* o = (GAS f32x4*)(F.out + (size_t)row * D) + F.lane;
#pragma unroll
        for (int j = 0; j < 8; ++j) { const f32x4 g = *(const f32x4*)(gain + 4 * F.lane + 256 * j); o[64 * j] = (v[j] * rs) * g; }
    }
}

DI void prep_phase(const Ctx& F, int l) {
    const bf16* Z = (const bf16*)(F.ws + WS_Z);
    bf16* QA = (bf16*)(F.ws + WS_QA); bf16* KA = (bf16*)(F.ws + WS_KA); bf16* QB = (bf16*)(F.ws + WS_QB); bf16* KB = (bf16*)(F.ws + WS_KB);
    float* E1 = (float*)(F.ws + WS_E1); float* E2 = (float*)(F.ws + WS_E2);
    const float* LB = (const float*)(F.ws + WS_LB) + l * 2048;
    constexpr int NCONV = M / 16, NHG = NCHUNKS * 8;
    for (int it = F.bid; it < NCONV + NHG; it += F.G) {
        if (it < NCONV) {
            const int r0 = it * 16, c0 = 8 * F.tid; const bool sample = r0 >= MPR;
            const int t0 = sample ? 0 : (r0 & (SEQ - 1)); const int bs = sample ? (r0 - MPR) >> 4 : (r0 >> 12);
            float w[4][8], cb[8];
#pragma unroll
            for (int j = 0; j < 4; ++j) { const f32x4 a = *(const f32x4*)(F.in[15] + ((size_t)l * 4 + j) * 4096 + c0), b = *(const f32x4*)(F.in[15] + ((size_t)l * 4 + j) * 4096 + c0 + 4);
                w[j][0] = a.x; w[j][1] = a.y; w[j][2] = a.z; w[j][3] = a.w; w[j][4] = b.x; w[j][5] = b.y; w[j][6] = b.z; w[j][7] = b.w; }
            { const f32x4 a = *(const f32x4*)(F.in[16] + (size_t)l * 4096 + c0), b = *(const f32x4*)(F.in[16] + (size_t)l * 4096 + c0 + 4);
                cb[0] = a.x; cb[1] = a.y; cb[2] = a.z; cb[3] = a.w; cb[4] = b.x; cb[5] = b.y; cb[6] = b.z; cb[7] = b.w; }
            float z0[8], z1[8], z2[8];
            if (t0 == 0) {
                if (sample) { const float* cc = F.in[2] + (((size_t)l * NSB + bs) * 3) * 4096 + c0;
#pragma unroll
                    for (int e = 0; e < 8; ++e) { z0[e] = cc[e]; z1[e] = cc[4096 + e]; z2[e] = cc[8192 + e]; } }
                else {
#pragma unroll
                    for (int e = 0; e < 8; ++e) { z0[e] = 0.f; z1[e] = 0.f; z2[e] = 0.f; } }
            } else {
                pg8::unpack8(*(const u32x4*)(Z + (size_t)(r0 - 3) * NINP + c0), z0); pg8::unpack8(*(const u32x4*)(Z + (size_t)(r0 - 2) * NINP + c0), z1); pg8::unpack8(*(const u32x4*)(Z + (size_t)(r0 - 1) * NINP + c0), z2);
            }
            const bool last = sample || (t0 + 16 == SEQ);
            float* cout = F.out + (sample ? O_CONVS + (((size_t)l * NSB + bs) * 3) * 4096 : O_CONVP + (((size_t)l * NB + bs) * 3) * 4096) + c0;
#pragma unroll
            for (int rr = 0; rr < 16; ++rr) {
                float z3[8]; pg8::unpack8(*(const u32x4*)(Z + (size_t)(r0 + rr) * NINP + c0), z3);
                float y[8];
#pragma unroll
                for (int e = 0; e < 8; ++e) { const float a = cb[e] + w[0][e] * z0[e] + w[1][e] * z1[e] + w[2][e] * z2[e] + w[3][e] * z3[e]; y[e] = a * sigm(a); }
                if (c0 < 2048) { u32x4 o; o.x = pk2(y[0], y[1]); o.y = pk2(y[2], y[3]); o.z = pk2(y[4], y[5]); o.w = pk2(y[6], y[7]); *(u32x4*)(QA + (size_t)(r0 + rr) * D + c0) = o; }
                else { u32x4 o; o.x = pk2(y[0] * 0.0625f, y[1] * 0.0625f); o.y = pk2(y[2] * 0.0625f, y[3] * 0.0625f); o.z = pk2(y[4] * 0.0625f, y[5] * 0.0625f); o.w = pk2(y[6] * 0.0625f, y[7] * 0.0625f);
                    *(u32x4*)(KA + (size_t)(r0 + rr) * D + (c0 - 2048)) = o; }
                if (last && rr >= 13) { float* cp = cout + (size_t)(rr - 13) * 4096; *(f32x4*)cp = (f32x4){z3[0], z3[1], z3[2], z3[3]}; *(f32x4*)(cp + 4) = (f32x4){z3[4], z3[5], z3[6], z3[7]}; }
#pragma unroll
                for (int e = 0; e < 8; ++e) { z0[e] = z1[e]; z1[e] = z2[e]; z2[e] = z3[e]; }
            }
        } else {
            const int hi = it - NCONV, ci = hi >> 3, cbase = (hi & 7) * 256, d = F.tid & 255, hf = F.tid >> 8;
            const bool sample = ci >= NB * 64; const int r0 = sample ? MPR + (ci - NB * 64) * 16 : ci * 64; const int Tv = sample ? 16 : 64;
            LAS unsigned char* FBs = F.lds; LAS unsigned char* QBs = F.lds + 32768; LAS float* xch = (LAS float*)(F.lds + 65536);
#pragma unroll
            for (int i = 0; i < 4; ++i) { const int idx = F.tid + 512 * i, rr = idx >> 5, sg = idx & 31;
                if (rr < Tv) { *(LAS u32x4*)(FBs + rr * 512 + sg * 16) = *(const GAS u32x4*)(Z + (size_t)(r0 + rr) * NINP + ZFB + cbase + 8 * sg);
                               *(LAS u32x4*)(QBs + rr * 512 + sg * 16) = *(const GAS u32x4*)(Z + (size_t)(r0 + rr) * NINP + ZQB + cbase + 8 * sg); } }
            __syncthreads();
            const float lb = LB[cbase + d], oml = 1.0f - lb;
            float bc[32]; float run = 0.f;
#pragma unroll
            for (int i = 0; i < 32; ++i) { const int t = 32 * hf + i;
                if (t < Tv) { const float fb = fminf(fmaxf(bf2f(*(const LAS unsigned short*)(FBs + t * 512 + d * 2)), -30.f), 30.f); const float f = lb + oml / (1.0f + __expf(-fb)); run += fmaxf(__logf(f), -60.0f); }
                bc[i] = run; }
            if (hf == 0) xch[d] = run;
            __syncthreads();
            const float base = hf ? xch[d] : 0.f; const float bR = hf ? base : run;
            if (hf) { E1[(size_t)ci * 2048 + cbase + d] = __expf(bR); E2[(size_t)ci * 2048 + cbase + d] = __expf(run); }
#pragma unroll
            for (int i = 0; i < 32; ++i) { const int t = 32 * hf + i;
                if (t < Tv) { const float fb = fminf(fmaxf(bf2f(*(const LAS unsigned short*)(FBs + t * 512 + d * 2)), -30.f), 30.f), qv = bf2f(*(const LAS unsigned short*)(QBs + t * 512 + d * 2));
                    const float e = __expf(-fb), s = 1.0f / (1.0f + e), bt = base + bc[i];
                    const float q = qv * sigm(qv) * __expf(bt - bR), k = oml * e * s * __expf(bR - bt);
                    *(LAS unsigned short*)(QBs + t * 512 + d * 2) = (unsigned short)f2bf(q); *(LAS unsigned short*)(FBs + t * 512 + d * 2) = (unsigned short)f2bf(k); } }
            __syncthreads();
#pragma unroll
            for (int i = 0; i < 4; ++i) { const int idx = F.tid + 512 * i, rr = idx >> 5, sg = idx & 31;
                if (rr < Tv) { *(GAS u32x4*)(QB + (size_t)(r0 + rr) * D + cbase + 8 * sg) = *(const LAS u32x4*)(QBs + rr * 512 + sg * 16);
                               *(GAS u32x4*)(KB + (size_t)(r0 + rr) * D + cbase + 8 * sg) = *(const LAS u32x4*)(FBs + rr * 512 + sg * 16); } }
            __syncthreads();
        }
    }
}

DI void headnorm_phase(const Ctx& F, int l) {
    const int gw = F.bid * 8 + F.wave, NGW = F.G * 8;
    const bf16* Z = (const bf16*)(F.ws + WS_Z); const bf16* HA = (const bf16*)(F.ws + WS_HA); const bf16* HB = (const bf16*)(F.ws + WS_HB);
    bf16* YA = (bf16*)(F.ws + WS_QA); bf16* YB = (bf16*)(F.ws + WS_KA);
    const float* ga = F.in[17] + (size_t)l * 2048; const float* gb = F.in[19] + (size_t)l * 2048;
    for (int row = gw; row < M; row += NGW) {
        u32x4 ha[4], hb[4], oa[4], ob[4];
#pragma unroll
        for (int j = 0; j < 4; ++j) { const int c = 512 * j + 8 * F.lane;
            ha[j] = *(const GAS u32x4*)(HA + (size_t)row * D + c); hb[j] = *(const GAS u32x4*)(HB + (size_t)row * D + c);
            oa[j] = *(const GAS u32x4*)(Z + (size_t)row * NINP + ZOA + c); ob[j] = *(const GAS u32x4*)(Z + (size_t)row * NINP + ZOGB + c); }
#pragma unroll
        for (int j = 0; j < 4; ++j) { const int c = 512 * j + 8 * F.lane;
            { float hv[8], ov[8]; pg8::unpack8(ha[j], hv); pg8::unpack8(oa[j], ov); float ss = 0.f;
#pragma unroll
              for (int e = 0; e < 8; ++e) ss += hv[e] * hv[e];
#pragma unroll
              for (int o = 1; o < 32; o <<= 1) ss += __shfl_xor(ss, o);
              const float rs = rsqrtf(ss * (1.0f / 256.0f) + EPS); const f32x4 g0 = *(const f32x4*)(ga + c), g1 = *(const f32x4*)(ga + c + 4); float y[8];
#pragma unroll
              for (int e = 0; e < 8; ++e) y[e] = hv[e] * rs * (e < 4 ? g0[e] : g1[e - 4]) * sigm(ov[e]);
              u32x4 w; w.x = pk2(y[0], y[1]); w.y = pk2(y[2], y[3]); w.z = pk2(y[4], y[5]); w.w = pk2(y[6], y[7]); *(GAS u32x4*)(YA + (size_t)row * D + c) = w; }
            { float hv[8], ov[8]; pg8::unpack8(hb[j], hv); pg8::unpack8(ob[j], ov); float ss = 0.f;
#pragma unroll
              for (int e = 0; e < 8; ++e) ss += hv[e] * hv[e];
#pragma unroll
              for (int o = 1; o < 16; o <<= 1) ss += __shfl_xor(ss, o);
              const float rs = rsqrtf(ss * (1.0f / 128.0f) + EPS); const f32x4 g0 = *(const f32x4*)(gb + c), g1 = *(const f32x4*)(gb + c + 4); float y[8];
#pragma unroll
              for (int e = 0; e < 8; ++e) y[e] = hv[e] * rs * (e < 4 ? g0[e] : g1[e - 4]) * sigm(ov[e]);
              u32x4 w; w.x = pk2(y[0], y[1]); w.y = pk2(y[2], y[3]); w.z = pk2(y[4], y[5]); w.w = pk2(y[6], y[7]); *(GAS u32x4*)(YB + (size_t)row * D + c) = w; }
        }
    }
}

DI bf16x8 frag(const LAS unsigned char* base, int row, int ldb, int kbyte) { return *(const LAS bf16x8*)(base + row * ldb + kbyte); }
DI bf16x8 frag_t(const LAS unsigned char* base, int k0, int ldb, int col) {
    const LAS unsigned short* p = (const LAS unsigned short*)(base + k0 * ldb + col * 2); bf16x8 r;
#pragma unroll
    for (int j = 0; j < 8; ++j) r[j] = (short)p[j * (ldb / 2)];
    return r;
}
#define MFMA16(a, b, c) __builtin_amdgcn_mfma_f32_16x16x32_bf16((a), (b), (c), 0, 0, 0)

DI void mlstm_unit(LAS unsigned char* lds, const bf16* QA, const bf16* KA, const bf16* Z, const float* G, bf16* HA,
                   int row0, int nchunk, int Tv, int h, int vs, const float* C0, const float* n0, const float* m0p, float* Cout, float* nout, float* mout) {
    int tid_ = threadIdx.x; asm volatile("" : "+v"(tid_));
    const int tid = tid_, lane = tid & 63, W = __builtin_amdgcn_readfirstlane(tid >> 6), g = lane >> 4, li = lane & 15;
    LAS unsigned char* Qs = lds + SC_Q; LAS unsigned char* Ks = lds + SC_K; LAS unsigned char* VT = lds + SC_VT; LAS unsigned char* VW = lds + SC_VW;
    LAS unsigned char* CTs = lds + SC_CT; LAS unsigned char* Ps = lds + SC_P; LAS unsigned char* Hs = lds + SC_H;
    f32x4 cacc[2][5];
#pragma unroll
    for (int di = 0; di < 2; ++di)
#pragma unroll
        for (int vi = 0; vi < 5; ++vi)
#pragma unroll
            for (int r = 0; r < 4; ++r) { const int d = 16 * (2 * W + di) + 4 * g + r; float v = 0.f;
                if (C0) { if (vi < 4) v = C0[(size_t)d * 256 + 64 * vs + 16 * vi + li]; else if (li == 0) v = n0[d]; }
                cacc[di][vi][r] = v; }
    float m_prev = m0p ? *m0p : 0.f;
    for (int i = tid; i < 16 * 72; i += 512) { const int rr = 64 + i / 72, cc = i % 72;
        *(LAS unsigned short*)(VT + rr * LVB + cc * 2) = (rr == 64 && cc < 64) ? (unsigned short)0x3F80 : (unsigned short)0; *(LAS unsigned short*)(VW + rr * LVB + cc * 2) = 0; }
    u32x4 pq[4], pk[4], pv; float pig, pfg;
#define ML_PREFETCH(c) do { const int r0_ = row0 + 64 * (c); \
        _Pragma("unroll") for (int i = 0; i < 4; ++i) { const int idx = tid + 512 * i, rr = idx >> 5, sg = idx & 31; \
            if (rr < Tv) { pq[i] = *(const GAS u32x4*)(QA + (size_t)(r0_ + rr) * D + 256 * h + 8 * sg); pk[i] = *(const GAS u32x4*)(KA + (size_t)(r0_ + rr) * D + 256 * h + 8 * sg); } \
            else { pq[i] = (u32x4){0u, 0u, 0u, 0u}; pk[i] = (u32x4){0u, 0u, 0u, 0u}; } } \
        { const int rr = tid >> 3, sg = tid & 7; pv = rr < Tv ? *(const GAS u32x4*)(Z + (size_t)(r0_ + rr) * NINP + ZVA + 256 * h + 64 * vs + 8 * sg) : (u32x4){0u, 0u, 0u, 0u}; } \
        pig = lane < Tv ? G[(size_t)(r0_ + lane) * 16 + h] : -1e30f; pfg = lane < Tv ? G[(size_t)(r0_ + lane) * 16 + 8 + h] : 0.f; } while (0)
    ML_PREFETCH(0);
    for (int c = 0; c < nchunk; ++c) {
        const int r0 = row0 + 64 * c;
        const float igv = pig; const float lfv = lane < Tv ? logsig(pfg) : 0.f;
        float bc = lfv;
#pragma unroll
        for (int o = 1; o < 64; o <<= 1) { const float y = __shfl_up(bc, o); if (lane >= o) bc += y; }
        float gm = igv - bc;
#pragma unroll
        for (int o = 1; o < 64; o <<= 1) { const float y = __shfl_up(gm, o); if (lane >= o) gm = fmaxf(gm, y); }
        const float mt = bc + fmaxf(gm, m_prev);
        const float winter = __expf(bc + m_prev - mt), enm = __expf(-mt);
        const float m_last = __shfl(mt, 63), b_last = __shfl(bc, 63);
        const float wlast = __expf(b_last - bc + igv - m_last);
        const float decay = __shfl(winter, 63);
#pragma unroll
        for (int i = 0; i < 4; ++i) { const int idx = tid + 512 * i, rr = idx >> 5, sg = idx & 31; *(LAS u32x4*)(Qs + rr * LQB + sg * 16) = pq[i]; *(LAS u32x4*)(Ks + rr * LQB + sg * 16) = pk[i]; }
        { const int rr = tid >> 3, sg = tid & 7; const float wl = __shfl(wlast, rr); float vv[8]; pg8::unpack8(pv, vv);
#pragma unroll
          for (int j = 0; j < 8; ++j) { *(LAS unsigned short*)(VT + (8 * sg + j) * LVB + rr * 2) = (unsigned short)f2bf(vv[j]); *(LAS unsigned short*)(VW + (8 * sg + j) * LVB + rr * 2) = (unsigned short)f2bf(vv[j] * wl); } }
        if (W == 0) *(LAS unsigned short*)(VW + 64 * LVB + lane * 2) = (unsigned short)f2bf(wlast);
#pragma unroll
        for (int di = 0; di < 2; ++di)
#pragma unroll
            for (int vi = 0; vi < 5; ++vi) { u32x2 w; w.x = pk2(cacc[di][vi][0], cacc[di][vi][1]); w.y = pk2(cacc[di][vi][2], cacc[di][vi][3]);
                *(LAS u32x2*)(CTs + (16 * vi + li) * LQB + (16 * (2 * W + di) + 4 * g) * 2) = w; }
        __syncthreads();
        if (c + 1 < nchunk) ML_PREFETCH(c + 1);
        {
            const int tt = W & 3, sh = W >> 2;
            f32x4 sacc[2] = {{0.f, 0.f, 0.f, 0.f}, {0.f, 0.f, 0.f, 0.f}};
#pragma unroll
            for (int kk = 0; kk < 8; ++kk) { const bf16x8 bq = frag(Qs, 16 * tt + li, LQB, 64 * kk + 16 * g);
#pragma unroll
                for (int i = 0; i < 2; ++i) { const bf16x8 ak = frag(Ks, 16 * (2 * sh + i) + li, LQB, 64 * kk + 16 * g); sacc[i] = MFMA16(ak, bq, sacc[i]); } }
            const int t = 16 * tt + li; const float bt = __shfl(bc, t), mtt = __shfl(mt, t);
#pragma unroll
            for (int i = 0; i < 2; ++i) { float p[4];
#pragma unroll
                for (int r = 0; r < 4; ++r) { const int s = 16 * (2 * sh + i) + 4 * g + r; const float bs = __shfl(bc, s), igs = __shfl(igv, s);
                    p[r] = (s <= t) ? sacc[i][r] * __expf(bt - bs + igs - mtt) : 0.f; }
                u32x2 w; w.x = pk2(p[0], p[1]); w.y = pk2(p[2], p[3]); *(LAS u32x2*)(Ps + t * LVB + (16 * (2 * sh + i) + 4 * g) * 2) = w; }
        }
        __syncthreads();
        {
            const int tt = W & 3, vh = W >> 2; const int vt0 = 2 * vh, vt1 = 2 * vh + 1;
            f32x4 a1[3], a2[3];
#pragma unroll
            for (int i = 0; i < 3; ++i) { a1[i] = (f32x4){0.f, 0.f, 0.f, 0.f}; a2[i] = (f32x4){0.f, 0.f, 0.f, 0.f}; }
#pragma unroll
            for (int kk = 0; kk < 2; ++kk) { const bf16x8 ap = frag(Ps, 16 * tt + li, LVB, 64 * kk + 16 * g);
                a1[0] = MFMA16(ap, frag(VT, 16 * vt0 + li, LVB, 64 * kk + 16 * g), a1[0]); a1[1] = MFMA16(ap, frag(VT, 16 * vt1 + li, LVB, 64 * kk + 16 * g), a1[1]);
                a1[2] = MFMA16(ap, frag(VT, 64 + li, LVB, 64 * kk + 16 * g), a1[2]); }
#pragma unroll
            for (int kk = 0; kk < 8; ++kk) { const bf16x8 aq = frag(Qs, 16 * tt + li, LQB, 64 * kk + 16 * g);
                a2[0] = MFMA16(aq, frag(CTs, 16 * vt0 + li, LQB, 64 * kk + 16 * g), a2[0]); a2[1] = MFMA16(aq, frag(CTs, 16 * vt1 + li, LQB, 64 * kk + 16 * g), a2[1]);
                a2[2] = MFMA16(aq, frag(CTs, 64 + li, LQB, 64 * kk + 16 * g), a2[2]); }
#pragma unroll
            for (int r = 0; r < 4; ++r) { const int t = 16 * tt + 4 * g + r; const float wi = __shfl(winter, t), en = __shfl(enm, t);
                const float o2 = a1[2][r] + wi * a2[2][r]; const float qn = __shfl(o2, lane & 48); const float inv = 1.0f / fmaxf(fabsf(qn), en);
                *(LAS unsigned short*)(Hs + t * LVB + (16 * vt0 + li) * 2) = (unsigned short)f2bf((a1[0][r] + wi * a2[0][r]) * inv); *(LAS unsigned short*)(Hs + t * LVB + (16 * vt1 + li) * 2) = (unsigned short)f2bf((a1[1][r] + wi * a2[1][r]) * inv); }
        }
#pragma unroll
        for (int di = 0; di < 2; ++di)
#pragma unroll
            for (int vi = 0; vi < 5; ++vi) cacc[di][vi] = cacc[di][vi] * decay;
#pragma unroll
        for (int kk = 0; kk < 2; ++kk) { bf16x8 ak[2];
#pragma unroll
            for (int di = 0; di < 2; ++di) ak[di] = frag_t(Ks, 32 * kk + 8 * g, LQB, 16 * (2 * W + di) + li);
#pragma unroll
            for (int vi = 0; vi < 5; ++vi) { const bf16x8 bv = frag(VW, 16 * vi + li, LVB, 64 * kk + 16 * g);
#pragma unroll
                for (int di = 0; di < 2; ++di) cacc[di][vi] = MFMA16(ak[di], bv, cacc[di][vi]); } }
        m_prev = m_last;
        __syncthreads();
        { const int rr = tid >> 3, sg = tid & 7; if (rr < Tv) *(GAS u32x4*)(HA + (size_t)(r0 + rr) * D + 256 * h + 64 * vs + 8 * sg) = *(const LAS u32x4*)(Hs + rr * LVB + sg * 16); }
    }
#undef ML_PREFETCH
#pragma unroll
    for (int di = 0; di < 2; ++di)
#pragma unroll
        for (int r = 0; r < 4; ++r) { const int d = 16 * (2 * W + di) + 4 * g + r;
#pragma unroll
            for (int vi = 0; vi < 4; ++vi) Cout[(size_t)d * 256 + 64 * vs + 16 * vi + li] = cacc[di][vi][r];
            if (vs == 0 && li == 0) nout[d] = cacc[di][4][r]; }
    if (vs == 0 && tid == 0) *mout = m_prev;
}

DI void hgrn_unit(LAS unsigned char* lds, const bf16* QB, const bf16* KB, const bf16* Z, const float* E1, const float* E2, bf16* HB,
                  int row0, int nchunk, int Tv, int h, int vs, int ci0, const float* S0, float* Sout) {
    int tid_ = threadIdx.x; asm volatile("" : "+v"(tid_));
    const int tid = tid_, lane = tid & 63, W = __builtin_amdgcn_readfirstlane(tid >> 6), g = lane >> 4, li = lane & 15;
    LAS unsigned char* Qs = lds + HS_Q; LAS unsigned char* Ks = lds + HS_K; LAS unsigned char* VT = lds + HS_VT; LAS unsigned char* STs = lds + HS_ST; LAS unsigned char* Ps = lds + HS_P; LAS unsigned char* Hs = lds + HS_H;
    f32x4 sacc[4];
#pragma unroll
    for (int vi = 0; vi < 4; ++vi)
#pragma unroll
        for (int r = 0; r < 4; ++r) sacc[vi][r] = S0 ? S0[(size_t)(16 * W + 4 * g + r) * 128 + 64 * vs + 16 * vi + li] : 0.f;
    u32x4 pq[2], pk[2], pv; f32x4 pe1, pe2;
#define HG_PREFETCH(c) do { const int r0_ = row0 + 64 * (c); \
        _Pragma("unroll") for (int i = 0; i < 2; ++i) { const int idx = tid + 512 * i, rr = idx >> 4, sg = idx & 15; \
            if (rr < Tv) { pq[i] = *(const GAS u32x4*)(QB + (size_t)(r0_ + rr) * D + 128 * h + 8 * sg); pk[i] = *(const GAS u32x4*)(KB + (size_t)(r0_ + rr) * D + 128 * h + 8 * sg); } \
            else { pq[i] = (u32x4){0u, 0u, 0u, 0u}; pk[i] = (u32x4){0u, 0u, 0u, 0u}; } } \
        { const int rr = tid >> 3, sg = tid & 7; pv = rr < Tv ? *(const GAS u32x4*)(Z + (size_t)(r0_ + rr) * NINP + ZIB + 128 * h + 64 * vs + 8 * sg) : (u32x4){0u, 0u, 0u, 0u}; } \
        pe1 = *(const GAS f32x4*)(E1 + (size_t)(ci0 + (c)) * 2048 + 128 * h + 16 * W + 4 * g); pe2 = *(const GAS f32x4*)(E2 + (size_t)(ci0 + (c)) * 2048 + 128 * h + 16 * W + 4 * g); } while (0)
    HG_PREFETCH(0);
    for (int c = 0; c < nchunk; ++c) {
        const int r0 = row0 + 64 * c;
        const f32x4 e2 = pe2;
        f32x4 smid[4];
#pragma unroll
        for (int vi = 0; vi < 4; ++vi) smid[vi] = sacc[vi] * pe1;
#pragma unroll
        for (int i = 0; i < 2; ++i) { const int idx = tid + 512 * i, rr = idx >> 4, sg = idx & 15; *(LAS u32x4*)(Qs + rr * LHB + sg * 16) = pq[i]; *(LAS u32x4*)(Ks + rr * LHB + sg * 16) = pk[i]; }
        { const int rr = tid >> 3, sg = tid & 7; const unsigned wv[4] = {pv.x, pv.y, pv.z, pv.w};
#pragma unroll
          for (int j = 0; j < 8; ++j) *(LAS unsigned short*)(VT + (8 * sg + j) * LVB + rr * 2) = (unsigned short)((j & 1) ? (wv[j >> 1] >> 16) : (wv[j >> 1] & 0xffffu)); }
#pragma unroll
        for (int vi = 0; vi < 4; ++vi) { u32x2 w; w.x = pk2(smid[vi][0], smid[vi][1]); w.y = pk2(smid[vi][2], smid[vi][3]); *(LAS u32x2*)(STs + (16 * vi + li) * LHB + (16 * W + 4 * g) * 2) = w; }
        __syncthreads();
        if (c + 1 < nchunk) HG_PREFETCH(c + 1);
        {
            const int tt = W & 3, sh = W >> 2;
            f32x4 a[2] = {{0.f, 0.f, 0.f, 0.f}, {0.f, 0.f, 0.f, 0.f}};
#pragma unroll
            for (int kk = 0; kk < 4; ++kk) { const bf16x8 bq = frag(Qs, 16 * tt + li, LHB, 64 * kk + 16 * g);
#pragma unroll
                for (int i = 0; i < 2; ++i) a[i] = MFMA16(frag(Ks, 16 * (2 * sh + i) + li, LHB, 64 * kk + 16 * g), bq, a[i]); }
            const int t = 16 * tt + li;
#pragma unroll
            for (int i = 0; i < 2; ++i) { float p[4];
#pragma unroll
                for (int r = 0; r < 4; ++r) { const int s = 16 * (2 * sh + i) + 4 * g + r; p[r] = (s <= t) ? a[i][r] : 0.f; }
                u32x2 w; w.x = pk2(p[0], p[1]); w.y = pk2(p[2], p[3]); *(LAS u32x2*)(Ps + t * LVB + (16 * (2 * sh + i) + 4 * g) * 2) = w; }
        }
        __syncthreads();
        {
            const int tt = W & 3, vh = W >> 2;
            f32x4 o[2] = {{0.f, 0.f, 0.f, 0.f}, {0.f, 0.f, 0.f, 0.f}};
#pragma unroll
            for (int kk = 0; kk < 2; ++kk) { const bf16x8 ap = frag(Ps, 16 * tt + li, LVB, 64 * kk + 16 * g);
#pragma unroll
                for (int i = 0; i < 2; ++i) o[i] = MFMA16(ap, frag(VT, 16 * (2 * vh + i) + li, LVB, 64 * kk + 16 * g), o[i]); }
#pragma unroll
            for (int kk = 0; kk < 4; ++kk) { const bf16x8 aq = frag(Qs, 16 * tt + li, LHB, 64 * kk + 16 * g);
#pragma unroll
                for (int i = 0; i < 2; ++i) o[i] = MFMA16(aq, frag(STs, 16 * (2 * vh + i) + li, LHB, 64 * kk + 16 * g), o[i]); }
#pragma unroll
            for (int r = 0; r < 4; ++r) { const int t = 16 * tt + 4 * g + r;
                *(LAS unsigned short*)(Hs + t * LVB + (16 * (2 * vh) + li) * 2) = (unsigned short)f2bf(o[0][r]); *(LAS unsigned short*)(Hs + t * LVB + (16 * (2 * vh + 1) + li) * 2) = (unsigned short)f2bf(o[1][r]); }
        }
#pragma unroll
        for (int vi = 0; vi < 4; ++vi) sacc[vi] = smid[vi];
#pragma unroll
        for (int kk = 0; kk < 2; ++kk) { const bf16x8 ak = frag_t(Ks, 32 * kk + 8 * g, LHB, 16 * W + li);
#pragma unroll
            for (int vi = 0; vi < 4; ++vi) sacc[vi] = MFMA16(ak, frag(VT, 16 * vi + li, LVB, 64 * kk + 16 * g), sacc[vi]); }
#pragma unroll
        for (int vi = 0; vi < 4; ++vi) sacc[vi] = sacc[vi] * e2;
        __syncthreads();
        { const int rr = tid >> 3, sg = tid & 7; if (rr < Tv) *(GAS u32x4*)(HB + (size_t)(r0 + rr) * D + 128 * h + 64 * vs + 8 * sg) = *(const LAS u32x4*)(Hs + rr * LVB + sg * 16); }
    }
#undef HG_PREFETCH
#pragma unroll
    for (int vi = 0; vi < 4; ++vi)
#pragma unroll
        for (int r = 0; r < 4; ++r) Sout[(size_t)(16 * W + 4 * g + r) * 128 + 64 * vs + 16 * vi + li] = sacc[vi][r];
}

DI void scan_phase(const Ctx& F, int l) {
    const bf16* Z = (const bf16*)(F.ws + WS_Z);
    const bf16* QA = (const bf16*)(F.ws + WS_QA); const bf16* KA = (const bf16*)(F.ws + WS_KA); const bf16* QB = (const bf16*)(F.ws + WS_QB); const bf16* KB = (const bf16*)(F.ws + WS_KB);
    const float* G = (const float*)(F.ws + WS_G); const float* E1 = (const float*)(F.ws + WS_E1); const float* E2 = (const float*)(F.ws + WS_E2);
    bf16* HA = (bf16*)(F.ws + WS_HA); bf16* HB = (bf16*)(F.ws + WS_HB);
    for (int u = F.bid; u < 768; u += F.G) {
        int type, idx, sample;
        if (u < 128) { type = 0; idx = u; sample = 0; } else if (u < 256) { type = 1; idx = u - 128; sample = 0; }
        else if (u < 384) { type = 1; idx = u - 256; sample = 1; } else if (u < 512) { type = 0; idx = u - 384; sample = 1; }
        else if (u < 640) { type = 1; idx = u - 512 + 128; sample = 1; } else { type = 0; idx = u - 640 + 128; sample = 1; }
        if (type == 0) {
            const int b = idx >> 5, h = (idx >> 2) & 7, vs = idx & 3;
            const size_t so = sample ? (size_t)l * NSB + b : (size_t)l * NB + b;
            const float* C0 = sample ? F.in[3] + (so * 8 + h) * 65536 : nullptr; const float* n0 = sample ? F.in[4] + (so * 8 + h) * 256 : nullptr; const float* m0 = sample ? F.in[5] + so * 8 + h : nullptr;
            float* Co = F.out + (sample ? O_CS : O_CP) + (so * 8 + h) * 65536; float* no = F.out + (sample ? O_NS : O_NP) + (so * 8 + h) * 256; float* mo = F.out + (sample ? O_MS : O_MP) + so * 8 + h;
            mlstm_unit(F.lds, QA, KA, Z, G, HA, sample ? MPR + b * SSEQ : b * SEQ, sample ? 1 : SEQ / 64, sample ? SSEQ : 64, h, vs, C0, n0, m0, Co, no, mo);
        } else {
            const int b = idx >> 5, h = (idx >> 1) & 15, vs = idx & 1;
            const size_t so = sample ? (size_t)l * NSB + b : (size_t)l * NB + b;
            const float* S0 = sample ? F.in[6] + (so * 16 + h) * 16384 : nullptr; float* So = F.out + (sample ? O_SS : O_SP) + (so * 16 + h) * 16384;
            hgrn_unit(F.lds, QB, KB, Z, E1, E2, HB, sample ? MPR + b * SSEQ : b * SEQ, sample ? 1 : SEQ / 64, sample ? SSEQ : 64, h, vs, sample ? NB * 64 + b : b * 64, S0, So);
        }
        __syncthreads();
    }
}

constexpr int NPH_LAYER = 10, NPHASES = 1 + DEPTH * NPH_LAYER + 1;
struct Args { const float* in[26]; float* out; unsigned char* ws; int ph_lo, ph_hi; };
static_assert(sizeof(Args) == 26 * 8 + 8 + 8 + 8, "Args has no padding");

__global__ void __launch_bounds__(512, 2) trunk_fwd(Args args) {
    extern __shared__ __attribute__((aligned(16))) unsigned char lds_raw[];
    Ctx F;
    F.lds = (LAS unsigned char*)lds_raw; F.ws = args.ws; F.in = args.in; F.out = args.out;
    F.tid = threadIdx.x; F.lane = F.tid & 63; F.wave = __builtin_amdgcn_readfirstlane(F.tid >> 6); F.G = gridDim.x; F.bid = blockIdx.x;
    volatile LAS unsigned* MISC = (volatile LAS unsigned*)(F.lds + MISC_OFF);
    if (F.tid < 64) MISC[F.tid] = 0u;
    __syncthreads();
    gu32* ctl = (gu32*)(F.ws + WS_CTL);
#if MK_PER_PHASE
#define GRID_BAR() do { } while (0)
#else
    XcdBarrier bar = xcd_barrier_post((unsigned*)(ctl + CW_BAR), MISC + 8);
#define GRID_BAR() xcd_barrier(bar)
#endif
    const int lo = args.ph_lo, hi = args.ph_hi;
#ifndef PH_MASK
#define PH_MASK 0xFFFFu
#endif
#define IN(k) (lo <= (k) && (k) < hi)
#define EN(j) ((PH_MASK >> (j)) & 1u)
#ifndef DUP_MASK
#define DUP_MASK 0x0u
#endif
#define DUP(j) ((int)((DUP_MASK >> (j)) & 1u))
#define BOTH(k) (IN(k) && IN((k) + 1))
    if (EN(10) && IN(0)) { for (int rep_ = 0; rep_ <= DUP(10); ++rep_) { p0_prologue(F); if (rep_ < DUP(10) || BOTH(0)) GRID_BAR(); } }
    for (int l = 0; l < DEPTH; ++l) {
        const int pb = 1 + NPH_LAYER * l;
        { int t_ = threadIdx.x; asm volatile("" : "+v"(t_)); F.tid = t_; F.lane = t_ & 63; F.wave = __builtin_amdgcn_readfirstlane(t_ >> 6); }
        unsigned char* wl = F.ws + WS_W + (size_t)l * W_LAYER;
        const float* modl = (const float*)(F.ws + WS_MOD) + (size_t)l * 12 * MODW;
        if (EN(0) && IN(pb + 0)) { for (int rep_ = 0; rep_ <= DUP(0); ++rep_) { norm_phase(F, F.in[11] + (size_t)l * D, modl, 0, D); if (rep_ < DUP(0) || BOTH(pb + 0)) GRID_BAR(); } }
        if (EN(1) && IN(pb + 1)) { for (int rep_ = 0; rep_ <= DUP(1); ++rep_) {
            pg8::Gemm gm{(const pg8::bf16_t*)(F.ws + WS_H), (const pg8::bf16_t*)(wl + W_WIN), MP, NINP, D}; pg8::StaticOrder S; S.init(MP, NINP, F.G, F.bid);
            pg8::EpiZ E{(pg8::bf16_t*)(F.ws + WS_Z), (const float*)(F.ws + WS_BIN) + (size_t)l * NINP, (float*)(F.ws + WS_G)};
            pg8::gemm_phase<pg8::EpiZ, pg8::StaticOrder, true, true>(F.lds + RING_OFF, gm, S, E);
            if (rep_ < DUP(1) || BOTH(pb + 1)) GRID_BAR();
        } }
        if (EN(2) && IN(pb + 2)) { for (int rep_ = 0; rep_ <= DUP(2); ++rep_) { prep_phase(F, l); if (rep_ < DUP(2) || BOTH(pb + 2)) GRID_BAR(); } }
        if (EN(3) && IN(pb + 3)) { for (int rep_ = 0; rep_ <= DUP(3); ++rep_) { scan_phase(F, l); if (rep_ < DUP(3) || BOTH(pb + 3)) GRID_BAR(); } }
        if (EN(4) && IN(pb + 4)) { for (int rep_ = 0; rep_ <= DUP(4); ++rep_) { headnorm_phase(F, l); if (rep_ < DUP(4) || BOTH(pb + 4)) GRID_BAR(); } }
        if (EN(5) && IN(pb + 5)) { for (int rep_ = 0; rep_ <= DUP(5); ++rep_) {
            { pg8::Gemm gm{(const pg8::bf16_t*)(F.ws + WS_KA), (const pg8::bf16_t*)(wl + W_WBB), MP, D, D}; pg8::StaticOrder S; S.init(MP, D, F.G, F.bid);
              pg8::EpiGateTmp E{(const pg8::bf16_t*)(F.ws + WS_Z) + ZGB, (float*)(F.ws + WS_HA)};
              pg8::gemm_phase<pg8::EpiGateTmp, pg8::StaticOrder, true, true>(F.lds + RING_OFF, gm, S, E); }
            VM_WAIT(); __syncthreads();
            { pg8::Gemm gm{(const pg8::bf16_t*)(F.ws + WS_QA), (const pg8::bf16_t*)(wl + W_WBA), MP, D, D}; pg8::StaticOrder S; S.init(MP, D, F.G, F.bid);
              pg8::EpiMerge E{(const pg8::bf16_t*)(F.ws + WS_Z) + ZGA, (const float*)(F.ws + WS_HA), (pg8::bf16_t*)(F.ws + WS_QB)};
              pg8::gemm_phase<pg8::EpiMerge, pg8::StaticOrder, true, true>(F.lds + RING_OFF, gm, S, E); }
            if (rep_ < DUP(5) || BOTH(pb + 5)) GRID_BAR();
        } }
        if (EN(6) && IN(pb + 6)) { for (int rep_ = 0; rep_ <= DUP(6); ++rep_) {
            pg8::Gemm gm{(const pg8::bf16_t*)(F.ws + WS_QB), (const pg8::bf16_t*)(wl + W_WO), MP, D, D}; pg8::StaticOrder S; S.init(MP, D, F.G, F.bid);
            pg8::EpiResid E{(float*)(F.ws + WS_X), modl + 2 * D};
            pg8::gemm_phase<pg8::EpiResid, pg8::StaticOrder, true, true>(F.lds + RING_OFF, gm, S, E);
            if (rep_ < DUP(6) || BOTH(pb + 6)) GRID_BAR();
        } }
        if (EN(7) && IN(pb + 7)) { for (int rep_ = 0; rep_ <= DUP(7); ++rep_) { norm_phase(F, F.in[12] + (size_t)l * D, modl, 3 * D, 4 * D); if (rep_ < DUP(7) || BOTH(pb + 7)) GRID_BAR(); } }
        if (EN(8) && IN(pb + 8)) { for (int rep_ = 0; rep_ <= DUP(8); ++rep_) {
            pg8::Gemm gm{(const pg8::bf16_t*)(F.ws + WS_H), (const pg8::bf16_t*)(wl + W_WUP), MP, DFF, D}; pg8::StaticOrder S; S.init(MP, DFF, F.G, F.bid);
            pg8::EpiRelu2 E{(pg8::bf16_t*)(F.ws + WS_Z), DFF};
            pg8::gemm_phase<pg8::EpiRelu2, pg8::StaticOrder, true, true>(F.lds + RING_OFF, gm, S, E);
            if (rep_ < DUP(8) || BOTH(pb + 8)) GRID_BAR();
        } }
        if (EN(9) && IN(pb + 9)) { for (int rep_ = 0; rep_ <= DUP(9); ++rep_) {
            pg8::Gemm gm{(const pg8::bf16_t*)(F.ws + WS_Z), (const pg8::bf16_t*)(wl + W_WDN), MP, D, DFF}; pg8::StaticOrder S; S.init(MP, D, F.G, F.bid);
            pg8::EpiResid E{(float*)(F.ws + WS_X), modl + 5 * D};
            pg8::gemm_phase<pg8::EpiResid, pg8::StaticOrder, true, true>(F.lds + RING_OFF, gm, S, E);
            if (rep_ < DUP(9) || BOTH(pb + 9)) GRID_BAR();
        } }
    }
    if (EN(11) && IN(NPHASES - 1)) final_norm_phase(F);
#undef IN
#undef BOTH
}

extern "C" void kernel_launch(void* const* d_in, const int* in_sizes, int n_in, void* d_out, int out_size, void* d_ws, size_t ws_size, hipStream_t stream) {
    static int grid = 0;
    if (grid == 0) {
        if (n_in != 26 || (size_t)out_size != O_END || ws_size < WS_END) { fprintf(stderr, "kernel_launch: shape mismatch: n_in %d out %d (want %zu) ws %zu (want %zu)\n", n_in, out_size, (size_t)O_END, ws_size, (size_t)WS_END); grid = -1; return; }
        int dev = 0, cus = 0, per_cu = 0;
        if (hipGetDevice(&dev) != hipSuccess || hipDeviceGetAttribute(&cus, hipDeviceAttributeMultiprocessorCount, dev) != hipSuccess) { grid = -1; return; }
        if (hipFuncSetAttribute((const void*)trunk_fwd, hipFuncAttributeMaxDynamicSharedMemorySize, LDS_BYTES) != hipSuccess) { fprintf(stderr, "kernel_launch: hipFuncSetAttribute failed\n"); grid = -1; return; }
        if (hipOccupancyMaxActiveBlocksPerMultiprocessor(&per_cu, (const void*)trunk_fwd, 512, LDS_BYTES) != hipSuccess || per_cu < 1) fprintf(stderr, "kernel_launch: occupancy query says %d\n", per_cu);
        (void)hipGetLastError();
        grid = cus;
    }
    if (grid < 0) return;
    (void)in_sizes;
    if (hipMemsetAsync((char*)d_ws + WS_CTL, 0, CTL_ZERO_BYTES, stream) != hipSuccess) { fprintf(stderr, "kernel_launch: memset failed\n"); return; }
    Args a{};
    for (int i = 0; i < 26; ++i) a.in[i] = (const float*)d_in[i];
    a.out = (float*)d_out; a.ws = (unsigned char*)d_ws;
#if MK_PER_PHASE
    for (int p = 0; p < NPHASES; ++p) { a.ph_lo = p; a.ph_hi = p + 1; hipLaunchKernelGGL(trunk_fwd, dim3(grid), dim3(512), LDS_BYTES, stream, a); }
#else
    a.ph_lo = 0; a.ph_hi = NPHASES;
    hipLaunchKernelGGL(trunk_fwd, dim3(grid), dim3(512), LDS_BYTES, stream, a);
#endif
    const hipError_t le = hipPeekAtLastError();
    if (le != hipSuccess) fprintf(stderr, "kernel_launch: launch failed: %s\n", hipGetErrorName(le));
}
```

```cpp
#include <hip/hip_runtime.h>
#include <cstdio>
#include <cstdint>
#ifndef MK_PER_PHASE
#define MK_PER_PHASE 0
#endif
namespace pg8 {
#define PG8_LAS __attribute__((address_space(3)))
typedef unsigned short bf16_t;
typedef short bf16x8 __attribute__((ext_vector_type(8)));
typedef float f32x4 __attribute__((ext_vector_type(4)));
typedef unsigned u32x4 __attribute__((ext_vector_type(4)));
constexpr int BM = 256, BK = 64, HALF = 128, HTB = HALF * BK * 2  , STAGE_BYTES = 8 * HTB, NXCD = 8, WGM = 8;

__host__ __device__ __forceinline__ int lds_byte(int r, int c) { const int st = (r >> 4) * 2 + (c >> 5), rr = r & 15, cc = c & 31, ob = rr * 64 + cc * 2; return st * 1024 + (ob ^ (((ob >> 9) & 1) << 5)); }
__host__ __device__ __forceinline__ void stage_rc(int b, int& R, int& C) { const int st = b / 1024, sb = b % 1024, swz = sb ^ (((sb >> 9) & 1) << 5); R = (st >> 1) * 16 + swz / 64; C = (st & 1) * 32 + (swz % 64) / 2; }
__host__ __device__ __forceinline__ int perm32(int rho) { const int n = rho >> 4, i = rho & 15; return 8 * (i >> 2) + 4 * n + (i & 3); }

struct Unit { int pm, pn, k0, nt, half; };
struct Gemm { const bf16_t* A; const bf16_t* Bt; int M, N, K; };

struct StaticOrder {
    int nM, nN, nwg, G, c;
    __host__ __device__ void init(int M, int N, int G_, int c_) { nM = M / BM; nN = N / BM; nwg = nM * nN; G = G_; c = c_; }
    __host__ __device__ __forceinline__ bool next(int i, Unit& u) const {
        const long L = (long)i * G + c; if (L >= nwg) return false;
        int wgid = (int)L; { const int q = nwg / NXCD, r = nwg % NXCD, xcd = wgid % NXCD, off = wgid / NXCD; wgid = (xcd < r ? xcd * (q + 1) : r * (q + 1) + (xcd - r) * q) + off; }
        const int nig = WGM * nN, gid = wgid / nig, fm = gid * WGM, gsz = (nM - fm) < WGM ? (nM - fm) : WGM;
        u.pm = fm + ((wgid % nig) % gsz); u.pn = (wgid % nig) / gsz; return true;
    }
    __device__ __forceinline__ void a_ready(const Unit&) const {}
    __device__ __forceinline__ void done(const Unit&) const {}
};

struct SplitOrder {
    int nM, nN, nwg, G, c, S, ntK;
    __device__ __forceinline__ void init(int Mfull, int N, int K, int S_, int G_, int c_) { nM = Mfull / BM; nN = N / BM; nwg = nM * nN; G = G_; c = c_; S = S_; ntK = K / BK; }
    __device__ __forceinline__ bool next(int i, Unit& u) const {
        const long L = (long)i * G + c; const bool full = L < nwg; const int j = full ? 0 : (int)(L - nwg);
        if (!full && j >= nN * S) return false;
        int wgid = full ? (int)L : 0; { const int q = nwg / NXCD, r = nwg % NXCD, xcd = wgid % NXCD, off = wgid / NXCD; wgid = (xcd < r ? xcd * (q + 1) : r * (q + 1) + (xcd - r) * q) + off; }
        const int nig = WGM * nN, gid = wgid / nig, fm = gid * WGM, gsz = (nM - fm) < WGM ? (nM - fm) : WGM;
        const int pm_f = fm + ((wgid % nig) % gsz), pn_f = (wgid % nig) / gsz;
        const int nts = ntK / S;
        const int pm = full ? pm_f : nM, pn = full ? pn_f : (j % nN), k0 = full ? 0 : (j / nN) * nts, nt = full ? ntK : nts, half = full ? 0 : 1;
        u = Unit{pm, pn, k0, nt, half}; return true;
    }
    __device__ __forceinline__ void a_ready(const Unit&) const {}
    __device__ __forceinline__ void done(const Unit&) const {}
};

__device__ __forceinline__ unsigned cvt_pk_bf16(float lo, float hi) { unsigned r; asm volatile("v_cvt_pk_bf16_f32 %0, %1, %2" : "=v"(r) : "v"(lo), "v"(hi)); return r; }
typedef float f32x2 __attribute__((ext_vector_type(2)));
template <class Epi, class Sched, bool ALIGN_EPI = false, bool SP2 = false>
__device__ __forceinline__ void gemm_phase(PG8_LAS unsigned char* lds, const Gemm g, const Sched& S, const Epi& E) {
    int tid_ = threadIdx.x; asm volatile("" : "+v"(tid_));
    const int tid = tid_, wid = __builtin_amdgcn_readfirstlane(tid >> 6), lane = tid & 63, wr = wid >> 2, wc = wid & 3, fr = lane & 15, fq = lane >> 4;
    const int K = g.K;
    unsigned voffA[2], voffB[2];
#pragma unroll
    for (int i = 0; i < 2; ++i) { int R, C; stage_rc(tid * 16 + i * 8192, R, C); const int Rb = Epi::PERM ? ((R & ~31) + perm32(R & 31)) : R;
        voffA[i] = (unsigned)(R * K + C) * 2u; voffB[i] = (unsigned)(Rb * K + C) * 2u; }
    const size_t kstep = (size_t)(BK * 2);
    const size_t hstep = (size_t)HALF * K * 2;
    const size_t tstep = 2 * hstep;
    const unsigned ldsw = (unsigned)wid * 1024u;
    const int aoff = lds_byte(wr * 64 + fr, fq * 8), boff = lds_byte(wc * 32 + fr, fq * 8);
#define PG8_SA(b, h) (((b) * 2 + (h)) * HTB)
#define PG8_SB(b, h) ((4 + (b) * 2 + (h)) * HTB)
#define PG8_STAGE(bufoff, gbase, voff) do { _Pragma("unroll") for (int _i = 0; _i < 2; ++_i) \
        __builtin_amdgcn_global_load_lds((const unsigned*)((const char*)(gbase) + (voff)[_i]), (PG8_LAS unsigned*)(lds + (bufoff) + ldsw + _i * 8192), 16, 0, 0); } while (0)
#define PG8_LDA(dst, b, h) do { _Pragma("unroll") for (int m = 0; m < 4; ++m) _Pragma("unroll") for (int k = 0; k < 2; ++k) dst[m][k] = *(const PG8_LAS bf16x8*)(lds + PG8_SA(b, h) + aoff + m * 2048 + k * 1024); } while (0)
#define PG8_LDB(dst, b, h) do { _Pragma("unroll") for (int n = 0; n < 2; ++n) _Pragma("unroll") for (int k = 0; k < 2; ++k) dst[n][k] = *(const PG8_LAS bf16x8*)(lds + PG8_SB(b, h) + boff + n * 2048 + k * 1024); } while (0)
#define PG8_MMA(ai, bj, At, Bt) do { __builtin_amdgcn_s_setprio(1); _Pragma("unroll") for (int m = 0; m < 4; ++m) _Pragma("unroll") for (int n = 0; n < 2; ++n) _Pragma("unroll") for (int k = 0; k < 2; ++k) \
        acc[ai][bj][m][n] = __builtin_amdgcn_mfma_f32_16x16x32_bf16(Bt[n][k], At[m][k], acc[ai][bj][m][n], 0, 0, 0); __builtin_amdgcn_s_setprio(0); } while (0)
#define PG8_WAIT_V(n) asm volatile("s_waitcnt vmcnt(" #n ")" ::: "memory")
#define PG8_WAIT_L(n) asm volatile("s_waitcnt lgkmcnt(" #n ")" ::: "memory")
#define PG8_BAR __builtin_amdgcn_s_barrier()
#define PG8_SCHED __builtin_amdgcn_sched_barrier(0)
    Unit cur, nxt; int ui = 0;
    if (!S.next(0, cur)) return;
    f32x4 acc[2][2][4][2];
#pragma unroll
    for (int a = 0; a < 2; ++a)
#pragma unroll
        for (int b = 0; b < 2; ++b)
#pragma unroll
            for (int m = 0; m < 4; ++m)
#pragma unroll
                for (int n = 0; n < 2; ++n) acc[a][b][m][n] = (f32x4){0.f, 0.f, 0.f, 0.f};
    bf16x8 At[4][2], B0[2][2], B1[2][2];
    const char* cA = (const char*)g.A + (size_t)cur.pm * tstep + (size_t)cur.k0 * kstep; const char* cB = (const char*)g.Bt + (size_t)cur.pn * tstep + (size_t)cur.k0 * kstep;
    S.a_ready(cur);
    if constexpr (SP2) {
        PG8_STAGE(PG8_SB(0, 0), cB, voffB); PG8_STAGE(PG8_SB(0, 1), cB + hstep, voffB); PG8_STAGE(PG8_SA(0, 0), cA, voffA); PG8_STAGE(PG8_SA(0, 1), cA + hstep, voffA);
        if (wr == 1) PG8_BAR;
        PG8_WAIT_V(2); PG8_BAR;
        PG8_STAGE(PG8_SB(1, 0), cB + kstep, voffB); PG8_STAGE(PG8_SA(1, 0), cA + kstep, voffA); PG8_STAGE(PG8_SB(1, 1), cB + hstep + kstep, voffB);
        PG8_WAIT_V(6); PG8_BAR;
    } else {
        PG8_STAGE(PG8_SB(0, 0), cB, voffB); PG8_STAGE(PG8_SA(0, 0), cA, voffA); PG8_STAGE(PG8_SB(0, 1), cB + hstep, voffB); PG8_STAGE(PG8_SA(0, 1), cA + hstep, voffA);
        if (wr == 1) PG8_BAR;
        PG8_WAIT_V(4); PG8_BAR;
        PG8_STAGE(PG8_SB(1, 0), cB + kstep, voffB); PG8_STAGE(PG8_SA(1, 0), cA + kstep, voffA); PG8_STAGE(PG8_SB(1, 1), cB + hstep + kstep, voffB);
        PG8_WAIT_V(6); PG8_BAR;
    }
    for (;;) {
        const bool has_next = S.next(ui + 1, nxt);
        const char* nA = has_next ? (const char*)g.A + (size_t)nxt.pm * tstep + (size_t)nxt.k0 * kstep : cA; const char* nB = has_next ? (const char*)g.Bt + (size_t)nxt.pn * tstep + (size_t)nxt.k0 * kstep : cB;
        const int nt = cur.nt; const bool fullrows = (cur.half == 0);
        for (int t = 0; t < nt; t += 2) {
            const bool last = (t == nt - 2);
            const char* a1 = cA + (size_t)(t + 1) * kstep;
            const char* a2 = last ? nA : cA + (size_t)(t + 2) * kstep; const char* b2 = last ? nB : cB + (size_t)(t + 2) * kstep;
            const char* a3 = a2 + kstep; const char* b3 = b2 + kstep;
            if (last && has_next) S.a_ready(nxt);
            if constexpr (SP2) {
            PG8_LDB(B0, 0, 0); PG8_LDB(B1, 0, 1); PG8_SCHED; PG8_LDA(At, 0, 0); PG8_STAGE(PG8_SA(1, 1), a1 + hstep, voffA);
            PG8_WAIT_V(8); PG8_WAIT_L(0); PG8_BAR; PG8_MMA(0, 0, At, B0); PG8_MMA(0, 1, At, B1); PG8_BAR; PG8_SCHED;
            PG8_LDA(At, 0, 1); PG8_STAGE(PG8_SB(0, 0), b2, voffB); PG8_STAGE(PG8_SB(0, 1), b2 + hstep, voffB); PG8_STAGE(PG8_SA(0, 0), a2, voffA);
            PG8_WAIT_V(8); PG8_WAIT_L(0); PG8_BAR; if (fullrows) { PG8_MMA(1, 0, At, B0); PG8_MMA(1, 1, At, B1); } PG8_BAR; PG8_SCHED;
            PG8_LDB(B0, 1, 0); PG8_LDB(B1, 1, 1); PG8_SCHED; PG8_LDA(At, 1, 0); PG8_STAGE(PG8_SA(0, 1), a2 + hstep, voffA);
            PG8_WAIT_V(8); PG8_WAIT_L(0); PG8_BAR; PG8_MMA(0, 0, At, B0); PG8_MMA(0, 1, At, B1); PG8_BAR; PG8_SCHED;
            PG8_LDA(At, 1, 1); PG8_STAGE(PG8_SB(1, 0), b3, voffB); PG8_STAGE(PG8_SB(1, 1), b3 + hstep, voffB); PG8_STAGE(PG8_SA(1, 0), a3, voffA);
            PG8_WAIT_V(8); PG8_WAIT_L(0); PG8_BAR; if (fullrows) { PG8_MMA(1, 0, At, B0); PG8_MMA(1, 1, At, B1); } PG8_BAR; PG8_SCHED;
            } else {
            PG8_LDB(B0, 0, 0); PG8_SCHED; PG8_LDA(At, 0, 0); PG8_STAGE(PG8_SA(1, 1), a1 + hstep, voffA);
            PG8_WAIT_L(8); PG8_BAR; PG8_WAIT_L(0); PG8_MMA(0, 0, At, B0); PG8_BAR; PG8_SCHED;
            PG8_LDB(B1, 0, 1); PG8_STAGE(PG8_SB(0, 0), b2, voffB);
            PG8_BAR; PG8_WAIT_L(0); PG8_MMA(0, 1, At, B1); PG8_BAR;
            PG8_LDA(At, 0, 1); PG8_STAGE(PG8_SA(0, 0), a2, voffA);
            PG8_BAR; PG8_WAIT_L(0); if (fullrows) PG8_MMA(1, 0, At, B0); PG8_BAR; PG8_SCHED;
            PG8_STAGE(PG8_SB(0, 1), b2 + hstep, voffB);
            PG8_WAIT_V(6); PG8_BAR; if (fullrows) PG8_MMA(1, 1, At, B1); PG8_BAR;
            PG8_LDB(B0, 1, 0); PG8_SCHED; PG8_LDA(At, 1, 0); PG8_STAGE(PG8_SA(0, 1), a2 + hstep, voffA);
            PG8_WAIT_L(8); PG8_BAR; PG8_WAIT_L(0); PG8_MMA(0, 0, At, B0); PG8_BAR; PG8_SCHED;
            PG8_LDB(B1, 1, 1); PG8_STAGE(PG8_SB(1, 0), b3, voffB);
            PG8_BAR; PG8_WAIT_L(0); PG8_MMA(0, 1, At, B1); PG8_BAR;
            PG8_LDA(At, 1, 1); PG8_STAGE(PG8_SA(1, 0), a3, voffA);
            PG8_BAR; PG8_WAIT_L(0); if (fullrows) PG8_MMA(1, 0, At, B0); PG8_BAR; PG8_SCHED;
            PG8_STAGE(PG8_SB(1, 1), b3 + hstep, voffB);
            PG8_WAIT_V(6); PG8_BAR; if (fullrows) PG8_MMA(1, 1, At, B1); PG8_BAR;
            }
        }
        if constexpr (ALIGN_EPI) { if (wr == 0) PG8_BAR; }
        if constexpr (!Epi::AFTER_DRAIN) { E(acc, cur, wr, wc, fr, fq); S.done(cur); }
        if (!has_next) break;
#pragma unroll
        for (int a = 0; a < 2; ++a)
#pragma unroll
            for (int b = 0; b < 2; ++b)
#pragma unroll
                for (int m = 0; m < 4; ++m)
#pragma unroll
                    for (int n = 0; n < 2; ++n) acc[a][b][m][n] = (f32x4){0.f, 0.f, 0.f, 0.f};
        cur = nxt; cA = nA; cB = nB; ++ui;
        if constexpr (ALIGN_EPI) { if (wr == 1) PG8_BAR; }
    }
    PG8_WAIT_V(0);
    if constexpr (!ALIGN_EPI) { if (wr == 0) PG8_BAR; }
    PG8_BAR;
    if constexpr (Epi::AFTER_DRAIN) { E.fused(acc, cur, wr, wc, fr, fq, lds, wid, lane); S.done(cur); }
#undef PG8_SA
#undef PG8_SB
#undef PG8_STAGE
#undef PG8_LDA
#undef PG8_LDB
#undef PG8_MMA
#undef PG8_WAIT_V
#undef PG8_WAIT_L
#undef PG8_BAR
#undef PG8_SCHED
}
}

constexpr int D = 2048, NB = 4, SEQ = 4096, DEPTH = 4, NSB = 8, SSEQ = 16;
constexpr int MPR = NB * SEQ;
constexpr int MS = NSB * SSEQ;
constexpr int M = MPR + MS;
constexpr int MP = 16640;
constexpr int NIN = 20496, NINP = 20736;
constexpr int DFF = 8192;
constexpr int ZQK = 0, ZVA = 4096, ZOA = 6144, ZQB = 8192, ZFB = 10240, ZIB = 12288, ZOGB = 14336, ZGA = 16384, ZGB = 18432, ZGT = 20480;
constexpr int MODW = 6 * D;
constexpr float EPS = 1e-6f;
constexpr int NCHUNKS = NB * (SEQ / 64) + NSB;

__device__ __forceinline__ int row_batch(int r) { int b = r < MPR ? (r >> 12) : 4 + ((r - MPR) >> 4); return b > 11 ? 11 : b; }
__device__ __forceinline__ float bf2f(unsigned short b) { return __uint_as_float(((unsigned)b) << 16); }
__device__ __forceinline__ float sigm(float x) { return __builtin_amdgcn_rcpf(1.0f + __expf(-x)); }

namespace pg8 {
__device__ __forceinline__ void unpack8(const u32x4 w, float (&f)[8]) {
    f[0] = __uint_as_float(w.x << 16); f[1] = __uint_as_float(w.x & 0xffff0000u); f[2] = __uint_as_float(w.y << 16); f[3] = __uint_as_float(w.y & 0xffff0000u);
    f[4] = __uint_as_float(w.z << 16); f[5] = __uint_as_float(w.z & 0xffff0000u); f[6] = __uint_as_float(w.w << 16); f[7] = __uint_as_float(w.w & 0xffff0000u);
}
struct EpiZ {
    static constexpr bool PERM = true, AFTER_DRAIN = false;
    bf16_t* Z; const float* bias; float* G;
    __device__ __forceinline__ void operator()(const f32x4 (&acc)[2][2][4][2], const Unit& u, int wr, int wc, int fr, int fq) const {
        const int row0 = u.pm * BM + wr * 64 + fr, col0 = u.pn * BM + wc * 32 + 8 * fq;
        const bool gates = (u.pn == 80) && (wc == 0) && (fq < 2);
#pragma unroll
        for (int bj = 0; bj < 2; ++bj) {
            const f32x4 b0 = *(const f32x4*)(bias + col0 + bj * HALF), b1 = *(const f32x4*)(bias + col0 + bj * HALF + 4);
#pragma unroll
            for (int ai = 0; ai < 2; ++ai)
#pragma unroll
                for (int m = 0; m < 4; ++m) { const int row = row0 + ai * HALF + m * 16; bf16_t* rowp = Z + (size_t)row * NINP + col0;
                    const f32x4 v0 = acc[ai][bj][m][0] + b0, v1 = acc[ai][bj][m][1] + b1;
                    u32x4 w; w.x = cvt_pk_bf16(v0[0], v0[1]); w.y = cvt_pk_bf16(v0[2], v0[3]); w.z = cvt_pk_bf16(v1[0], v1[1]); w.w = cvt_pk_bf16(v1[2], v1[3]);
                    *(u32x4*)(rowp + bj * HALF) = w;
                    if (bj == 0 && gates) { float* gp = G + (size_t)row * 16 + 8 * fq; *(f32x4*)gp = v0; *(f32x4*)(gp + 4) = v1; } }
        }
    }
};
struct EpiGateTmp {
    static constexpr bool PERM = true, AFTER_DRAIN = false;
    const bf16_t* Zg; float* T;
    __device__ __forceinline__ void operator()(const f32x4 (&acc)[2][2][4][2], const Unit& u, int wr, int wc, int fr, int fq) const {
        const int row0 = u.pm * BM + wr * 64 + fr, col0 = u.pn * BM + wc * 32 + 8 * fq;
#pragma unroll
        for (int ai = 0; ai < 2; ++ai)
#pragma unroll
            for (int m = 0; m < 4; ++m) { const int row = row0 + ai * HALF + m * 16;
#pragma unroll
                for (int bj = 0; bj < 2; ++bj) { const int c = col0 + bj * HALF; float gz[8]; unpack8(*(const u32x4*)(Zg + (size_t)row * NINP + c), gz);
                    f32x4 v0 = acc[ai][bj][m][0], v1 = acc[ai][bj][m][1];
#pragma unroll
                    for (int j = 0; j < 4; ++j) { v0[j] *= sigm(gz[j]); v1[j] *= sigm(gz[4 + j]); }
                    float* tp = T + (size_t)row * D + c; *(f32x4*)tp = v0; *(f32x4*)(tp + 4) = v1; } }
    }
};
struct EpiMerge {
    static constexpr bool PERM = true, AFTER_DRAIN = false;
    const bf16_t* Zg; const float* T; bf16_t* O;
    __device__ __forceinline__ void operator()(const f32x4 (&acc)[2][2][4][2], const Unit& u, int wr, int wc, int fr, int fq) const {
        const int row0 = u.pm * BM + wr * 64 + fr, col0 = u.pn * BM + wc * 32 + 8 * fq;
#pragma unroll
        for (int ai = 0; ai < 2; ++ai)
#pragma unroll
            for (int m = 0; m < 4; ++m) { const int row = row0 + ai * HALF + m * 16;
#pragma unroll
                for (int bj = 0; bj < 2; ++bj) { const int c = col0 + bj * HALF; float gz[8]; unpack8(*(const u32x4*)(Zg + (size_t)row * NINP + c), gz);
                    const float* tp = T + (size_t)row * D + c; f32x4 v0 = *(const f32x4*)tp, v1 = *(const f32x4*)(tp + 4);
#pragma unroll
                    for (int j = 0; j < 4; ++j) { v0[j] += acc[ai][bj][m][0][j] * sigm(gz[j]); v1[j] += acc[ai][bj][m][1][j] * sigm(gz[4 + j]); }
                    u32x4 w; w.x = cvt_pk_bf16(v0[0], v0[1]); w.y = cvt_pk_bf16(v0[2], v0[3]); w.z = cvt_pk_bf16(v1[0], v1[1]); w.w = cvt_pk_bf16(v1[2], v1[3]);
                    *(u32x4*)(O + (size_t)row * D + c) = w; } }
    }
};
struct EpiResid {
    static constexpr bool PERM = false, AFTER_DRAIN = false;
    float* X; const float* gate;
    __device__ __forceinline__ void operator()(const f32x4 (&acc)[2][2][4][2], const Unit& u, int wr, int wc, int fr, int fq) const {
        const int row0 = u.pm * BM + wr * 64 + fr, col0 = u.pn * BM + wc * 32 + 4 * fq;
#pragma unroll
        for (int ai = 0; ai < 2; ++ai)
#pragma unroll
            for (int m = 0; m < 4; ++m) { const int row = row0 + ai * HALF + m * 16; const float* gp = gate + (size_t)row_batch(row) * MODW + col0; float* xp = X + (size_t)row * D + col0;
#pragma unroll
                for (int bj = 0; bj < 2; ++bj)
#pragma unroll
                    for (int n = 0; n < 2; ++n) { const int o = bj * HALF + n * 16; const f32x4 gv = *(const f32x4*)(gp + o);
                        if (!u.half) { const f32x4 xv = *(const f32x4*)(xp + o); *(f32x4*)(xp + o) = xv + gv * acc[ai][bj][m][n]; }
                        else if (ai == 0) { const f32x4 d = gv * acc[ai][bj][m][n];
#pragma unroll
                            for (int e = 0; e < 4; ++e) __hip_atomic_fetch_add(xp + o + e, d[e], __ATOMIC_RELAXED, __HIP_MEMORY_SCOPE_AGENT); } }
                asm volatile("" ::: "memory"); }
    }
};
struct EpiRelu2 {
    static constexpr bool PERM = true, AFTER_DRAIN = false;
    bf16_t* O; int ldc;
    __device__ __forceinline__ void operator()(const f32x4 (&acc)[2][2][4][2], const Unit& u, int wr, int wc, int fr, int fq) const {
        const int row0 = u.pm * BM + wr * 64 + fr, col0 = u.pn * BM + wc * 32 + 8 * fq;
#pragma unroll
        for (int ai = 0; ai < 2; ++ai)
#pragma unroll
            for (int m = 0; m < 4; ++m) { bf16_t* rowp = O + (size_t)(row0 + ai * HALF + m * 16) * ldc + col0;
#pragma unroll
                for (int bj = 0; bj < 2; ++bj) { f32x4 v0 = acc[ai][bj][m][0], v1 = acc[ai][bj][m][1];
#pragma unroll
                    for (int j = 0; j < 4; ++j) { const float a = fmaxf(v0[j], 0.f), b = fmaxf(v1[j], 0.f); v0[j] = a * a; v1[j] = b * b; }
                    u32x4 w; w.x = cvt_pk_bf16(v0[0], v0[1]); w.y = cvt_pk_bf16(v0[2], v0[3]); w.z = cvt_pk_bf16(v1[0], v1[1]); w.w = cvt_pk_bf16(v1[2], v1[3]);
                    *(u32x4*)(rowp + bj * HALF) = w; } }
    }
};
}

constexpr size_t MiB = 1u << 20;
constexpr size_t WS_CTL = 0, CTL_ZERO_BYTES = 1 * MiB;
constexpr size_t WS_MOD = 1 * MiB;
constexpr size_t WS_LB = 4 * MiB;
constexpr size_t WS_BIN = 4 * MiB + 65536;
constexpr size_t WS_E1 = 5 * MiB, WS_E2 = 8 * MiB;
constexpr size_t WS_G = 11 * MiB;
constexpr size_t WS_W = 16 * MiB;
constexpr size_t W_WIN = 0, W_WBA = 81 * MiB, W_WBB = 89 * MiB, W_WO = 97 * MiB, W_WUP = 105 * MiB, W_WDN = 137 * MiB, W_LAYER = 169 * MiB;
constexpr size_t WS_X = 692 * MiB;
constexpr size_t WS_H = 822 * MiB;
constexpr size_t WS_Z = 887 * MiB;
constexpr size_t WS_QA = 1546 * MiB;
constexpr size_t WS_KA = 1611 * MiB;
constexpr size_t WS_QB = 1676 * MiB;
constexpr size_t WS_KB = 1741 * MiB;
constexpr size_t WS_HA = 1806 * MiB;
constexpr size_t WS_HB = 1936 * MiB;
constexpr size_t WS_GP = 2066 * MiB;
constexpr size_t WS_END = 2072 * MiB;
static_assert((size_t)NINP * D * 2 <= 81 * MiB && (size_t)MP * NINP * 2 <= (WS_QA - WS_Z) && (size_t)MP * D * 2 == 65 * MiB && WS_W + 4 * W_LAYER <= WS_X, "ws map");
constexpr int CW_BAR = 4096;

constexpr size_t O_YP = 0, O_YS = O_YP + (size_t)MPR * D, O_CONVP = O_YS + (size_t)MS * D, O_CP = O_CONVP + (size_t)DEPTH * NB * 3 * 4096,
    O_NP = O_CP + (size_t)DEPTH * NB * 8 * 65536, O_MP = O_NP + (size_t)DEPTH * NB * 8 * 256, O_SP = O_MP + (size_t)DEPTH * NB * 8,
    O_CONVS = O_SP + (size_t)DEPTH * NB * 16 * 16384, O_CS = O_CONVS + (size_t)DEPTH * NSB * 3 * 4096, O_NS = O_CS + (size_t)DEPTH * NSB * 8 * 65536,
    O_MS = O_NS + (size_t)DEPTH * NSB * 8 * 256, O_SS = O_MS + (size_t)DEPTH * NSB * 8, O_END = O_SS + (size_t)DEPTH * NSB * 16 * 16384;

constexpr int RING_OFF = 0, RING_BYTES = 131072;
constexpr int LDS_BYTES = 155648;
constexpr int MISC_OFF = LDS_BYTES - 256;
constexpr int SC_Q = 0, SC_K = 33792, SC_VT = 67584, SC_VW = 79104, SC_CT = 90624, SC_P = 132864, SC_H = 142080, SC_END = 151296;
constexpr int LQB = 528;
constexpr int LVB = 144;
constexpr int HS_Q = 0, HS_K = 17408, HS_VT = 34816, HS_ST = 44032, HS_P = 61440, HS_H = 70656;
constexpr int LHB = 272;
static_assert(SC_END <= MISC_OFF, "LDS map");

#define GAS __attribute__((address_space(1)))
#define LAS __attribute__((address_space(3)))
#define DI __device__ __forceinline__
typedef unsigned short bf16;
typedef float f32x4 __attribute__((ext_vector_type(4)));
typedef unsigned u32x2 __attribute__((ext_vector_type(2)));
typedef unsigned u32x4 __attribute__((ext_vector_type(4)));
typedef short bf16x8 __attribute__((ext_vector_type(8)));
typedef GAS unsigned gu32;
#define RLX_AGENT __ATOMIC_RELAXED, __HIP_MEMORY_SCOPE_AGENT
#define LDS_WAIT() asm volatile("s_waitcnt lgkmcnt(0)" ::: "memory")
#define VM_WAIT() asm volatile("s_waitcnt vmcnt(0)" ::: "memory")
DI unsigned f2bf(float f) { unsigned u = __float_as_uint(f); return (u + 0x7fffu + ((u >> 16) & 1u)) >> 16; }
DI unsigned pk2(float lo, float hi) { return f2bf(lo) | (f2bf(hi) << 16); }
DI float wave_sum(float v) {
#pragma unroll
    for (int o = 1; o < 64; o <<= 1) v += __shfl_xor(v, o);
    return v;
}
DI unsigned cvtpk(float lo, float hi) { unsigned r; asm volatile("v_cvt_pk_bf16_f32 %0, %1, %2" : "=v"(r) : "v"(lo), "v"(hi)); return r; }
DI float logsig(float x) { return fminf(x, 0.f) - __logf(1.0f + __expf(-fabsf(x))); }
#define XB_TMO      128
#define XB_XCNT(j)  (256  + 64 * (j))
#define XB_XSUB(j)  (1280 + 64 * (j))
#define XB_XGEN(j)  (2304 + 64 * (j))
#define XB_TOP      3328
#define XB_TOPGEN   3392
#define XCD_BAR_WORDS 3456
#define XB_SPIN_CAP (1u << 18)

__device__ __forceinline__ unsigned xb_ld(unsigned* p)              { return __hip_atomic_load(p, __ATOMIC_RELAXED, __HIP_MEMORY_SCOPE_AGENT); }
__device__ __forceinline__ unsigned xb_add(unsigned* p, unsigned v) { return __hip_atomic_fetch_add(p, v, __ATOMIC_RELAXED, __HIP_MEMORY_SCOPE_AGENT); }
__device__ __forceinline__ unsigned xb_xcc_id() { return (unsigned)__builtin_amdgcn_s_getreg((3 << 11) | 20) & 0xFu; }
#define XB_SPIN(cond, bar) do { unsigned _sp = 0; while (cond) { __builtin_amdgcn_s_sleep(1); \
    if ((++_sp & 255u) == 0u) { if (xb_ld(&(bar)[XB_TMO])) break; if (_sp > XB_SPIN_CAP) { atomicAdd(&(bar)[XB_TMO], 1u); break; } } } } while (0)

__device__ __forceinline__ bool xb_tid0() { int t = threadIdx.x; asm volatile("" : "+v"(t)); return t == 0; }
struct XcdBarrier {
    unsigned* bar; unsigned x;
    volatile LAS unsigned* st;
};

__device__ __forceinline__ XcdBarrier xcd_barrier_post(unsigned* bar, volatile LAS unsigned* st) {
    XcdBarrier b; b.bar = bar; b.x = xb_xcc_id(); b.st = st;
    if (xb_tid0()) (void)xb_add(&bar[XB_XCNT(b.x)], 1u);
    return b;
}
__device__ __forceinline__ void xcd_barrier_complete(unsigned* bar, unsigned x, unsigned& nloc, unsigned& nx) {
    const unsigned G = gridDim.x * gridDim.y * gridDim.z;
    unsigned sum, cnt, mine, sp = 0u;
    for (;;) {
        sum = 0u; cnt = 0u; mine = 0u;
#pragma unroll
        for (unsigned j = 0; j < 16; ++j) { const unsigned c = xb_ld(&bar[XB_XCNT(j)]); sum += c; cnt += (c > 0u) ? 1u : 0u; mine = (j == x) ? c : mine; }
        if (sum == G) break;
        __builtin_amdgcn_s_sleep(1);
        if ((++sp & 255u) == 0u) { if (xb_ld(&bar[XB_TMO])) break; if (sp > XB_SPIN_CAP) { atomicAdd(&bar[XB_TMO], 1u); break; } }
    }
    nloc = mine > 0u ? mine : 1u; nx = cnt > 0u ? cnt : 1u;
}

__device__ __forceinline__ void xcd_barrier(const XcdBarrier& b) {
    asm volatile("s_waitcnt vmcnt(0)" ::: "memory");
    __syncthreads();
    if (xb_tid0()) {
        unsigned* bar = b.bar;
        __builtin_amdgcn_s_waitcnt(0);
        unsigned nloc = b.st[0], nx = b.st[1];
        if (nloc == 0u) { xcd_barrier_complete(bar, b.x, nloc, nx); b.st[0] = nloc; b.st[1] = nx; }
        const unsigned old = xb_add(&bar[XB_XSUB(b.x)], 1u);
        const unsigned gen = old / nloc;
        if (old + 1u == (gen + 1u) * nloc) {
            __builtin_amdgcn_fence(__ATOMIC_RELEASE, "agent");
            asm volatile("s_waitcnt vmcnt(0)" ::: "memory");
            const unsigned og = xb_add(&bar[XB_TOP], 1u);
            const unsigned tg = og / nx;
            if (og + 1u == (tg + 1u) * nx) xb_add(&bar[XB_TOPGEN], 1u);
            else XB_SPIN(xb_ld(&bar[XB_TOPGEN]) == tg, bar);
            __builtin_amdgcn_fence(__ATOMIC_ACQUIRE, "agent");
            xb_add(&bar[XB_XGEN(b.x)], 1u);
            asm volatile("s_waitcnt vmcnt(0)" ::: "memory");
        } else {
            XB_SPIN(xb_ld(&bar[XB_XGEN(b.x)]) == gen, bar);
            __builtin_amdgcn_fence(__ATOMIC_ACQUIRE, "agent");
            asm volatile("s_waitcnt vmcnt(0)" ::: "memory");
        }
    }
    __syncthreads();
}

struct Ctx { LAS unsigned char* lds; unsigned char* ws; const float* const* in; float* out; int tid, lane, wave, G, bid; };

DI void p0_transpose_item(const float* W, int K, int Nsrc, int Npad, bf16* WT, LAS float* scr, int item, int lane) {
    const int nblk = Npad / 64, kb = item / nblk, nb = item % nblk, k0 = 64 * kb, n0 = 64 * nb;
    const int nq = lane & 15, kr = lane >> 4; const int n = n0 + 4 * nq; const bool ok = n < Nsrc;
    f32x4 v[16];
#pragma unroll
    for (int i = 0; i < 16; ++i) v[i] = ok ? *(const GAS f32x4*)(W + (size_t)(k0 + 4 * i + kr) * Nsrc + n) : (f32x4){0.f, 0.f, 0.f, 0.f};
#pragma unroll
    for (int i = 0; i < 16; ++i) { LAS float* s = scr + (4 * i + kr) * 65 + 4 * nq; s[0] = v[i].x; s[1] = v[i].y; s[2] = v[i].z; s[3] = v[i].w; }
    LDS_WAIT(); asm volatile("" ::: "memory");
#pragma unroll
    for (int j = 0; j < 8; ++j) { const int pr = lane + 64 * j, nn = pr >> 3, c = pr & 7; const LAS float* s = scr + (8 * c) * 65 + nn;
        u32x4 o; o.x = pk2(s[0 * 65], s[1 * 65]); o.y = pk2(s[2 * 65], s[3 * 65]); o.z = pk2(s[4 * 65], s[5 * 65]); o.w = pk2(s[6 * 65], s[7 * 65]);
        *(GAS u32x4*)(WT + (size_t)(n0 + nn) * K + k0 + 8 * c) = o; }
    LDS_WAIT(); asm volatile("" ::: "memory");
}

DI void p0_prologue(const Ctx& F) {
    const float* const* in = F.in;
    const int gw = F.bid * 8 + F.wave, NGW = F.G * 8;
    const int gt = F.bid * 512 + F.tid, NGT = F.G * 512;
    {
        LAS float* scr = (LAS float*)(F.lds + F.wave * 16640);
        constexpr int I0 = 32 * (NINP / 64), I1 = 32 * 32, I4 = 32 * 128, I5 = 128 * 32, IL = I0 + 3 * I1 + I4 + I5;
        for (int it = gw; it < DEPTH * IL; it += NGW) {
            const int l = it / IL; int r = it % IL;
            unsigned char* wl = F.ws + WS_W + (size_t)l * W_LAYER;
            if (r < I0) { p0_transpose_item(in[13] + (size_t)l * D * NIN, D, NIN, NINP, (bf16*)(wl + W_WIN), scr, r, F.lane); continue; } r -= I0;
            if (r < I1) { p0_transpose_item(in[20] + (size_t)l * D * D, D, D, D, (bf16*)(wl + W_WBA), scr, r, F.lane); continue; } r -= I1;
            if (r < I1) { p0_transpose_item(in[21] + (size_t)l * D * D, D, D, D, (bf16*)(wl + W_WBB), scr, r, F.lane); continue; } r -= I1;
            if (r < I1) { p0_transpose_item(in[22] + (size_t)l * D * D, D, D, D, (bf16*)(wl + W_WO), scr, r, F.lane); continue; } r -= I1;
            if (r < I4) { p0_transpose_item(in[23] + (size_t)l * D * DFF, D, DFF, DFF, (bf16*)(wl + W_WUP), scr, r, F.lane); continue; } r -= I4;
            p0_transpose_item(in[24] + (size_t)l * DFF * D, DFF, D, D, (bf16*)(wl + W_WDN), scr, r, F.lane);
        }
    }
    __syncthreads();
    {
        LAS float* csT = (LAS float*)F.lds;
        LAS float* red = (LAS float*)(F.lds + 98304);
        for (int i = F.tid; i < 12 * D; i += 512) { const int r = i / D, k = i % D; const float c = r < 4 ? in[7][r * D + k] : in[8][(r - 4) * D + k]; csT[k * 12 + r] = c * sigm(c); }
        __syncthreads();
        float* MOD = (float*)(F.ws + WS_MOD);
        for (int u = F.bid; u < DEPTH * (MODW / 64); u += F.G) {
            const int l = u / (MODW / 64), j = (u % (MODW / 64)) * 64 + F.lane;
            const float* wp = in[9] + (size_t)l * D * MODW + (size_t)(256 * F.wave) * MODW + j;
            float acc[12];
#pragma unroll
            for (int r = 0; r < 12; ++r) acc[r] = 0.f;
#pragma unroll 32
            for (int k = 0; k < 256; ++k) { const float w = wp[(size_t)k * MODW]; const LAS f32x4* cp = (const LAS f32x4*)(csT + (256 * F.wave + k) * 12);
                const f32x4 c0 = cp[0], c1 = cp[1], c2 = cp[2];
                acc[0] += c0[0] * w; acc[1] += c0[1] * w; acc[2] += c0[2] * w; acc[3] += c0[3] * w; acc[4] += c1[0] * w; acc[5] += c1[1] * w; acc[6] += c1[2] * w; acc[7] += c1[3] * w;
                acc[8] += c2[0] * w; acc[9] += c2[1] * w; acc[10] += c2[2] * w; acc[11] += c2[3] * w; }
#pragma unroll
            for (int r = 0; r < 12; ++r) red[(F.wave * 12 + r) * 64 + F.lane] = acc[r];
            __syncthreads();
            for (int i = F.tid; i < 12 * 64; i += 512) { const int r = i / 64, c = i % 64; float s = 0.f;
#pragma unroll
                for (int w = 0; w < 8; ++w) s += red[(w * 12 + r) * 64 + c];
                const int jj = (u % (MODW / 64)) * 64 + c; MOD[((size_t)l * 12 + r) * MODW + jj] = s + in[10][(size_t)l * MODW + jj]; }
            __syncthreads();
        }
    }
    {
        f32x4* X4 = (f32x4*)(F.ws + WS_X); const f32x4* xp = (const f32x4*)in[0]; const f32x4* xs = (const f32x4*)in[1];
        const size_t n_p = (size_t)MPR * D / 4, n_s = (size_t)MS * D / 4, n_all = (size_t)MP * D / 4;
        for (size_t i = gt; i < n_all; i += NGT) X4[i] = i < n_p ? xp[i] : (i < n_p + n_s ? xs[i - n_p] : (f32x4){0.f, 0.f, 0.f, 0.f});
        const size_t pad0 = (size_t)M * D * 2 / 16, pad1 = (size_t)MP * D * 2 / 16;
        u32x4* h4 = (u32x4*)(F.ws + WS_H); u32x4* a4 = (u32x4*)(F.ws + WS_QA); u32x4* b4 = (u32x4*)(F.ws + WS_KA);
        for (size_t i = pad0 + gt; i < pad1; i += NGT) { const u32x4 z = {0u, 0u, 0u, 0u}; h4[i] = z; a4[i] = z; b4[i] = z; }
    }
    {
        float* LB = (float*)(F.ws + WS_LB);
        for (int d = gt; d < 2048; d += NGT) { float r[4], mx = -1e30f;
#pragma unroll
            for (int l = 0; l < 4; ++l) { r[l] = in[18][l * 2048 + d]; mx = fmaxf(mx, r[l]); }
            float e[4], s = 0.f;
#pragma unroll
            for (int l = 0; l < 4; ++l) { e[l] = __expf(r[l] - mx); s += e[l]; }
            const float inv = 1.0f / s; float cum = 0.f;
#pragma unroll
            for (int l = 0; l < 4; ++l) { if (l > 0) cum += e[l] * inv; LB[l * 2048 + d] = cum; } }
        float* BIN = (float*)(F.ws + WS_BIN);
        for (int i = gt; i < DEPTH * NINP; i += NGT) { const int l = i / NINP, c = i % NINP; BIN[i] = c < NIN ? in[14][(size_t)l * NIN + c] : 0.f; }
    }
}

DI void norm_phase(const Ctx& F, const float* gain, const float* modl  , int sh_off, int sc_off) {
    const int gw = F.bid * 8 + F.wave, NGW = F.G * 8;
    const float* X = (const float*)(F.ws + WS_X); bf16* H = (bf16*)(F.ws + WS_H);
    for (int row = gw; row < M; row += NGW) {
        const GAS f32x4* xr = (const GAS f32x4*)(X + (size_t)row * D) + F.lane;
        f32x4 v[8]; float ss = 0.f;
#pragma unroll
        for (int j = 0; j < 8; ++j) { v[j] = xr[64 * j]; ss += (v[j].x * v[j].x + v[j].y * v[j].y) + (v[j].z * v[j].z + v[j].w * v[j].w); }
        const float rs = rsqrtf(wave_sum(ss) * (1.0f / D) + EPS);
        const float* mb = modl + (size_t)row_batch(row) * MODW;
        GAS u32x2* o8 = (GAS u32x2*)(H + (size_t)row * D) + F.lane;
#pragma unroll
        for (int j = 0; j < 8; ++j) { const int c = 4 * F.lane + 256 * j; const f32x4 g = *(const f32x4*)(gain + c), sc = *(const f32x4*)(mb + sc_off + c), sh = *(const f32x4*)(mb + sh_off + c);
            const f32x4 y = (v[j] * rs) * g * (sc + 1.0f) + sh; u32x2 w; w.x = pk2(y.x, y.y); w.y = pk2(y.z, y.w); o8[64 * j] = w; }
    }
}
DI void final_norm_phase(const Ctx& F) {
    const int gw = F.bid * 8 + F.wave, NGW = F.G * 8;
    const float* X = (const float*)(F.ws + WS_X); const float* gain = F.in[25];
    for (int row = gw; row < M; row += NGW) {
        const GAS f32x4* xr = (const GAS f32x4*)(X + (size_t)row * D) + F.lane;
        f32x4 v[8]; float ss = 0.f;
#pragma unroll
        for (int j = 0; j < 8; ++j) { v[j] = xr[64 * j]; ss += (v[j].x * v[j].x + v[j].y * v[j].y) + (v[j].z * v[j].z + v[j].w * v[j].w); }
        const float rs = rsqrtf(wave_sum(ss) * (1.0f / D) + EPS);
        GAS f32x4* o = (GAS f32x4*)(F.out + (size_t)row * D) + F.lane;
#pragma unroll
        for (int j = 0; j < 8; ++j) { const f32x4 g = *(const f32x4*)(gain + 4 * F.lane + 256 * j); o[64 * j] = (v[j] * rs) * g; }
    }
}

DI void prep_phase(const Ctx& F, int l) {
    const bf16* Z = (const bf16*)(F.ws + WS_Z);
    bf16* QA = (bf16*)(F.ws + WS_QA); bf16* KA = (bf16*)(F.ws + WS_KA); bf16* QB = (bf16*)(F.ws + WS_QB); bf16* KB = (bf16*)(F.ws + WS_KB);
    float* E1 = (float*)(F.ws + WS_E1); float* E2 = (float*)(F.ws + WS_E2);
    const float* LB = (const float*)(F.ws + WS_LB) + l * 2048;
    constexpr int NGC = 12, NCONV = M / 16, NHG = NCHUNKS * 8;
    const float* G = (const float*)(F.ws + WS_G); float* GP = (float*)(F.ws + WS_GP);
    const bool chainblk = F.bid < NGC && F.G > 2 * NGC;
    const int it_step = F.G > 2 * NGC ? (chainblk ? NGC + NCONV + NHG : F.G - NGC) : F.G;
    for (int it0 = F.bid; it0 < NGC + NCONV + NHG; it0 += it_step) {
        if (it0 < NGC) {
            const int chain = it0 * 8 + F.wave, lane = F.lane;
            const bool sample = chain >= 32; const int cc = sample ? chain - 32 : chain, b = cc >> 3, h = cc & 7;
            const int row0 = sample ? MPR + b * SSEQ : b * SEQ, nchunk = sample ? 1 : SEQ / 64, Tv = sample ? SSEQ : 64;
            float m_prev = sample ? F.in[5][((size_t)l * NSB + b) * 8 + h] : 0.f;
            for (int c = 0; c < nchunk; ++c) {
                const int r0 = row0 + 64 * c;
                const float igv = lane < Tv ? G[(size_t)(r0 + lane) * 16 + h] : -1e30f; const float lfv = lane < Tv ? logsig(G[(size_t)(r0 + lane) * 16 + 8 + h]) : 0.f;
                float bc = lfv;
#pragma unroll
                for (int o = 1; o < 64; o <<= 1) { const float y = __shfl_up(bc, o); if (lane >= o) bc += y; }
                float gm = igv - bc;
#pragma unroll
                for (int o = 1; o < 64; o <<= 1) { const float y = __shfl_up(gm, o); if (lane >= o) gm = fmaxf(gm, y); }
                const float mt = bc + fmaxf(gm, m_prev);
                const float winter = __expf(bc + m_prev - mt), enm = __expf(-mt);
                const float m_last = __shfl(mt, 63), b_last = __shfl(bc, 63);
                const float wlast = __expf(b_last - bc + igv - m_last);
                if (lane < Tv) { float* gp = GP + ((size_t)(r0 + lane) * 8 + h) * 8; *(f32x4*)gp = (f32x4){bc - mt, igv - bc, winter, enm}; *(f32x4*)(gp + 4) = (f32x4){wlast, mt, 0.f, 0.f}; }
                m_prev = m_last;
            }
            continue;
        }
        const int it = it0 - NGC;
        if (it < NCONV) {
            const int r0 = it * 16, c0 = 8 * F.tid; const bool sample = r0 >= MPR;
            const int t0 = sample ? 0 : (r0 & (SEQ - 1)); const int bs = sample ? (r0 - MPR) >> 4 : (r0 >> 12);
            float w[4][8], cb[8];
#pragma unroll
            for (int j = 0; j < 4; ++j) { const f32x4 a = *(const f32x4*)(F.in[15] + ((size_t)l * 4 + j) * 4096 + c0), b = *(const f32x4*)(F.in[15] + ((size_t)l * 4 + j) * 4096 + c0 + 4);
                w[j][0] = a.x; w[j][1] = a.y; w[j][2] = a.z; w[j][3] = a.w; w[j][4] = b.x; w[j][5] = b.y; w[j][6] = b.z; w[j][7] = b.w; }
            { const f32x4 a = *(const f32x4*)(F.in[16] + (size_t)l * 4096 + c0), b = *(const f32x4*)(F.in[16] + (size_t)l * 4096 + c0 + 4);
                cb[0] = a.x; cb[1] = a.y; cb[2] = a.z; cb[3] = a.w; cb[4] = b.x; cb[5] = b.y; cb[6] = b.z; cb[7] = b.w; }
            float z0[8], z1[8], z2[8];
            if (t0 == 0) {
                if (sample) { const float* cc = F.in[2] + (((size_t)l * NSB + bs) * 3) * 4096 + c0;
#pragma unroll
                    for (int e = 0; e < 8; ++e) { z0[e] = cc[e]; z1[e] = cc[4096 + e]; z2[e] = cc[8192 + e]; } }
                else {
#pragma unroll
                    for (int e = 0; e < 8; ++e) { z0[e] = 0.f; z1[e] = 0.f; z2[e] = 0.f; } }
            } else {
                pg8::unpack8(*(const u32x4*)(Z + (size_t)(r0 - 3) * NINP + c0), z0); pg8::unpack8(*(const u32x4*)(Z + (size_t)(r0 - 2) * NINP + c0), z1); pg8::unpack8(*(const u32x4*)(Z + (size_t)(r0 - 1) * NINP + c0), z2);
            }
            const bool last = sample || (t0 + 16 == SEQ);
            float* cout = F.out + (sample ? O_CONVS + (((size_t)l * NSB + bs) * 3) * 4096 : O_CONVP + (((size_t)l * NB + bs) * 3) * 4096) + c0;
#pragma unroll
            for (int rr = 0; rr < 16; ++rr) {
                float z3[8]; pg8::unpack8(*(const u32x4*)(Z + (size_t)(r0 + rr) * NINP + c0), z3);
                float y[8];
#pragma unroll
                for (int e = 0; e < 8; ++e) { const float a = cb[e] + w[0][e] * z0[e] + w[1][e] * z1[e] + w[2][e] * z2[e] + w[3][e] * z3[e]; y[e] = a * sigm(a); }
                if (c0 < 2048) { u32x4 o; o.x = pk2(y[0], y[1]); o.y = pk2(y[2], y[3]); o.z = pk2(y[4], y[5]); o.w = pk2(y[6], y[7]); *(u32x4*)(QA + (size_t)(r0 + rr) * D + c0) = o; }
                else { u32x4 o; o.x = pk2(y[0] * 0.0625f, y[1] * 0.0625f); o.y = pk2(y[2] * 0.0625f, y[3] * 0.0625f); o.z = pk2(y[4] * 0.0625f, y[5] * 0.0625f); o.w = pk2(y[6] * 0.0625f, y[7] * 0.0625f);
                    *(u32x4*)(KA + (size_t)(r0 + rr) * D + (c0 - 2048)) = o; }
                if (last && rr >= 13) { float* cp = cout + (size_t)(rr - 13) * 4096; *(f32x4*)cp = (f32x4){z3[0], z3[1], z3[2], z3[3]}; *(f32x4*)(cp + 4) = (f32x4){z3[4], z3[5], z3[6], z3[7]}; }
#pragma unroll
                for (int e = 0; e < 8; ++e) { z0[e] = z1[e]; z1[e] = z2[e]; z2[e] = z3[e]; }
            }
        } else {
            const int hi = it - NCONV, ci = hi >> 3, cbase = (hi & 7) * 256, d = F.tid & 255, hf = F.tid >> 8;
            const bool sample = ci >= NB * 64; const int r0 = sample ? MPR + (ci - NB * 64) * 16 : ci * 64; const int Tv = sample ? 16 : 64;
            LAS unsigned char* FBs = F.lds; LAS unsigned char* QBs = F.lds + 32768; LAS float* xch = (LAS float*)(F.lds + 65536);
#pragma unroll
            for (int i = 0; i < 4; ++i) { const int idx = F.tid + 512 * i, rr = idx >> 5, sg = idx & 31;
                if (rr < Tv) { *(LAS u32x4*)(FBs + rr * 512 + sg * 16) = *(const GAS u32x4*)(Z + (size_t)(r0 + rr) * NINP + ZFB + cbase + 8 * sg);
                               *(LAS u32x4*)(QBs + rr * 512 + sg * 16) = *(const GAS u32x4*)(Z + (size_t)(r0 + rr) * NINP + ZQB + cbase + 8 * sg); } }
            __syncthreads();
            const float lb = LB[cbase + d], oml = 1.0f - lb;
            float bc[32]; float run = 0.f;
#pragma unroll
            for (int i = 0; i < 32; ++i) { const int t = 32 * hf + i;
                if (t < Tv) { const float fb = fminf(fmaxf(bf2f(*(const LAS unsigned short*)(FBs + t * 512 + d * 2)), -30.f), 30.f); const float f = lb + oml * __builtin_amdgcn_rcpf(1.0f + __expf(-fb)); run += fmaxf(__logf(f), -60.0f); }
                bc[i] = run; }
            if (hf == 0) xch[d] = run;
            __syncthreads();
            const float base = hf ? xch[d] : 0.f; const float bR = hf ? base : run;
            if (hf) { E1[(size_t)ci * 2048 + cbase + d] = __expf(bR); E2[(size_t)ci * 2048 + cbase + d] = __expf(run); }
#pragma unroll
            for (int i = 0; i < 32; ++i) { const int t = 32 * hf + i;
                if (t < Tv) { const float fb = fminf(fmaxf(bf2f(*(const LAS unsigned short*)(FBs + t * 512 + d * 2)), -30.f), 30.f), qv = bf2f(*(const LAS unsigned short*)(QBs + t * 512 + d * 2));
                    const float e = __expf(-fb), s = __builtin_amdgcn_rcpf(1.0f + e), bt = base + bc[i];
                    const float q = qv * sigm(qv) * __expf(bt - bR), k = oml * e * s * __expf(bR - bt);
                    *(LAS unsigned short*)(QBs + t * 512 + d * 2) = (unsigned short)f2bf(q); *(LAS unsigned short*)(FBs + t * 512 + d * 2) = (unsigned short)f2bf(k); } }
            __syncthreads();
#pragma unroll
            for (int i = 0; i < 4; ++i) { const int idx = F.tid + 512 * i, rr = idx >> 5, sg = idx & 31;
                if (rr < Tv) { *(GAS u32x4*)(QB + (size_t)(r0 + rr) * D + cbase + 8 * sg) = *(const LAS u32x4*)(QBs + rr * 512 + sg * 16);
                               *(GAS u32x4*)(KB + (size_t)(r0 + rr) * D + cbase + 8 * sg) = *(const LAS u32x4*)(FBs + rr * 512 + sg * 16); } }
            __syncthreads();
        }
    }
}

DI void headnorm_phase(const Ctx& F, int l) {
    const int gw = F.bid * 8 + F.wave, NGW = F.G * 8;
    const bf16* Z = (const bf16*)(F.ws + WS_Z); const bf16* HA = (const bf16*)(F.ws + WS_HA); const bf16* HB = (const bf16*)(F.ws + WS_HB);
    bf16* YA = (bf16*)(F.ws + WS_QA); bf16* YB = (bf16*)(F.ws + WS_KA);
    const float* ga = F.in[17] + (size_t)l * 2048; const float* gb = F.in[19] + (size_t)l * 2048;
    for (int row = gw; row < M; row += NGW) {
        u32x4 ha[4], hb[4], oa[4], ob[4];
#pragma unroll
        for (int j = 0; j < 4; ++j) { const int c = 512 * j + 8 * F.lane;
            ha[j] = *(const GAS u32x4*)(HA + (size_t)row * D + c); hb[j] = *(const GAS u32x4*)(HB + (size_t)row * D + c);
            oa[j] = *(const GAS u32x4*)(Z + (size_t)row * NINP + ZOA + c); ob[j] = *(const GAS u32x4*)(Z + (size_t)row * NINP + ZOGB + c); }
#pragma unroll
        for (int j = 0; j < 4; ++j) { const int c = 512 * j + 8 * F.lane;
            { float hv[8], ov[8]; pg8::unpack8(ha[j], hv); pg8::unpack8(oa[j], ov); float ss = 0.f;
#pragma unroll
              for (int e = 0; e < 8; ++e) ss += hv[e] * hv[e];
#pragma unroll
              for (int o = 1; o < 32; o <<= 1) ss += __shfl_xor(ss, o);
              const float rs = rsqrtf(ss * (1.0f / 256.0f) + EPS); const f32x4 g0 = *(const f32x4*)(ga + c), g1 = *(const f32x4*)(ga + c + 4); float y[8];
#pragma unroll
              for (int e = 0; e < 8; ++e) y[e] = hv[e] * rs * (e < 4 ? g0[e] : g1[e - 4]) * sigm(ov[e]);
              u32x4 w; w.x = pk2(y[0], y[1]); w.y = pk2(y[2], y[3]); w.z = pk2(y[4], y[5]); w.w = pk2(y[6], y[7]); *(GAS u32x4*)(YA + (size_t)row * D + c) = w; }
            { float hv[8], ov[8]; pg8::unpack8(hb[j], hv); pg8::unpack8(ob[j], ov); float ss = 0.f;
#pragma unroll
              for (int e = 0; e < 8; ++e) ss += hv[e] * hv[e];
#pragma unroll
              for (int o = 1; o < 16; o <<= 1) ss += __shfl_xor(ss, o);
              const float rs = rsqrtf(ss * (1.0f / 128.0f) + EPS); const f32x4 g0 = *(const f32x4*)(gb + c), g1 = *(const f32x4*)(gb + c + 4); float y[8];
#pragma unroll
              for (int e = 0; e < 8; ++e) y[e] = hv[e] * rs * (e < 4 ? g0[e] : g1[e - 4]) * sigm(ov[e]);
              u32x4 w; w.x = pk2(y[0], y[1]); w.y = pk2(y[2], y[3]); w.z = pk2(y[4], y[5]); w.w = pk2(y[6], y[7]); *(GAS u32x4*)(YB + (size_t)row * D + c) = w; }
        }
    }
}

DI bf16x8 frag(const LAS unsigned char* base, int row, int ldb, int kbyte) { return *(const LAS bf16x8*)(base + row * ldb + kbyte); }
DI bf16x8 frag_t(const LAS unsigned char* base, int k0, int ldb, int col) {
    const LAS unsigned short* p = (const LAS unsigned short*)(base + k0 * ldb + col * 2); bf16x8 r;
#pragma unroll
    for (int j = 0; j < 8; ++j) r[j] = (short)p[j * (ldb / 2)];
    return r;
}
#define LBAR() do { asm volatile("s_waitcnt lgkmcnt(0)" ::: "memory"); __builtin_amdgcn_s_barrier(); asm volatile("" ::: "memory"); } while (0)
#define MFMA16(a, b, c) __builtin_amdgcn_mfma_f32_16x16x32_bf16((a), (b), (c), 0, 0, 0)

DI void mlstm_unit(LAS unsigned char* lds, const bf16* QA, const bf16* KA, const bf16* Z, const float* GP, bf16* HA,
                   int row0, int nchunk, int Tv, int h, int vs, const float* C0, const float* n0, const float* m0p, float* Cout, float* nout, float* mout) {
    int tid_ = threadIdx.x; asm volatile("" : "+v"(tid_));
    const int tid = tid_, lane = tid & 63, W = __builtin_amdgcn_readfirstlane(tid >> 6), g = lane >> 4, li = lane & 15;
    LAS unsigned char* Qs = lds + SC_Q; LAS unsigned char* Ks = lds + SC_K; LAS unsigned char* VT = lds + SC_VT; LAS unsigned char* VW = lds + SC_VW;
    LAS unsigned char* CTs = lds + SC_CT; LAS unsigned char* Ps = lds + SC_P; LAS unsigned char* Hs = lds + SC_H;
    f32x4 cacc[2][5];
#pragma unroll
    for (int di = 0; di < 2; ++di)
#pragma unroll
        for (int vi = 0; vi < 5; ++vi)
#pragma unroll
            for (int r = 0; r < 4; ++r) { const int d = 16 * (2 * W + di) + 4 * g + r; float v = 0.f;
                if (C0) { if (vi < 4) v = C0[(size_t)d * 256 + 64 * vs + 16 * vi + li]; else if (li == 0) v = n0[d]; }
                cacc[di][vi][r] = v; }
    float m_prev = m0p ? *m0p : 0.f;
    for (int i = tid; i < 16 * 72; i += 512) { const int rr = 64 + i / 72, cc = i % 72;
        *(LAS unsigned short*)(VT + rr * LVB + cc * 2) = (rr == 64 && cc < 64) ? (unsigned short)0x3F80 : (unsigned short)0; *(LAS unsigned short*)(VW + rr * LVB + cc * 2) = 0; }
    u32x4 pq[4], pk[4], pv; f32x4 pg0, pg1;
#define ML_PREFETCH(c) do { const int r0_ = row0 + 64 * (c); \
        _Pragma("unroll") for (int i = 0; i < 4; ++i) { const int idx = tid + 512 * i, rr = idx >> 5, sg = idx & 31; \
            if (rr < Tv) { pq[i] = *(const GAS u32x4*)(QA + (size_t)(r0_ + rr) * D + 256 * h + 8 * sg); pk[i] = *(const GAS u32x4*)(KA + (size_t)(r0_ + rr) * D + 256 * h + 8 * sg); } \
            else { pq[i] = (u32x4){0u, 0u, 0u, 0u}; pk[i] = (u32x4){0u, 0u, 0u, 0u}; } } \
        { const int rr = tid >> 3, sg = tid & 7; pv = rr < Tv ? *(const GAS u32x4*)(Z + (size_t)(r0_ + rr) * NINP + ZVA + 256 * h + 64 * vs + 8 * sg) : (u32x4){0u, 0u, 0u, 0u}; } \
        if (lane < Tv) { const float* gp_ = GP + ((size_t)(r0_ + lane) * 8 + h) * 8; pg0 = *(const GAS f32x4*)gp_; pg1 = *(const GAS f32x4*)(gp_ + 4); } \
        else { pg0 = (f32x4){0.f, -1e30f, 0.f, 1.f}; pg1 = (f32x4){0.f, 0.f, 0.f, 0.f}; } } while (0)
    ML_PREFETCH(0);
    for (int c = 0; c < nchunk; ++c) {
        const int r0 = row0 + 64 * c;
        const float gx = pg0[0], gy = pg0[1], winter = pg0[2], enm = pg0[3], wlast = pg1[0];
        const float m_last = __shfl(pg1[1], Tv - 1), decay = __shfl(winter, Tv - 1);
#pragma unroll
        for (int i = 0; i < 4; ++i) { const int idx = tid + 512 * i, rr = idx >> 5, sg = idx & 31; *(LAS u32x4*)(Qs + rr * LQB + sg * 16) = pq[i]; *(LAS u32x4*)(Ks + rr * LQB + sg * 16) = pk[i]; }
        { const int rr = tid >> 3, sg = tid & 7; const float wl = __shfl(wlast, rr); float vv[8]; pg8::unpack8(pv, vv);
#pragma unroll
          for (int j = 0; j < 8; j += 2) { const unsigned raw = (j == 0 ? pv.x : j == 2 ? pv.y : j == 4 ? pv.z : pv.w), sc = cvtpk(vv[j] * wl, vv[j + 1] * wl);
            *(LAS unsigned short*)(VT + (8 * sg + j) * LVB + rr * 2) = (unsigned short)(raw & 0xffffu); *(LAS unsigned short*)(VT + (8 * sg + j + 1) * LVB + rr * 2) = (unsigned short)(raw >> 16);
            *(LAS unsigned short*)(VW + (8 * sg + j) * LVB + rr * 2) = (unsigned short)(sc & 0xffffu); *(LAS unsigned short*)(VW + (8 * sg + j + 1) * LVB + rr * 2) = (unsigned short)(sc >> 16); } }
        if (W == 0) *(LAS unsigned short*)(VW + 64 * LVB + lane * 2) = (unsigned short)(cvtpk(wlast, wlast) & 0xffffu);
#pragma unroll
        for (int di = 0; di < 2; ++di)
#pragma unroll
            for (int vi = 0; vi < 5; ++vi) { u32x2 w; w.x = cvtpk(cacc[di][vi][0], cacc[di][vi][1]); w.y = cvtpk(cacc[di][vi][2], cacc[di][vi][3]);
                *(LAS u32x2*)(CTs + (16 * vi + li) * LQB + (16 * (2 * W + di) + 4 * g) * 2) = w; }
        LBAR();
        if (c + 1 < nchunk) ML_PREFETCH(c + 1);
        {
            const int tt = W & 3, sh = W >> 2;
            f32x4 sacc[2] = {{0.f, 0.f, 0.f, 0.f}, {0.f, 0.f, 0.f, 0.f}};
#pragma unroll
            for (int kk = 0; kk < 8; ++kk) { const bf16x8 bq = frag(Qs, 16 * tt + li, LQB, 64 * kk + 16 * g);
#pragma unroll
                for (int i = 0; i < 2; ++i) { const bf16x8 ak = frag(Ks, 16 * (2 * sh + i) + li, LQB, 64 * kk + 16 * g); sacc[i] = MFMA16(ak, bq, sacc[i]); } }
            const int t = 16 * tt + li; const float xt = __shfl(gx, t);
#pragma unroll
            for (int i = 0; i < 2; ++i) { float p[4];
#pragma unroll
                for (int r = 0; r < 4; ++r) { const int s = 16 * (2 * sh + i) + 4 * g + r; const float ys = __shfl(gy, s);
                    p[r] = (s <= t) ? sacc[i][r] * __expf(xt + ys) : 0.f; }
                u32x2 w; w.x = cvtpk(p[0], p[1]); w.y = cvtpk(p[2], p[3]); *(LAS u32x2*)(Ps + t * LVB + (16 * (2 * sh + i) + 4 * g) * 2) = w; }
        }
        LBAR();
        {
            const int tt = W & 3, vh = W >> 2; const int vt0 = 2 * vh, vt1 = 2 * vh + 1;
            f32x4 a1[3], a2[3];
#pragma unroll
            for (int i = 0; i < 3; ++i) { a1[i] = (f32x4){0.f, 0.f, 0.f, 0.f}; a2[i] = (f32x4){0.f, 0.f, 0.f, 0.f}; }
#pragma unroll
            for (int kk = 0; kk < 2; ++kk) { const bf16x8 ap = frag(Ps, 16 * tt + li, LVB, 64 * kk + 16 * g);
                a1[0] = MFMA16(ap, frag(VT, 16 * vt0 + li, LVB, 64 * kk + 16 * g), a1[0]); a1[1] = MFMA16(ap, frag(VT, 16 * vt1 + li, LVB, 64 * kk + 16 * g), a1[1]);
                a1[2] = MFMA16(ap, frag(VT, 64 + li, LVB, 64 * kk + 16 * g), a1[2]); }
#pragma unroll
            for (int kk = 0; kk < 8; ++kk) { const bf16x8 aq = frag(Qs, 16 * tt + li, LQB, 64 * kk + 16 * g);
                a2[0] = MFMA16(aq, frag(CTs, 16 * vt0 + li, LQB, 64 * kk + 16 * g), a2[0]); a2[1] = MFMA16(aq, frag(CTs, 16 * vt1 + li, LQB, 64 * kk + 16 * g), a2[1]);
                a2[2] = MFMA16(aq, frag(CTs, 64 + li, LQB, 64 * kk + 16 * g), a2[2]); }
#pragma unroll
            for (int r = 0; r < 4; ++r) { const int t = 16 * tt + 4 * g + r; const float wi = __shfl(winter, t), en = __shfl(enm, t);
                const float o2 = a1[2][r] + wi * a2[2][r]; const float qn = __shfl(o2, lane & 48); const float inv = __builtin_amdgcn_rcpf(fmaxf(fabsf(qn), en));
                const unsigned hw = cvtpk((a1[0][r] + wi * a2[0][r]) * inv, (a1[1][r] + wi * a2[1][r]) * inv);
                *(LAS unsigned short*)(Hs + t * LVB + (16 * vt0 + li) * 2) = (unsigned short)(hw & 0xffffu); *(LAS unsigned short*)(Hs + t * LVB + (16 * vt1 + li) * 2) = (unsigned short)(hw >> 16); }
        }
#pragma unroll
        for (int di = 0; di < 2; ++di)
#pragma unroll
            for (int vi = 0; vi < 5; ++vi) cacc[di][vi] = cacc[di][vi] * decay;
#pragma unroll
        for (int kk = 0; kk < 2; ++kk) { bf16x8 ak[2];
#pragma unroll
            for (int di = 0; di < 2; ++di) ak[di] = frag_t(Ks, 32 * kk + 8 * g, LQB, 16 * (2 * W + di) + li);
#pragma unroll
            for (int vi = 0; vi < 5; ++vi) { const bf16x8 bv = frag(VW, 16 * vi + li, LVB, 64 * kk + 16 * g);
#pragma unroll
                for (int di = 0; di < 2; ++di) cacc[di][vi] = MFMA16(ak[di], bv, cacc[di][vi]); } }
        m_prev = m_last;
        LBAR();
        { const int rr = tid >> 3, sg = tid & 7; if (rr < Tv) *(GAS u32x4*)(HA + (size_t)(r0 + rr) * D + 256 * h + 64 * vs + 8 * sg) = *(const LAS u32x4*)(Hs + rr * LVB + sg * 16); }
    }
#undef ML_PREFETCH
#pragma unroll
    for (int di = 0; di < 2; ++di)
#pragma unroll
        for (int r = 0; r < 4; ++r) { const int d = 16 * (2 * W + di) + 4 * g + r;
#pragma unroll
            for (int vi = 0; vi < 4; ++vi) Cout[(size_t)d * 256 + 64 * vs + 16 * vi + li] = cacc[di][vi][r];
            if (vs == 0 && li == 0) nout[d] = cacc[di][4][r]; }
    if (vs == 0 && tid == 0) *mout = m_prev;
}

DI void hgrn_unit(LAS unsigned char* lds, const bf16* QB, const bf16* KB, const bf16* Z, const float* E1, const float* E2, bf16* HB,
                  int row0, int nchunk, int Tv, int h, int vs, int ci0, const float* S0, float* Sout) {
    int tid_ = threadIdx.x; asm volatile("" : "+v"(tid_));
    const int tid = tid_, lane = tid & 63, W = __builtin_amdgcn_readfirstlane(tid >> 6), g = lane >> 4, li = lane & 15;
    LAS unsigned char* Qs = lds + HS_Q; LAS unsigned char* Ks = lds + HS_K; LAS unsigned char* VT = lds + HS_VT; LAS unsigned char* STs = lds + HS_ST; LAS unsigned char* Ps = lds + HS_P; LAS unsigned char* Hs = lds + HS_H;
    f32x4 sacc[4];
#pragma unroll
    for (int vi = 0; vi < 4; ++vi)
#pragma unroll
        for (int r = 0; r < 4; ++r) sacc[vi][r] = S0 ? S0[(size_t)(16 * W + 4 * g + r) * 128 + 64 * vs + 16 * vi + li] : 0.f;
    u32x4 pq[2], pk[2], pv; f32x4 pe1, pe2;
#define HG_PREFETCH(c) do { const int r0_ = row0 + 64 * (c); \
        _Pragma("unroll") for (int i = 0; i < 2; ++i) { const int idx = tid + 512 * i, rr = idx >> 4, sg = idx & 15; \
            if (rr < Tv) { pq[i] = *(const GAS u32x4*)(QB + (size_t)(r0_ + rr) * D + 128 * h + 8 * sg); pk[i] = *(const GAS u32x4*)(KB + (size_t)(r0_ + rr) * D + 128 * h + 8 * sg); } \
            else { pq[i] = (u32x4){0u, 0u, 0u, 0u}; pk[i] = (u32x4){0u, 0u, 0u, 0u}; } } \
        { const int rr = tid >> 3, sg = tid & 7; pv = rr < Tv ? *(const GAS u32x4*)(Z + (size_t)(r0_ + rr) * NINP + ZIB + 128 * h + 64 * vs + 8 * sg) : (u32x4){0u, 0u, 0u, 0u}; } \
        pe1 = *(const GAS f32x4*)(E1 + (size_t)(ci0 + (c)) * 2048 + 128 * h + 16 * W + 4 * g); pe2 = *(const GAS f32x4*)(E2 + (size_t)(ci0 + (c)) * 2048 + 128 * h + 16 * W + 4 * g); } while (0)
    HG_PREFETCH(0);
    for (int c = 0; c < nchunk; ++c) {
        const int r0 = row0 + 64 * c;
        const f32x4 e2 = pe2;
        f32x4 smid[4];
#pragma unroll
        for (int vi = 0; vi < 4; ++vi) smid[vi] = sacc[vi] * pe1;
#pragma unroll
        for (int i = 0; i < 2; ++i) { const int idx = tid + 512 * i, rr = idx >> 4, sg = idx & 15; *(LAS u32x4*)(Qs + rr * LHB + sg * 16) = pq[i]; *(LAS u32x4*)(Ks + rr * LHB + sg * 16) = pk[i]; }
        { const int rr = tid >> 3, sg = tid & 7; const unsigned wv[4] = {pv.x, pv.y, pv.z, pv.w};
#pragma unroll
          for (int j = 0; j < 8; ++j) *(LAS unsigned short*)(VT + (8 * sg + j) * LVB + rr * 2) = (unsigned short)((j & 1) ? (wv[j >> 1] >> 16) : (wv[j >> 1] & 0xffffu)); }
#pragma unroll
        for (int vi = 0; vi < 4; ++vi) { u32x2 w; w.x = cvtpk(smid[vi][0], smid[vi][1]); w.y = cvtpk(smid[vi][2], smid[vi][3]); *(LAS u32x2*)(STs + (16 * vi + li) * LHB + (16 * W + 4 * g) * 2) = w; }
        LBAR();
        if (c + 1 < nchunk) HG_PREFETCH(c + 1);
        {
            const int tt = W & 3, sh = W >> 2;
            f32x4 a[2] = {{0.f, 0.f, 0.f, 0.f}, {0.f, 0.f, 0.f, 0.f}};
#pragma unroll
            for (int kk = 0; kk < 4; ++kk) { const bf16x8 bq = frag(Qs, 16 * tt + li, LHB, 64 * kk + 16 * g);
#pragma unroll
                for (int i = 0; i < 2; ++i) a[i] = MFMA16(frag(Ks, 16 * (2 * sh + i) + li, LHB, 64 * kk + 16 * g), bq, a[i]); }
            const int t = 16 * tt + li;
#pragma unroll
            for (int i = 0; i < 2; ++i) { float p[4];
#pragma unroll
                for (int r = 0; r < 4; ++r) { const int s = 16 * (2 * sh + i) + 4 * g + r; p[r] = (s <= t) ? a[i][r] : 0.f; }
                u32x2 w; w.x = cvtpk(p[0], p[1]); w.y = cvtpk(p[2], p[3]); *(LAS u32x2*)(Ps + t * LVB + (16 * (2 * sh + i) + 4 * g) * 2) = w; }
        }
        LBAR();
        {
            const int tt = W & 3, vh = W >> 2;
            f32x4 o[2] = {{0.f, 0.f, 0.f, 0.f}, {0.f, 0.f, 0.f, 0.f}};
#pragma unroll
            for (int kk = 0; kk < 2; ++kk) { const bf16x8 ap = frag(Ps, 16 * tt + li, LVB, 64 * kk + 16 * g);
#pragma unroll
                for (int i = 0; i < 2; ++i) o[i] = MFMA16(ap, frag(VT, 16 * (2 * vh + i) + li, LVB, 64 * kk + 16 * g), o[i]); }
#pragma unroll
            for (int kk = 0; kk < 4; ++kk) { const bf16x8 aq = frag(Qs, 16 * tt + li, LHB, 64 * kk + 16 * g);
#pragma unroll
                for (int i = 0; i < 2; ++i) o[i] = MFMA16(aq, frag(STs, 16 * (2 * vh + i) + li, LHB, 64 * kk + 16 * g), o[i]); }
#pragma unroll
            for (int r = 0; r < 4; ++r) { const int t = 16 * tt + 4 * g + r;
                const unsigned hw = cvtpk(o[0][r], o[1][r]); *(LAS unsigned short*)(Hs + t * LVB + (16 * (2 * vh) + li) * 2) = (unsigned short)(hw & 0xffffu); *(LAS unsigned short*)(Hs + t * LVB + (16 * (2 * vh + 1) + li) * 2) = (unsigned short)(hw >> 16); }
        }
#pragma unroll
        for (int vi = 0; vi < 4; ++vi) sacc[vi] = smid[vi];
#pragma unroll
        for (int kk = 0; kk < 2; ++kk) { const bf16x8 ak = frag_t(Ks, 32 * kk + 8 * g, LHB, 16 * W + li);
#pragma unroll
            for (int vi = 0; vi < 4; ++vi) sacc[vi] = MFMA16(ak, frag(VT, 16 * vi + li, LVB, 64 * kk + 16 * g), sacc[vi]); }
#pragma unroll
        for (int vi = 0; vi < 4; ++vi) sacc[vi] = sacc[vi] * e2;
        LBAR();
        { const int rr = tid >> 3, sg = tid & 7; if (rr < Tv) *(GAS u32x4*)(HB + (size_t)(r0 + rr) * D + 128 * h + 64 * vs + 8 * sg) = *(const LAS u32x4*)(Hs + rr * LVB + sg * 16); }
    }
#undef HG_PREFETCH
#pragma unroll
    for (int vi = 0; vi < 4; ++vi)
#pragma unroll
        for (int r = 0; r < 4; ++r) Sout[(size_t)(16 * W + 4 * g + r) * 128 + 64 * vs + 16 * vi + li] = sacc[vi][r];
}

DI void scan_phase(const Ctx& F, int l) {
    const bf16* Z = (const bf16*)(F.ws + WS_Z);
    const bf16* QA = (const bf16*)(F.ws + WS_QA); const bf16* KA = (const bf16*)(F.ws + WS_KA); const bf16* QB = (const bf16*)(F.ws + WS_QB); const bf16* KB = (const bf16*)(F.ws + WS_KB);
    const float* GP = (const float*)(F.ws + WS_GP); const float* E1 = (const float*)(F.ws + WS_E1); const float* E2 = (const float*)(F.ws + WS_E2);
    bf16* HA = (bf16*)(F.ws + WS_HA); bf16* HB = (bf16*)(F.ws + WS_HB);
    for (int u = F.bid; u < 768; u += F.G) {
        int type, idx, sample;
        if (u < 128) { type = 0; idx = u; sample = 0; } else if (u < 256) { type = 1; idx = u - 128; sample = 0; }
        else if (u < 384) { type = 1; idx = u - 256; sample = 1; } else if (u < 512) { type = 0; idx = u - 384; sample = 1; }
        else if (u < 640) { type = 1; idx = u - 512 + 128; sample = 1; } else { type = 0; idx = u - 640 + 128; sample = 1; }
        if (type == 0) {
            const int b = idx >> 5, h = (idx >> 2) & 7, vs = idx & 3;
            const size_t so = sample ? (size_t)l * NSB + b : (size_t)l * NB + b;
            const float* C0 = sample ? F.in[3] + (so * 8 + h) * 65536 : nullptr; const float* n0 = sample ? F.in[4] + (so * 8 + h) * 256 : nullptr; const float* m0 = sample ? F.in[5] + so * 8 + h : nullptr;
            float* Co = F.out + (sample ? O_CS : O_CP) + (so * 8 + h) * 65536; float* no = F.out + (sample ? O_NS : O_NP) + (so * 8 + h) * 256; float* mo = F.out + (sample ? O_MS : O_MP) + so * 8 + h;
            mlstm_unit(F.lds, QA, KA, Z, GP, HA, sample ? MPR + b * SSEQ : b * SEQ, sample ? 1 : SEQ / 64, sample ? SSEQ : 64, h, vs, C0, n0, m0, Co, no, mo);
        } else {
            const int b = idx >> 5, h = (idx >> 1) & 15, vs = idx & 1;
            const size_t so = sample ? (size_t)l * NSB + b : (size_t)l * NB + b;
            const float* S0 = sample ? F.in[6] + (so * 16 + h) * 16384 : nullptr; float* So = F.out + (sample ? O_SS : O_SP) + (so * 16 + h) * 16384;
            hgrn_unit(F.lds, QB, KB, Z, E1, E2, HB, sample ? MPR + b * SSEQ : b * SEQ, sample ? 1 : SEQ / 64, sample ? SSEQ : 64, h, vs, sample ? NB * 64 + b : b * 64, S0, So);
        }
        __syncthreads();
    }
}

constexpr int NPH_LAYER = 10, NPHASES = 1 + DEPTH * NPH_LAYER + 1;
struct Args { const float* in[26]; float* out; unsigned char* ws; int ph_lo, ph_hi; };
static_assert(sizeof(Args) == 26 * 8 + 8 + 8 + 8, "Args has no padding");

__global__ void __launch_bounds__(512, 2) trunk_fwd(Args args) {
    extern __shared__ __attribute__((aligned(16))) unsigned char lds_raw[];
    Ctx F;
    F.lds = (LAS unsigned char*)lds_raw; F.ws = args.ws; F.in = args.in; F.out = args.out;
    F.tid = threadIdx.x; F.lane = F.tid & 63; F.wave = __builtin_amdgcn_readfirstlane(F.tid >> 6); F.G = gridDim.x; F.bid = blockIdx.x;
    volatile LAS unsigned* MISC = (volatile LAS unsigned*)(F.lds + MISC_OFF);
    if (F.tid < 64) MISC[F.tid] = 0u;
    __syncthreads();
    gu32* ctl = (gu32*)(F.ws + WS_CTL);
#if MK_PER_PHASE
#define GRID_BAR() do { } while (0)
#else
    XcdBarrier bar = xcd_barrier_post((unsigned*)(ctl + CW_BAR), MISC + 8);
#define GRID_BAR() xcd_barrier(bar)
#endif
#define LAUNDER() do { unsigned char* w_ = args.ws; float* o_ = args.out; int b_ = blockIdx.x, g_ = gridDim.x; asm volatile("" : "+s"(w_), "+s"(o_), "+s"(b_), "+s"(g_)); F.ws = w_; F.out = o_; F.bid = b_; F.G = g_; } while (0)
    const int lo = args.ph_lo, hi = args.ph_hi;
#ifndef PH_MASK
#define PH_MASK 0xFFFFu
#endif
#define IN(k) (lo <= (k) && (k) < hi)
#define EN(j) ((PH_MASK >> (j)) & 1u)
#ifndef DUP_MASK
#define DUP_MASK 0x0u
#endif
#define DUP(j) ((int)((DUP_MASK >> (j)) & 1u))
#define BOTH(k) (IN(k) && IN((k) + 1))
    if (EN(10) && IN(0)) { for (int rep_ = 0; rep_ <= DUP(10); ++rep_) { LAUNDER(); p0_prologue(F); if (rep_ < DUP(10) || BOTH(0)) GRID_BAR(); } }
    for (int l = 0; l < DEPTH; ++l) {
        const int pb = 1 + NPH_LAYER * l;
        { int t_ = threadIdx.x; asm volatile("" : "+v"(t_)); F.tid = t_; F.lane = t_ & 63; F.wave = __builtin_amdgcn_readfirstlane(t_ >> 6); }
        { unsigned char* w_ = args.ws; float* o_ = args.out; asm volatile("" : "+s"(w_), "+s"(o_)); F.ws = w_; F.out = o_; }
        unsigned char* wl = F.ws + WS_W + (size_t)l * W_LAYER;
        const float* modl = (const float*)(F.ws + WS_MOD) + (size_t)l * 12 * MODW;
        if (EN(0) && IN(pb + 0)) { for (int rep_ = 0; rep_ <= DUP(0); ++rep_) { LAUNDER(); norm_phase(F, F.in[11] + (size_t)l * D, modl, 0, D); if (rep_ < DUP(0) || BOTH(pb + 0)) GRID_BAR(); } }
        if (EN(1) && IN(pb + 1)) { for (int rep_ = 0; rep_ <= DUP(1); ++rep_) { LAUNDER();
            pg8::Gemm gm{(const pg8::bf16_t*)(F.ws + WS_H), (const pg8::bf16_t*)(wl + W_WIN), MP, NINP, D}; pg8::SplitOrder S; S.init(MPR, NINP, D, 1, F.G, F.bid);
            pg8::EpiZ E{(pg8::bf16_t*)(F.ws + WS_Z), (const float*)(F.ws + WS_BIN) + (size_t)l * NINP, (float*)(F.ws + WS_G)};
            pg8::gemm_phase<pg8::EpiZ, pg8::SplitOrder, true, true>(F.lds + RING_OFF, gm, S, E);
            if (rep_ < DUP(1) || BOTH(pb + 1)) GRID_BAR();
        } }
        if (EN(2) && IN(pb + 2)) { for (int rep_ = 0; rep_ <= DUP(2); ++rep_) { LAUNDER(); prep_phase(F, l); if (rep_ < DUP(2) || BOTH(pb + 2)) GRID_BAR(); } }
        if (EN(3) && IN(pb + 3)) { for (int rep_ = 0; rep_ <= DUP(3); ++rep_) { LAUNDER(); scan_phase(F, l); if (rep_ < DUP(3) || BOTH(pb + 3)) GRID_BAR(); } }
        if (EN(4) && IN(pb + 4)) { for (int rep_ = 0; rep_ <= DUP(4); ++rep_) { LAUNDER(); headnorm_phase(F, l); if (rep_ < DUP(4) || BOTH(pb + 4)) GRID_BAR(); } }
        if (EN(5) && IN(pb + 5)) { for (int rep_ = 0; rep_ <= DUP(5); ++rep_) { LAUNDER();
            { pg8::Gemm gm{(const pg8::bf16_t*)(F.ws + WS_KA), (const pg8::bf16_t*)(wl + W_WBB), MP, D, D}; pg8::SplitOrder S; S.init(MPR, D, D, 1, F.G, F.bid);
              pg8::EpiGateTmp E{(const pg8::bf16_t*)(F.ws + WS_Z) + ZGB, (float*)(F.ws + WS_HA)};
              pg8::gemm_phase<pg8::EpiGateTmp, pg8::SplitOrder, true, true>(F.lds + RING_OFF, gm, S, E); }
            VM_WAIT(); __syncthreads();
            { pg8::Gemm gm{(const pg8::bf16_t*)(F.ws + WS_QA), (const pg8::bf16_t*)(wl + W_WBA), MP, D, D}; pg8::SplitOrder S; S.init(MPR, D, D, 1, F.G, F.bid);
              pg8::EpiMerge E{(const pg8::bf16_t*)(F.ws + WS_Z) + ZGA, (const float*)(F.ws + WS_HA), (pg8::bf16_t*)(F.ws + WS_QB)};
              pg8::gemm_phase<pg8::EpiMerge, pg8::SplitOrder, true, true>(F.lds + RING_OFF, gm, S, E); }
            if (rep_ < DUP(5) || BOTH(pb + 5)) GRID_BAR();
        } }
        if (EN(6) && IN(pb + 6)) { for (int rep_ = 0; rep_ <= DUP(6); ++rep_) { LAUNDER();
            pg8::Gemm gm{(const pg8::bf16_t*)(F.ws + WS_QB), (const pg8::bf16_t*)(wl + W_WO), MP, D, D}; pg8::SplitOrder S; S.init(MPR, D, D, 4, F.G, F.bid);
            pg8::EpiResid E{(float*)(F.ws + WS_X), modl + 2 * D};
            pg8::gemm_phase<pg8::EpiResid, pg8::SplitOrder, true, true>(F.lds + RING_OFF, gm, S, E);
            if (rep_ < DUP(6) || BOTH(pb + 6)) GRID_BAR();
        } }
        if (EN(7) && IN(pb + 7)) { for (int rep_ = 0; rep_ <= DUP(7); ++rep_) { LAUNDER(); norm_phase(F, F.in[12] + (size_t)l * D, modl, 3 * D, 4 * D); if (rep_ < DUP(7) || BOTH(pb + 7)) GRID_BAR(); } }
        if (EN(8) && IN(pb + 8)) { for (int rep_ = 0; rep_ <= DUP(8); ++rep_) { LAUNDER();
            pg8::Gemm gm{(const pg8::bf16_t*)(F.ws + WS_H), (const pg8::bf16_t*)(wl + W_WUP), MP, DFF, D}; pg8::SplitOrder S; S.init(MPR, DFF, D, 1, F.G, F.bid);
            pg8::EpiRelu2 E{(pg8::bf16_t*)(F.ws + WS_Z), DFF};
            pg8::gemm_phase<pg8::EpiRelu2, pg8::SplitOrder, true, true>(F.lds + RING_OFF, gm, S, E);
            if (rep_ < DUP(8) || BOTH(pb + 8)) GRID_BAR();
        } }
        if (EN(9) && IN(pb + 9)) { for (int rep_ = 0; rep_ <= DUP(9); ++rep_) { LAUNDER();
            pg8::Gemm gm{(const pg8::bf16_t*)(F.ws + WS_Z), (const pg8::bf16_t*)(wl + W_WDN), MP, D, DFF}; pg8::SplitOrder S; S.init(MPR, D, DFF, 16, F.G, F.bid);
            pg8::EpiResid E{(float*)(F.ws + WS_X), modl + 5 * D};
            pg8::gemm_phase<pg8::EpiResid, pg8::SplitOrder, true, true>(F.lds + RING_OFF, gm, S, E);
            if (rep_ < DUP(9) || BOTH(pb + 9)) GRID_BAR();
        } }
    }
    if (EN(11) && IN(NPHASES - 1)) final_norm_phase(F);
#undef IN
#undef BOTH
}

extern "C" void kernel_launch(void* const* d_in, const int* in_sizes, int n_in, void* d_out, int out_size, void* d_ws, size_t ws_size, hipStream_t stream) {
    static int grid = 0;
    if (grid == 0) {
        if (n_in != 26 || (size_t)out_size != O_END || ws_size < WS_END) { fprintf(stderr, "kernel_launch: shape mismatch: n_in %d out %d (want %zu) ws %zu (want %zu)\n", n_in, out_size, (size_t)O_END, ws_size, (size_t)WS_END); grid = -1; return; }
        int dev = 0, cus = 0, per_cu = 0;
        if (hipGetDevice(&dev) != hipSuccess || hipDeviceGetAttribute(&cus, hipDeviceAttributeMultiprocessorCount, dev) != hipSuccess) { grid = -1; return; }
        if (hipFuncSetAttribute((const void*)trunk_fwd, hipFuncAttributeMaxDynamicSharedMemorySize, LDS_BYTES) != hipSuccess) { fprintf(stderr, "kernel_launch: hipFuncSetAttribute failed\n"); grid = -1; return; }
        if (hipOccupancyMaxActiveBlocksPerMultiprocessor(&per_cu, (const void*)trunk_fwd, 512, LDS_BYTES) != hipSuccess || per_cu < 1) fprintf(stderr, "kernel_launch: occupancy query says %d\n", per_cu);
        (void)hipGetLastError();
        grid = cus;
    }
    if (grid < 0) return;
    (void)in_sizes;
    if (hipMemsetAsync((char*)d_ws + WS_CTL, 0, CTL_ZERO_BYTES, stream) != hipSuccess) { fprintf(stderr, "kernel_launch: memset failed\n"); return; }
    Args a{};
    for (int i = 0; i < 26; ++i) a.in[i] = (const float*)d_in[i];
    a.out = (float*)d_out; a.ws = (unsigned char*)d_ws;
#if MK_PER_PHASE
    for (int p = 0; p < NPHASES; ++p) { a.ph_lo = p; a.ph_hi = p + 1; hipLaunchKernelGGL(trunk_fwd, dim3(grid), dim3(512), LDS_BYTES, stream, a); }
#else
    a.ph_lo = 0; a.ph_hi = NPHASES;
    hipLaunchKernelGGL(trunk_fwd, dim3(grid), dim3(512), LDS_BYTES, stream, a);
#endif
    const hipError_t le = hipPeekAtLastError();
    if (le != hipSuccess) fprintf(stderr, "kernel_launch: launch failed: %s\n", hipGetErrorName(le));
}
```

```cpp
#include <hip/hip_runtime.h>
#include <cstdio>
#include <cstdint>
#ifndef MK_PER_PHASE
#define MK_PER_PHASE 0
#endif
namespace pg8 {
#define PG8_LAS __attribute__((address_space(3)))
typedef unsigned short bf16_t;
typedef short bf16x8 __attribute__((ext_vector_type(8)));
typedef float f32x4 __attribute__((ext_vector_type(4)));
typedef unsigned u32x4 __attribute__((ext_vector_type(4)));
constexpr int BM = 256, BK = 64, HALF = 128, HTB = HALF * BK * 2  , STAGE_BYTES = 8 * HTB, NXCD = 8, WGM = 8;

__host__ __device__ __forceinline__ int lds_byte(int r, int c) { const int st = (r >> 4) * 2 + (c >> 5), rr = r & 15, cc = c & 31, ob = rr * 64 + cc * 2; return st * 1024 + (ob ^ (((ob >> 9) & 1) << 5)); }
__host__ __device__ __forceinline__ void stage_rc(int b, int& R, int& C) { const int st = b / 1024, sb = b % 1024, swz = sb ^ (((sb >> 9) & 1) << 5); R = (st >> 1) * 16 + swz / 64; C = (st & 1) * 32 + (swz % 64) / 2; }
__host__ __device__ __forceinline__ int perm32(int rho) { const int n = rho >> 4, i = rho & 15; return 8 * (i >> 2) + 4 * n + (i & 3); }

struct Unit { int pm, pn, k0, nt, half; };
struct Gemm { const bf16_t* A; const bf16_t* Bt; int M, N, K; };

struct StaticOrder {
    int nM, nN, nwg, G, c;
    __host__ __device__ void init(int M, int N, int G_, int c_) { nM = M / BM; nN = N / BM; nwg = nM * nN; G = G_; c = c_; }
    __host__ __device__ __forceinline__ bool next(int i, Unit& u) const {
        const long L = (long)i * G + c; if (L >= nwg) return false;
        int wgid = (int)L; { const int q = nwg / NXCD, r = nwg % NXCD, xcd = wgid % NXCD, off = wgid / NXCD; wgid = (xcd < r ? xcd * (q + 1) : r * (q + 1) + (xcd - r) * q) + off; }
        const int nig = WGM * nN, gid = wgid / nig, fm = gid * WGM, gsz = (nM - fm) < WGM ? (nM - fm) : WGM;
        u.pm = fm + ((wgid % nig) % gsz); u.pn = (wgid % nig) / gsz; return true;
    }
    __device__ __forceinline__ void a_ready(const Unit&) const {}
    __device__ __forceinline__ void done(const Unit&) const {}
};

struct SplitOrder {
    int nM, nN, nwg, G, c, S, ntK, wgm;
    __device__ __forceinline__ void init(int Mfull, int N, int K, int S_, int G_, int c_, int wgm_ = WGM) { nM = Mfull / BM; nN = N / BM; nwg = nM * nN; G = G_; c = c_; S = S_; ntK = K / BK; wgm = wgm_; }
    __device__ __forceinline__ bool next(int i, Unit& u) const {
        const long L = (long)i * G + c; const bool full = L < nwg; const int j = full ? 0 : (int)(L - nwg);
        if (!full && j >= nN * S) return false;
        int wgid = full ? (int)L : 0; { const int q = nwg / NXCD, r = nwg % NXCD, xcd = wgid % NXCD, off = wgid / NXCD; wgid = (xcd < r ? xcd * (q + 1) : r * (q + 1) + (xcd - r) * q) + off; }
        const int nig = wgm * nN, gid = wgid / nig, fm = gid * wgm, gsz = (nM - fm) < wgm ? (nM - fm) : wgm;
        const int pm_f = fm + ((wgid % nig) % gsz), pn_f = (wgid % nig) / gsz;
        const int nts = ntK / S;
        const int pm = full ? pm_f : nM, pn = full ? pn_f : (j % nN), k0 = full ? 0 : (j / nN) * nts, nt = full ? ntK : nts, half = full ? 0 : 1;
        u = Unit{pm, pn, k0, nt, half}; return true;
    }
    __device__ __forceinline__ void a_ready(const Unit&) const {}
    __device__ __forceinline__ void done(const Unit&) const {}
};

__device__ __forceinline__ unsigned cvt_pk_bf16(float lo, float hi) { unsigned r; asm volatile("v_cvt_pk_bf16_f32 %0, %1, %2" : "=v"(r) : "v"(lo), "v"(hi)); return r; }
typedef float f32x2 __attribute__((ext_vector_type(2)));
template <class Epi, class Sched, bool ALIGN_EPI = false, bool SP2 = false>
__device__ __forceinline__ void gemm_phase(PG8_LAS unsigned char* lds, const Gemm g, const Sched& S, const Epi& E) {
    int tid_ = threadIdx.x; asm volatile("" : "+v"(tid_));
    const int tid = tid_, wid = __builtin_amdgcn_readfirstlane(tid >> 6), lane = tid & 63, wr = wid >> 2, wc = wid & 3, fr = lane & 15, fq = lane >> 4;
    const int K = g.K;
    unsigned voffA[2], voffB[2];
#pragma unroll
    for (int i = 0; i < 2; ++i) { int R, C; stage_rc(tid * 16 + i * 8192, R, C); const int Rb = Epi::PERM ? ((R & ~31) + perm32(R & 31)) : R;
        voffA[i] = (unsigned)(R * K + C) * 2u; voffB[i] = (unsigned)(Rb * K + C) * 2u; }
    const size_t kstep = (size_t)(BK * 2);
    const size_t hstep = (size_t)HALF * K * 2;
    const size_t tstep = 2 * hstep;
    const unsigned ldsw = (unsigned)wid * 1024u;
    const int aoff = lds_byte(wr * 64 + fr, fq * 8), boff = lds_byte(wc * 32 + fr, fq * 8);
#define PG8_SA(b, h) (((b) * 2 + (h)) * HTB)
#define PG8_SB(b, h) ((4 + (b) * 2 + (h)) * HTB)
#define PG8_STAGE(bufoff, gbase, voff) do { _Pragma("unroll") for (int _i = 0; _i < 2; ++_i) \
        __builtin_amdgcn_global_load_lds((const unsigned*)((const char*)(gbase) + (voff)[_i]), (PG8_LAS unsigned*)(lds + (bufoff) + ldsw + _i * 8192), 16, 0, 0); } while (0)
#define PG8_LDA(dst, b, h) do { _Pragma("unroll") for (int m = 0; m < 4; ++m) _Pragma("unroll") for (int k = 0; k < 2; ++k) dst[m][k] = *(const PG8_LAS bf16x8*)(lds + PG8_SA(b, h) + aoff + m * 2048 + k * 1024); } while (0)
#define PG8_LDB(dst, b, h) do { _Pragma("unroll") for (int n = 0; n < 2; ++n) _Pragma("unroll") for (int k = 0; k < 2; ++k) dst[n][k] = *(const PG8_LAS bf16x8*)(lds + PG8_SB(b, h) + boff + n * 2048 + k * 1024); } while (0)
#define PG8_MMA(ai, bj, At, Bt) do { __builtin_amdgcn_s_setprio(1); _Pragma("unroll") for (int m = 0; m < 4; ++m) _Pragma("unroll") for (int n = 0; n < 2; ++n) _Pragma("unroll") for (int k = 0; k < 2; ++k) \
        acc[ai][bj][m][n] = __builtin_amdgcn_mfma_f32_16x16x32_bf16(Bt[n][k], At[m][k], acc[ai][bj][m][n], 0, 0, 0); __builtin_amdgcn_s_setprio(0); } while (0)
#define PG8_WAIT_V(n) asm volatile("s_waitcnt vmcnt(" #n ")" ::: "memory")
#define PG8_WAIT_L(n) asm volatile("s_waitcnt lgkmcnt(" #n ")" ::: "memory")
#define PG8_BAR __builtin_amdgcn_s_barrier()
#define PG8_SCHED __builtin_amdgcn_sched_barrier(0)
    Unit cur, nxt; int ui = 0;
    if (!S.next(0, cur)) return;
    f32x4 acc[2][2][4][2];
#pragma unroll
    for (int a = 0; a < 2; ++a)
#pragma unroll
        for (int b = 0; b < 2; ++b)
#pragma unroll
            for (int m = 0; m < 4; ++m)
#pragma unroll
                for (int n = 0; n < 2; ++n) acc[a][b][m][n] = (f32x4){0.f, 0.f, 0.f, 0.f};
    bf16x8 At[4][2], B0[2][2], B1[2][2];
    const char* cA = (const char*)g.A + (size_t)cur.pm * tstep + (size_t)cur.k0 * kstep; const char* cB = (const char*)g.Bt + (size_t)cur.pn * tstep + (size_t)cur.k0 * kstep;
    S.a_ready(cur);
    if constexpr (SP2) {
        PG8_STAGE(PG8_SB(0, 0), cB, voffB); PG8_STAGE(PG8_SB(0, 1), cB + hstep, voffB); PG8_STAGE(PG8_SA(0, 0), cA, voffA); PG8_STAGE(PG8_SA(0, 1), cA + hstep, voffA);
        if (wr == 1) PG8_BAR;
        PG8_WAIT_V(2); PG8_BAR;
        PG8_STAGE(PG8_SB(1, 0), cB + kstep, voffB); PG8_STAGE(PG8_SA(1, 0), cA + kstep, voffA); PG8_STAGE(PG8_SB(1, 1), cB + hstep + kstep, voffB);
        PG8_WAIT_V(6); PG8_BAR;
    } else {
        PG8_STAGE(PG8_SB(0, 0), cB, voffB); PG8_STAGE(PG8_SA(0, 0), cA, voffA); PG8_STAGE(PG8_SB(0, 1), cB + hstep, voffB); PG8_STAGE(PG8_SA(0, 1), cA + hstep, voffA);
        if (wr == 1) PG8_BAR;
        PG8_WAIT_V(4); PG8_BAR;
        PG8_STAGE(PG8_SB(1, 0), cB + kstep, voffB); PG8_STAGE(PG8_SA(1, 0), cA + kstep, voffA); PG8_STAGE(PG8_SB(1, 1), cB + hstep + kstep, voffB);
        PG8_WAIT_V(6); PG8_BAR;
    }
    for (;;) {
        const bool has_next = S.next(ui + 1, nxt);
        const char* nA = has_next ? (const char*)g.A + (size_t)nxt.pm * tstep + (size_t)nxt.k0 * kstep : cA; const char* nB = has_next ? (const char*)g.Bt + (size_t)nxt.pn * tstep + (size_t)nxt.k0 * kstep : cB;
        const int nt = cur.nt; const bool fullrows = (cur.half == 0);
#ifdef PROBE_KTWICE
        _Pragma("nounroll") for (int pass_ = 0; pass_ < 2; ++pass_) { const char* nA_ = pass_ == 0 ? cA : nA; const char* nB_ = pass_ == 0 ? cB : nB;
#else
        { const char* nA_ = nA; const char* nB_ = nB;
#endif
        for (int t = 0; t < nt; t += 2) {
            const bool last = (t == nt - 2);
            const char* a1 = cA + (size_t)(t + 1) * kstep;
            const char* a2 = last ? nA_ : cA + (size_t)(t + 2) * kstep; const char* b2 = last ? nB_ : cB + (size_t)(t + 2) * kstep;
            const char* a3 = a2 + kstep; const char* b3 = b2 + kstep;
            if (last && has_next) S.a_ready(nxt);
            if constexpr (SP2) {
            PG8_LDB(B0, 0, 0); PG8_LDB(B1, 0, 1); PG8_SCHED; PG8_LDA(At, 0, 0); PG8_STAGE(PG8_SA(1, 1), a1 + hstep, voffA);
            PG8_WAIT_V(8); PG8_WAIT_L(0); PG8_BAR; PG8_MMA(0, 0, At, B0); PG8_MMA(0, 1, At, B1); PG8_BAR; PG8_SCHED;
            PG8_LDA(At, 0, 1); PG8_STAGE(PG8_SB(0, 0), b2, voffB); PG8_STAGE(PG8_SB(0, 1), b2 + hstep, voffB); PG8_STAGE(PG8_SA(0, 0), a2, voffA);
            PG8_WAIT_V(8); PG8_WAIT_L(0); PG8_BAR; if (fullrows) { PG8_MMA(1, 0, At, B0); PG8_MMA(1, 1, At, B1); } PG8_BAR; PG8_SCHED;
            PG8_LDB(B0, 1, 0); PG8_LDB(B1, 1, 1); PG8_SCHED; PG8_LDA(At, 1, 0); PG8_STAGE(PG8_SA(0, 1), a2 + hstep, voffA);
            PG8_WAIT_V(8); PG8_WAIT_L(0); PG8_BAR; PG8_MMA(0, 0, At, B0); PG8_MMA(0, 1, At, B1); PG8_BAR; PG8_SCHED;
            PG8_LDA(At, 1, 1); PG8_STAGE(PG8_SB(1, 0), b3, voffB); PG8_STAGE(PG8_SB(1, 1), b3 + hstep, voffB); PG8_STAGE(PG8_SA(1, 0), a3, voffA);
            PG8_WAIT_V(8); PG8_WAIT_L(0); PG8_BAR; if (fullrows) { PG8_MMA(1, 0, At, B0); PG8_MMA(1, 1, At, B1); } PG8_BAR; PG8_SCHED;
            } else {
            PG8_LDB(B0, 0, 0); PG8_SCHED; PG8_LDA(At, 0, 0); PG8_STAGE(PG8_SA(1, 1), a1 + hstep, voffA);
            PG8_WAIT_L(8); PG8_BAR; PG8_WAIT_L(0); PG8_MMA(0, 0, At, B0); PG8_BAR; PG8_SCHED;
            PG8_LDB(B1, 0, 1); PG8_STAGE(PG8_SB(0, 0), b2, voffB);
            PG8_BAR; PG8_WAIT_L(0); PG8_MMA(0, 1, At, B1); PG8_BAR;
            PG8_LDA(At, 0, 1); PG8_STAGE(PG8_SA(0, 0), a2, voffA);
            PG8_BAR; PG8_WAIT_L(0); if (fullrows) PG8_MMA(1, 0, At, B0); PG8_BAR; PG8_SCHED;
            PG8_STAGE(PG8_SB(0, 1), b2 + hstep, voffB);
            PG8_WAIT_V(6); PG8_BAR; if (fullrows) PG8_MMA(1, 1, At, B1); PG8_BAR;
            PG8_LDB(B0, 1, 0); PG8_SCHED; PG8_LDA(At, 1, 0); PG8_STAGE(PG8_SA(0, 1), a2 + hstep, voffA);
            PG8_WAIT_L(8); PG8_BAR; PG8_WAIT_L(0); PG8_MMA(0, 0, At, B0); PG8_BAR; PG8_SCHED;
            PG8_LDB(B1, 1, 1); PG8_STAGE(PG8_SB(1, 0), b3, voffB);
            PG8_BAR; PG8_WAIT_L(0); PG8_MMA(0, 1, At, B1); PG8_BAR;
            PG8_LDA(At, 1, 1); PG8_STAGE(PG8_SA(1, 0), a3, voffA);
            PG8_BAR; PG8_WAIT_L(0); if (fullrows) PG8_MMA(1, 0, At, B0); PG8_BAR; PG8_SCHED;
            PG8_STAGE(PG8_SB(1, 1), b3 + hstep, voffB);
            PG8_WAIT_V(6); PG8_BAR; if (fullrows) PG8_MMA(1, 1, At, B1); PG8_BAR;
            }
        }
        }
#ifdef PROBE_KTWICE
        _Pragma("unroll") for (int a_ = 0; a_ < 2; ++a_) _Pragma("unroll") for (int b_ = 0; b_ < 2; ++b_) _Pragma("unroll") for (int m_ = 0; m_ < 4; ++m_) _Pragma("unroll") for (int n_ = 0; n_ < 2; ++n_) acc[a_][b_][m_][n_] = acc[a_][b_][m_][n_] * 0.5f;
#endif
        if constexpr (ALIGN_EPI) { if (wr == 0) PG8_BAR; }
        if constexpr (!Epi::AFTER_DRAIN) { E(acc, cur, wr, wc, fr, fq);
#ifdef PROBE_EPI_TWICE
            if constexpr (Epi::IDEMPOTENT) { asm volatile("" ::: "memory"); E(acc, cur, wr, wc, fr, fq); }
#endif
            S.done(cur); }
        if (!has_next) break;
#pragma unroll
        for (int a = 0; a < 2; ++a)
#pragma unroll
            for (int b = 0; b < 2; ++b)
#pragma unroll
                for (int m = 0; m < 4; ++m)
#pragma unroll
                    for (int n = 0; n < 2; ++n) acc[a][b][m][n] = (f32x4){0.f, 0.f, 0.f, 0.f};
        cur = nxt; cA = nA; cB = nB; ++ui;
        if constexpr (ALIGN_EPI) { if (wr == 1) PG8_BAR; }
    }
    PG8_WAIT_V(0);
    if constexpr (!ALIGN_EPI) { if (wr == 0) PG8_BAR; }
    PG8_BAR;
    if constexpr (Epi::AFTER_DRAIN) { E.fused(acc, cur, wr, wc, fr, fq, lds, wid, lane); S.done(cur); }
#undef PG8_SA
#undef PG8_SB
#undef PG8_STAGE
#undef PG8_LDA
#undef PG8_LDB
#undef PG8_MMA
#undef PG8_WAIT_V
#undef PG8_WAIT_L
#undef PG8_BAR
#undef PG8_SCHED
}
}

constexpr int D = 2048, NB = 4, SEQ = 4096, DEPTH = 4, NSB = 8, SSEQ = 16;
constexpr int MPR = NB * SEQ;
constexpr int MS = NSB * SSEQ;
constexpr int M = MPR + MS;
constexpr int MP = 16640;
constexpr int NIN = 20496, NINP = 20736;
constexpr int DFF = 8192;
constexpr int ZQK = 0, ZVA = 4096, ZOA = 6144, ZQB = 8192, ZFB = 10240, ZIB = 12288, ZOGB = 14336, ZGA = 16384, ZGB = 18432, ZGT = 20480;
constexpr int MODW = 6 * D;
constexpr float EPS = 1e-6f;
constexpr int NCHUNKS = NB * (SEQ / 64) + NSB;

__device__ __forceinline__ int row_batch(int r) { int b = r < MPR ? (r >> 12) : 4 + ((r - MPR) >> 4); return b > 11 ? 11 : b; }
__device__ __forceinline__ float bf2f(unsigned short b) { return __uint_as_float(((unsigned)b) << 16); }
__device__ __forceinline__ float sigm(float x) { return __builtin_amdgcn_rcpf(1.0f + __expf(-x)); }

namespace pg8 {
__device__ __forceinline__ void unpack8(const u32x4 w, float (&f)[8]) {
    f[0] = __uint_as_float(w.x << 16); f[1] = __uint_as_float(w.x & 0xffff0000u); f[2] = __uint_as_float(w.y << 16); f[3] = __uint_as_float(w.y & 0xffff0000u);
    f[4] = __uint_as_float(w.z << 16); f[5] = __uint_as_float(w.z & 0xffff0000u); f[6] = __uint_as_float(w.w << 16); f[7] = __uint_as_float(w.w & 0xffff0000u);
}
struct EpiZ {
    static constexpr bool PERM = true, AFTER_DRAIN = false, IDEMPOTENT = true;
    bf16_t* Z; const float* bias; float* G;
    __device__ __forceinline__ void operator()(const f32x4 (&acc)[2][2][4][2], const Unit& u, int wr, int wc, int fr, int fq) const {
        const int row0 = u.pm * BM + wr * 64 + fr, col0 = u.pn * BM + wc * 32 + 8 * fq;
        const bool gates = (u.pn == 80) && (wc == 0) && (fq < 2);
        const f32x4 bb[2][2] = {{*(const f32x4*)(bias + col0), *(const f32x4*)(bias + col0 + 4)}, {*(const f32x4*)(bias + col0 + HALF), *(const f32x4*)(bias + col0 + HALF + 4)}};
#pragma unroll
        for (int bj = 0; bj < 2; ++bj) {
            const f32x4 b0 = bb[bj][0], b1 = bb[bj][1];
#pragma unroll
            for (int ai = 0; ai < 2; ++ai)
#pragma unroll
                for (int m = 0; m < 4; ++m) { const int row = row0 + ai * HALF + m * 16; bf16_t* rowp = Z + (size_t)row * NINP + col0;
                    const f32x4 v0 = acc[ai][bj][m][0] + b0, v1 = acc[ai][bj][m][1] + b1;
                    u32x4 w; w.x = cvt_pk_bf16(v0[0], v0[1]); w.y = cvt_pk_bf16(v0[2], v0[3]); w.z = cvt_pk_bf16(v1[0], v1[1]); w.w = cvt_pk_bf16(v1[2], v1[3]);
                    *(u32x4*)(rowp + bj * HALF) = w;
                    if (bj == 0 && gates) { float* gp = G + (size_t)row * 16 + 8 * fq; *(f32x4*)gp = v0; *(f32x4*)(gp + 4) = v1; } }
        }
    }
};
struct EpiGateTmp {
    static constexpr bool PERM = true, AFTER_DRAIN = false, IDEMPOTENT = false;
    const bf16_t* Zg; float* T;
    __device__ __forceinline__ void operator()(const f32x4 (&acc)[2][2][4][2], const Unit& u, int wr, int wc, int fr, int fq) const {
        const int row0 = u.pm * BM + wr * 64 + fr, col0 = u.pn * BM + wc * 32 + 8 * fq;
#pragma unroll
        for (int ai = 0; ai < 2; ++ai) {
            u32x4 gz[4][2];
#pragma unroll
            for (int m = 0; m < 4; ++m)
#pragma unroll
                for (int bj = 0; bj < 2; ++bj) gz[m][bj] = *(const u32x4*)(Zg + (size_t)(row0 + ai * HALF + m * 16) * NINP + col0 + bj * HALF);
#pragma unroll
            for (int m = 0; m < 4; ++m) { const int row = row0 + ai * HALF + m * 16;
#pragma unroll
                for (int bj = 0; bj < 2; ++bj) { const int c = col0 + bj * HALF; float gf[8]; unpack8(gz[m][bj], gf);
                    f32x4 v0 = acc[ai][bj][m][0], v1 = acc[ai][bj][m][1];
#pragma unroll
                    for (int j = 0; j < 4; ++j) { v0[j] *= sigm(gf[j]); v1[j] *= sigm(gf[4 + j]); }
                    float* tp = T + (size_t)row * D + c; *(f32x4*)tp = v0; *(f32x4*)(tp + 4) = v1; } }
            asm volatile("" ::: "memory");
        }
    }
};
struct EpiMerge {
    static constexpr bool PERM = true, AFTER_DRAIN = false, IDEMPOTENT = false;
    const bf16_t* Zg; const float* T; bf16_t* O;
    __device__ __forceinline__ void operator()(const f32x4 (&acc)[2][2][4][2], const Unit& u, int wr, int wc, int fr, int fq) const {
        const int row0 = u.pm * BM + wr * 64 + fr, col0 = u.pn * BM + wc * 32 + 8 * fq;
#pragma unroll
        for (int ai = 0; ai < 2; ++ai)
#pragma unroll
            for (int mp = 0; mp < 2; ++mp) {
                u32x4 gz[2][2]; f32x4 t0[2][2], t1[2][2];
#pragma unroll
                for (int mm = 0; mm < 2; ++mm)
#pragma unroll
                    for (int bj = 0; bj < 2; ++bj) { const int row = row0 + ai * HALF + (2 * mp + mm) * 16, c = col0 + bj * HALF; gz[mm][bj] = *(const u32x4*)(Zg + (size_t)row * NINP + c);
                        const float* tp = T + (size_t)row * D + c; t0[mm][bj] = *(const f32x4*)tp; t1[mm][bj] = *(const f32x4*)(tp + 4); }
#pragma unroll
                for (int mm = 0; mm < 2; ++mm)
#pragma unroll
                    for (int bj = 0; bj < 2; ++bj) { const int m = 2 * mp + mm, row = row0 + ai * HALF + m * 16, c = col0 + bj * HALF; float gf[8]; unpack8(gz[mm][bj], gf);
                        f32x4 v0 = t0[mm][bj], v1 = t1[mm][bj];
#pragma unroll
                        for (int j = 0; j < 4; ++j) { v0[j] += acc[ai][bj][m][0][j] * sigm(gf[j]); v1[j] += acc[ai][bj][m][1][j] * sigm(gf[4 + j]); }
                        u32x4 w; w.x = cvt_pk_bf16(v0[0], v0[1]); w.y = cvt_pk_bf16(v0[2], v0[3]); w.z = cvt_pk_bf16(v1[0], v1[1]); w.w = cvt_pk_bf16(v1[2], v1[3]);
                        *(u32x4*)(O + (size_t)row * D + c) = w; }
                asm volatile("" ::: "memory");
            }
    }
};
struct EpiResid {
    static constexpr bool PERM = false, AFTER_DRAIN = false, IDEMPOTENT = false;
    float* X; const float* gate; const float* Xsrc;
    __device__ __forceinline__ void operator()(const f32x4 (&acc)[2][2][4][2], const Unit& u, int wr, int wc, int fr, int fq) const {
        const int row0 = u.pm * BM + wr * 64 + fr, col0 = u.pn * BM + wc * 32 + 4 * fq;
        if (!u.half) {
            const float* gp = gate + (size_t)row_batch(u.pm * BM) * MODW + col0;
            const f32x4 gv[2][2] = {{*(const f32x4*)gp, *(const f32x4*)(gp + 16)}, {*(const f32x4*)(gp + HALF), *(const f32x4*)(gp + HALF + 16)}};
#pragma unroll
            for (int ai = 0; ai < 2; ++ai) {
                f32x4 xv[4][2][2];
#pragma unroll
                for (int m = 0; m < 4; ++m)
#pragma unroll
                    for (int bj = 0; bj < 2; ++bj)
#pragma unroll
                        for (int n = 0; n < 2; ++n) xv[m][bj][n] = *(const f32x4*)(Xsrc + (size_t)(row0 + ai * HALF + m * 16) * D + col0 + bj * HALF + n * 16);
#pragma unroll
                for (int m = 0; m < 4; ++m)
#pragma unroll
                    for (int bj = 0; bj < 2; ++bj)
#pragma unroll
                        for (int n = 0; n < 2; ++n) *(f32x4*)(X + (size_t)(row0 + ai * HALF + m * 16) * D + col0 + bj * HALF + n * 16) = xv[m][bj][n] + gv[bj][n] * acc[ai][bj][m][n];
                asm volatile("" ::: "memory");
            }
        } else {
#pragma unroll
            for (int m = 0; m < 4; ++m) { const int row = row0 + m * 16; const float* gp = gate + (size_t)row_batch(row) * MODW + col0; float* xp = X + (size_t)row * D + col0;
#pragma unroll
                for (int bj = 0; bj < 2; ++bj)
#pragma unroll
                    for (int n = 0; n < 2; ++n) { const int o = bj * HALF + n * 16; const f32x4 d = *(const f32x4*)(gp + o) * acc[0][bj][m][n];
#pragma unroll
                        for (int e = 0; e < 4; ++e) __hip_atomic_fetch_add(xp + o + e, d[e], __ATOMIC_RELAXED, __HIP_MEMORY_SCOPE_AGENT); } }
        }
    }
};
struct EpiRelu2 {
    static constexpr bool PERM = true, AFTER_DRAIN = false, IDEMPOTENT = true;
    bf16_t* O; int ldc;
    __device__ __forceinline__ void operator()(const f32x4 (&acc)[2][2][4][2], const Unit& u, int wr, int wc, int fr, int fq) const {
        const int row0 = u.pm * BM + wr * 64 + fr, col0 = u.pn * BM + wc * 32 + 8 * fq;
#pragma unroll
        for (int ai = 0; ai < 2; ++ai)
#pragma unroll
            for (int m = 0; m < 4; ++m) { bf16_t* rowp = O + (size_t)(row0 + ai * HALF + m * 16) * ldc + col0;
#pragma unroll
                for (int bj = 0; bj < 2; ++bj) { f32x4 v0 = acc[ai][bj][m][0], v1 = acc[ai][bj][m][1];
#pragma unroll
                    for (int j = 0; j < 4; ++j) { const float a = fmaxf(v0[j], 0.f), b = fmaxf(v1[j], 0.f); v0[j] = a * a; v1[j] = b * b; }
                    u32x4 w; w.x = cvt_pk_bf16(v0[0], v0[1]); w.y = cvt_pk_bf16(v0[2], v0[3]); w.z = cvt_pk_bf16(v1[0], v1[1]); w.w = cvt_pk_bf16(v1[2], v1[3]);
                    *(u32x4*)(rowp + bj * HALF) = w; } }
    }
};
}

constexpr size_t MiB = 1u << 20;
constexpr size_t WS_CTL = 0, CTL_ZERO_BYTES = 1 * MiB;
constexpr size_t WS_MOD = 1 * MiB;
constexpr size_t WS_LB = 4 * MiB;
constexpr size_t WS_BIN = 4 * MiB + 65536;
constexpr size_t WS_E1 = 5 * MiB, WS_E2 = 8 * MiB;
constexpr size_t WS_G = 11 * MiB;
constexpr size_t WS_W = 16 * MiB;
constexpr size_t W_WIN = 0, W_WBA = 81 * MiB, W_WBB = 89 * MiB, W_WO = 97 * MiB, W_WUP = 105 * MiB, W_WDN = 137 * MiB, W_LAYER = 169 * MiB;
constexpr size_t WS_X = 692 * MiB;
constexpr size_t WS_H = 822 * MiB;
constexpr size_t WS_Z = 887 * MiB;
constexpr size_t WS_QA = 1546 * MiB;
constexpr size_t WS_KA = 1611 * MiB;
constexpr size_t WS_QB = 1676 * MiB;
constexpr size_t WS_KB = 1741 * MiB;
constexpr size_t WS_HA = 1806 * MiB;
constexpr size_t WS_HB = 1936 * MiB;
constexpr size_t WS_GP = 2066 * MiB;
constexpr size_t WS_END = 2072 * MiB;
static_assert((size_t)NINP * D * 2 <= 81 * MiB && (size_t)MP * NINP * 2 <= (WS_QA - WS_Z) && (size_t)MP * D * 2 == 65 * MiB && WS_W + 4 * W_LAYER <= WS_X, "ws map");
constexpr int CW_BAR = 4096;

constexpr size_t O_YP = 0, O_YS = O_YP + (size_t)MPR * D, O_CONVP = O_YS + (size_t)MS * D, O_CP = O_CONVP + (size_t)DEPTH * NB * 3 * 4096,
    O_NP = O_CP + (size_t)DEPTH * NB * 8 * 65536, O_MP = O_NP + (size_t)DEPTH * NB * 8 * 256, O_SP = O_MP + (size_t)DEPTH * NB * 8,
    O_CONVS = O_SP + (size_t)DEPTH * NB * 16 * 16384, O_CS = O_CONVS + (size_t)DEPTH * NSB * 3 * 4096, O_NS = O_CS + (size_t)DEPTH * NSB * 8 * 65536,
    O_MS = O_NS + (size_t)DEPTH * NSB * 8 * 256, O_SS = O_MS + (size_t)DEPTH * NSB * 8, O_END = O_SS + (size_t)DEPTH * NSB * 16 * 16384;

constexpr int RING_OFF = 0, RING_BYTES = 131072;
constexpr int LDS_BYTES = 155648;
constexpr int MISC_OFF = LDS_BYTES - 256;
constexpr int SC_Q = 0, SC_K = 33792, SC_VT = 67584, SC_VW = 79104, SC_CT = 90624, SC_P = 132864, SC_H = 142080, SC_END = 151296;
constexpr int LQB = 528;
constexpr int LVB = 144;
constexpr int HS_Q = 0, HS_K = 17408, HS_VT = 34816, HS_ST = 44032, HS_P = 61440, HS_H = 70656;
constexpr int LHB = 272;
static_assert(SC_END <= MISC_OFF, "LDS map");

#define GAS __attribute__((address_space(1)))
#define LAS __attribute__((address_space(3)))
#define DI __device__ __forceinline__
typedef unsigned short bf16;
typedef float f32x4 __attribute__((ext_vector_type(4)));
typedef unsigned u32x2 __attribute__((ext_vector_type(2)));
typedef unsigned u32x4 __attribute__((ext_vector_type(4)));
typedef short bf16x8 __attribute__((ext_vector_type(8)));
typedef GAS unsigned gu32;
#define RLX_AGENT __ATOMIC_RELAXED, __HIP_MEMORY_SCOPE_AGENT
#define LDS_WAIT() asm volatile("s_waitcnt lgkmcnt(0)" ::: "memory")
#define VM_WAIT() asm volatile("s_waitcnt vmcnt(0)" ::: "memory")
DI unsigned f2bf(float f) { unsigned u = __float_as_uint(f); return (u + 0x7fffu + ((u >> 16) & 1u)) >> 16; }
DI unsigned pk2(float lo, float hi) { return f2bf(lo) | (f2bf(hi) << 16); }
DI float wave_sum(float v) {
#pragma unroll
    for (int o = 1; o < 64; o <<= 1) v += __shfl_xor(v, o);
    return v;
}
DI unsigned cvtpk(float lo, float hi) { unsigned r; asm volatile("v_cvt_pk_bf16_f32 %0, %1, %2" : "=v"(r) : "v"(lo), "v"(hi)); return r; }
DI float logsig(float x) { return fminf(x, 0.f) - __logf(1.0f + __expf(-fabsf(x))); }
#define XB_TMO      128
#define XB_XCNT(j)  (256  + 64 * (j))
#define XB_XSUB(j)  (1280 + 64 * (j))
#define XB_XGEN(j)  (2304 + 64 * (j))
#define XB_TOP      3328
#define XB_TOPGEN   3392
#define XCD_BAR_WORDS 3456
#define XB_SPIN_CAP (1u << 18)

__device__ __forceinline__ unsigned xb_ld(unsigned* p)              { return __hip_atomic_load(p, __ATOMIC_RELAXED, __HIP_MEMORY_SCOPE_AGENT); }
__device__ __forceinline__ unsigned xb_add(unsigned* p, unsigned v) { return __hip_atomic_fetch_add(p, v, __ATOMIC_RELAXED, __HIP_MEMORY_SCOPE_AGENT); }
__device__ __forceinline__ unsigned xb_xcc_id() { return (unsigned)__builtin_amdgcn_s_getreg((3 << 11) | 20) & 0xFu; }
#define XB_SPIN(cond, bar) do { unsigned _sp = 0; while (cond) { __builtin_amdgcn_s_sleep(1); \
    if ((++_sp & 255u) == 0u) { if (xb_ld(&(bar)[XB_TMO])) break; if (_sp > XB_SPIN_CAP) { atomicAdd(&(bar)[XB_TMO], 1u); break; } } } } while (0)

__device__ __forceinline__ bool xb_tid0() { int t = threadIdx.x; asm volatile("" : "+v"(t)); return t == 0; }
struct XcdBarrier {
    unsigned* bar; unsigned x;
    volatile LAS unsigned* st;
};

__device__ __forceinline__ XcdBarrier xcd_barrier_post(unsigned* bar, volatile LAS unsigned* st) {
    XcdBarrier b; b.bar = bar; b.x = xb_xcc_id(); b.st = st;
    if (xb_tid0()) (void)xb_add(&bar[XB_XCNT(b.x)], 1u);
    return b;
}
__device__ __forceinline__ void xcd_barrier_complete(unsigned* bar, unsigned x, unsigned& nloc, unsigned& nx) {
    const unsigned G = gridDim.x * gridDim.y * gridDim.z;
    unsigned sum, cnt, mine, sp = 0u;
    for (;;) {
        sum = 0u; cnt = 0u; mine = 0u;
#pragma unroll
        for (unsigned j = 0; j < 16; ++j) { const unsigned c = xb_ld(&bar[XB_XCNT(j)]); sum += c; cnt += (c > 0u) ? 1u : 0u; mine = (j == x) ? c : mine; }
        if (sum == G) break;
        __builtin_amdgcn_s_sleep(1);
        if ((++sp & 255u) == 0u) { if (xb_ld(&bar[XB_TMO])) break; if (sp > XB_SPIN_CAP) { atomicAdd(&bar[XB_TMO], 1u); break; } }
    }
    nloc = mine > 0u ? mine : 1u; nx = cnt > 0u ? cnt : 1u;
}

__device__ __forceinline__ void xcd_barrier(const XcdBarrier& b) {
    asm volatile("s_waitcnt vmcnt(0)" ::: "memory");
    __syncthreads();
    if (xb_tid0()) {
        unsigned* bar = b.bar;
        __builtin_amdgcn_s_waitcnt(0);
        unsigned nloc = b.st[0], nx = b.st[1];
        if (nloc == 0u) { xcd_barrier_complete(bar, b.x, nloc, nx); b.st[0] = nloc; b.st[1] = nx; }
        const unsigned old = xb_add(&bar[XB_XSUB(b.x)], 1u);
        const unsigned gen = old / nloc;
        if (old + 1u == (gen + 1u) * nloc) {
            __builtin_amdgcn_fence(__ATOMIC_RELEASE, "agent");
            asm volatile("s_waitcnt vmcnt(0)" ::: "memory");
            const unsigned og = xb_add(&bar[XB_TOP], 1u);
            const unsigned tg = og / nx;
            if (og + 1u == (tg + 1u) * nx) xb_add(&bar[XB_TOPGEN], 1u);
            else XB_SPIN(xb_ld(&bar[XB_TOPGEN]) == tg, bar);
            __builtin_amdgcn_fence(__ATOMIC_ACQUIRE, "agent");
            xb_add(&bar[XB_XGEN(b.x)], 1u);
            asm volatile("s_waitcnt vmcnt(0)" ::: "memory");
        } else {
            XB_SPIN(xb_ld(&bar[XB_XGEN(b.x)]) == gen, bar);
            __builtin_amdgcn_fence(__ATOMIC_ACQUIRE, "agent");
            asm volatile("s_waitcnt vmcnt(0)" ::: "memory");
        }
    }
    __syncthreads();
}

struct Ctx { LAS unsigned char* lds; unsigned char* ws; const float* const* in; float* out; int tid, lane, wave, G, bid; };

struct TItem { const float* W; bf16* WT; int K, Nsrc, k0, n0; };
DI void p0_item_decode(const Ctx& F, int it, TItem& t) {
    constexpr int I0 = 32 * (NINP / 64), I1 = 32 * 32, I4 = 32 * 128, I5 = 128 * 32, IL = I0 + 3 * I1 + I4 + I5;
    const int l = it / IL; int r = it % IL; unsigned char* wl = F.ws + WS_W + (size_t)l * W_LAYER; const float* const* in = F.in;
    const float* W; bf16* WT; int K, Nsrc, Npad;
    if (r < I0) { W = in[13] + (size_t)l * D * NIN; WT = (bf16*)(wl + W_WIN); K = D; Nsrc = NIN; Npad = NINP; }
    else if ((r -= I0) < I1) { W = in[20] + (size_t)l * D * D; WT = (bf16*)(wl + W_WBA); K = D; Nsrc = D; Npad = D; }
    else if ((r -= I1) < I1) { W = in[21] + (size_t)l * D * D; WT = (bf16*)(wl + W_WBB); K = D; Nsrc = D; Npad = D; }
    else if ((r -= I1) < I1) { W = in[22] + (size_t)l * D * D; WT = (bf16*)(wl + W_WO); K = D; Nsrc = D; Npad = D; }
    else if ((r -= I1) < I4) { W = in[23] + (size_t)l * D * DFF; WT = (bf16*)(wl + W_WUP); K = D; Nsrc = DFF; Npad = DFF; }
    else { r -= I4; W = in[24] + (size_t)l * DFF * D; WT = (bf16*)(wl + W_WDN); K = DFF; Nsrc = D; Npad = D; }
    const int nblk = Npad / 64; t.W = W; t.WT = WT; t.K = K; t.Nsrc = Nsrc; t.k0 = 64 * (r / nblk); t.n0 = 64 * (r % nblk);
}
DI void p0_item_load(const TItem& t, int lane, f32x4 (&v)[16]) {
    const int nq = lane & 15, kr = lane >> 4, n = t.n0 + 4 * nq; const bool ok = n < t.Nsrc;
#pragma unroll
    for (int i = 0; i < 16; ++i) v[i] = ok ? *(const GAS f32x4*)(t.W + (size_t)(t.k0 + 4 * i + kr) * t.Nsrc + n) : (f32x4){0.f, 0.f, 0.f, 0.f};
}
DI void p0_item_store(const TItem& t, int lane, const f32x4 (&v)[16], LAS float* scr) {
    const int nq = lane & 15, kr = lane >> 4;
#pragma unroll
    for (int i = 0; i < 16; ++i) { LAS float* s = scr + (4 * i + kr) * 65 + 4 * nq; s[0] = v[i].x; s[1] = v[i].y; s[2] = v[i].z; s[3] = v[i].w; }
    LDS_WAIT(); asm volatile("" ::: "memory");
#pragma unroll
    for (int j = 0; j < 8; ++j) { const int pr = lane + 64 * j, nn = pr >> 3, c = pr & 7; const LAS float* s = scr + (8 * c) * 65 + nn;
        u32x4 o; o.x = cvtpk(s[0 * 65], s[1 * 65]); o.y = cvtpk(s[2 * 65], s[3 * 65]); o.z = cvtpk(s[4 * 65], s[5 * 65]); o.w = cvtpk(s[6 * 65], s[7 * 65]);
        *(GAS u32x4*)(t.WT + (size_t)(t.n0 + nn) * t.K + t.k0 + 8 * c) = o; }
    LDS_WAIT(); asm volatile("" ::: "memory");
}

DI void p0_prologue(const Ctx& F) {
    const float* const* in = F.in;
    const int gw = F.bid * 8 + F.wave, NGW = F.G * 8;
    const int gt = F.bid * 512 + F.tid, NGT = F.G * 512;
    {
        LAS float* csT = (LAS float*)F.lds;
        LAS float* red = (LAS float*)(F.lds + 98304);
        for (int i = F.tid; i < 12 * D; i += 512) { const int r = i / D, k = i % D; const float c = r < 4 ? in[7][r * D + k] : in[8][(r - 4) * D + k]; csT[k * 12 + r] = c * sigm(c); }
        __syncthreads();
        float* MOD = (float*)(F.ws + WS_MOD);
        for (int u = F.bid; u < DEPTH * (MODW / 256); u += F.G) {
            const int l = u / (MODW / 256), j0 = (u % (MODW / 256)) * 256;
            const float* wp = in[9] + (size_t)l * D * MODW + (size_t)(256 * F.wave) * MODW + j0 + 4 * F.lane;
            f32x4 acc[12];
#pragma unroll
            for (int r = 0; r < 12; ++r) acc[r] = (f32x4){0.f, 0.f, 0.f, 0.f};
#pragma unroll 8
            for (int k = 0; k < 256; ++k) { const f32x4 w = *(const GAS f32x4*)(wp + (size_t)k * MODW); const LAS f32x4* cp = (const LAS f32x4*)(csT + (256 * F.wave + k) * 12);
                const f32x4 c0 = cp[0], c1 = cp[1], c2 = cp[2];
                acc[0] += w * c0[0]; acc[1] += w * c0[1]; acc[2] += w * c0[2]; acc[3] += w * c0[3]; acc[4] += w * c1[0]; acc[5] += w * c1[1]; acc[6] += w * c1[2]; acc[7] += w * c1[3];
                acc[8] += w * c2[0]; acc[9] += w * c2[1]; acc[10] += w * c2[2]; acc[11] += w * c2[3]; }
#pragma unroll
            for (int hf = 0; hf < 2; ++hf) {
#pragma unroll
                for (int r = 0; r < 6; ++r) *(LAS f32x4*)(red + ((F.wave * 6 + r) * 256 + 4 * F.lane)) = acc[6 * hf + r];
                __syncthreads();
                for (int i = F.tid; i < 6 * 256; i += 512) { const int r = i / 256, c = i % 256; float s = 0.f;
#pragma unroll
                    for (int w = 0; w < 8; ++w) s += red[(w * 6 + r) * 256 + c];
                    MOD[((size_t)l * 12 + 6 * hf + r) * MODW + j0 + c] = s + in[10][(size_t)l * MODW + j0 + c]; }
                __syncthreads();
            }
        }
    }
    {
        LAS float* scr = (LAS float*)(F.lds + F.wave * 16640);
        constexpr int IL = 32 * (NINP / 64) + 3 * 32 * 32 + 32 * 128 + 128 * 32, NIT = DEPTH * IL;
        f32x4 va[16], vb[16]; TItem ta, tb;
        int it = gw;
        if (it < NIT) { p0_item_decode(F, it, ta); p0_item_load(ta, F.lane, va); }
        while (it < NIT) {
            const int itn = it + NGW;
            if (itn < NIT) { p0_item_decode(F, itn, tb); p0_item_load(tb, F.lane, vb); }
            p0_item_store(ta, F.lane, va, scr);
            it = itn; if (it >= NIT) break;
            const int itn2 = it + NGW;
            if (itn2 < NIT) { p0_item_decode(F, itn2, ta); p0_item_load(ta, F.lane, va); }
            p0_item_store(tb, F.lane, vb, scr);
            it = itn2;
        }
    }
    {
        f32x4* Xs = (f32x4*)(F.ws + WS_X) + (size_t)MPR * D / 4; const f32x4* xs = (const f32x4*)in[1];
        for (size_t i = gt; i < (size_t)MS * D / 4; i += NGT) Xs[i] = xs[i];
        const size_t pad0 = (size_t)M * D * 2 / 16, pad1 = (size_t)MP * D * 2 / 16;
        u32x4* h4 = (u32x4*)(F.ws + WS_H); u32x4* a4 = (u32x4*)(F.ws + WS_QA); u32x4* b4 = (u32x4*)(F.ws + WS_KA);
        for (size_t i = pad0 + gt; i < pad1; i += NGT) { const u32x4 z = {0u, 0u, 0u, 0u}; h4[i] = z; a4[i] = z; b4[i] = z; }
    }
    {
        float* LB = (float*)(F.ws + WS_LB);
        for (int d = gt; d < 2048; d += NGT) { float r[4], mx = -1e30f;
#pragma unroll
            for (int l = 0; l < 4; ++l) { r[l] = in[18][l * 2048 + d]; mx = fmaxf(mx, r[l]); }
            float e[4], s = 0.f;
#pragma unroll
            for (int l = 0; l < 4; ++l) { e[l] = __expf(r[l] - mx); s += e[l]; }
            const float inv = 1.0f / s; float cum = 0.f;
#pragma unroll
            for (int l = 0; l < 4; ++l) { if (l > 0) cum += e[l] * inv; LB[l * 2048 + d] = cum; } }
        float* BIN = (float*)(F.ws + WS_BIN);
        for (int i = gt; i < DEPTH * NINP; i += NGT) { const int l = i / NINP, c = i % NINP; BIN[i] = c < NIN ? in[14][(size_t)l * NIN + c] : 0.f; }
    }
}

DI void norm_phase(const Ctx& F, const float* gain, const float* modl  , int sh_off, int sc_off, const float* Xp  ) {
    const int gw = F.bid * 8 + F.wave, NGW = F.G * 8;
    const float* X = (const float*)(F.ws + WS_X); bf16* H = (bf16*)(F.ws + WS_H);
    for (int row = gw; row < M; row += NGW) {
        const GAS f32x4* xr = (const GAS f32x4*)((row < MPR ? Xp : X) + (size_t)row * D) + F.lane;
        f32x4 v[8]; float ss = 0.f;
#pragma unroll
        for (int j = 0; j < 8; ++j) { v[j] = xr[64 * j]; ss += (v[j].x * v[j].x + v[j].y * v[j].y) + (v[j].z * v[j].z + v[j].w * v[j].w); }
        const float rs = rsqrtf(wave_sum(ss) * (1.0f / D) + EPS);
        const float* mb = modl + (size_t)row_batch(row) * MODW;
        GAS u32x2* o8 = (GAS u32x2*)(H + (size_t)row * D) + F.lane;
#pragma unroll
        for (int j = 0; j < 8; ++j) { const int c = 4 * F.lane + 256 * j; const f32x4 g = *(const f32x4*)(gain + c), sc = *(const f32x4*)(mb + sc_off + c), sh = *(const f32x4*)(mb + sh_off + c);
            const f32x4 y = (v[j] * rs) * g * (sc + 1.0f) + sh; u32x2 w; w.x = pk2(y.x, y.y); w.y = pk2(y.z, y.w); o8[64 * j] = w; }
    }
}
DI void final_norm_phase(const Ctx& F) {
    const int gw = F.bid * 8 + F.wave, NGW = F.G * 8;
    const float* X = (const float*)(F.ws + WS_X); const float* gain = F.in[25];
    for (int row = gw; row < M; row += NGW) {
        const GAS f32x4* xr = (const GAS f32x4*)(X + (size_t)row * D) + F.lane;
        f32x4 v[8]; float ss = 0.f;
#pragma unroll
        for (int j = 0; j < 8; ++j) { v[j] = xr[64 * j]; ss += (v[j].x * v[j].x + v[j].y * v[j].y) + (v[j].z * v[j].z + v[j].w * v[j].w); }
        const float rs = rsqrtf(wave_sum(ss) * (1.0f / D) + EPS);
        GAS f32x4* o = (GAS f32x4*)(F.out + (size_t)row * D) + F.lane;
#pragma unroll
        for (int j = 0; j < 8; ++j) { const f32x4 g = *(const f32x4*)(gain + 4 * F.lane + 256 * j); o[64 * j] = (v[j] * rs) * g; }
    }
}

DI void prep_phase(const Ctx& F, int l) {
    const bf16* Z = (const bf16*)(F.ws + WS_Z);
    bf16* QA = (bf16*)(F.ws + WS_QA); bf16* KA = (bf16*)(F.ws + WS_KA); bf16* QB = (bf16*)(F.ws + WS_QB); bf16* KB = (bf16*)(F.ws + WS_KB);
    float* E1 = (float*)(F.ws + WS_E1); float* E2 = (float*)(F.ws + WS_E2);
    const float* LB = (const float*)(F.ws + WS_LB) + l * 2048;
    constexpr int NGC = 12, NCONV = M / 16, NHG = NCHUNKS * 8;
    const float* G = (const float*)(F.ws + WS_G); float* GP = (float*)(F.ws + WS_GP);
    const bool chainblk = F.bid < NGC && F.G > 2 * NGC;
    const int it_step = F.G > 2 * NGC ? (chainblk ? NGC + NCONV + NHG : F.G - NGC) : F.G;
    for (int it0 = F.bid; it0 < NGC + NCONV + NHG; it0 += it_step) {
        if (it0 < NGC) {
            const int chain = it0 * 8 + F.wave, lane = F.lane;
            const bool sample = chain >= 32; const int cc = sample ? chain - 32 : chain, b = cc >> 3, h = cc & 7;
            const int row0 = sample ? MPR + b * SSEQ : b * SEQ, nchunk = sample ? 1 : SEQ / 64, Tv = sample ? SSEQ : 64;
            float m_prev = sample ? F.in[5][((size_t)l * NSB + b) * 8 + h] : 0.f;
            for (int c = 0; c < nchunk; ++c) {
                const int r0 = row0 + 64 * c;
                const float igv = lane < Tv ? G[(size_t)(r0 + lane) * 16 + h] : -1e30f; const float lfv = lane < Tv ? logsig(G[(size_t)(r0 + lane) * 16 + 8 + h]) : 0.f;
                float bc = lfv;
#pragma unroll
                for (int o = 1; o < 64; o <<= 1) { const float y = __shfl_up(bc, o); if (lane >= o) bc += y; }
                float gm = igv - bc;
#pragma unroll
                for (int o = 1; o < 64; o <<= 1) { const float y = __shfl_up(gm, o); if (lane >= o) gm = fmaxf(gm, y); }
                const float mt = bc + fmaxf(gm, m_prev);
                const float winter = __expf(bc + m_prev - mt), enm = __expf(-mt);
                const float m_last = __shfl(mt, 63), b_last = __shfl(bc, 63);
                const float wlast = __expf(b_last - bc + igv - m_last);
                if (lane < Tv) { float* gp = GP + ((size_t)(r0 + lane) * 8 + h) * 8; *(f32x4*)gp = (f32x4){bc - mt, igv - bc, winter, enm}; *(f32x4*)(gp + 4) = (f32x4){wlast, mt, 0.f, 0.f}; }
                m_prev = m_last;
            }
            continue;
        }
        const int it = it0 - NGC;
        if (it < NCONV) {
            const int r0 = it * 16, c0 = 8 * F.tid; const bool sample = r0 >= MPR;
            const int t0 = sample ? 0 : (r0 & (SEQ - 1)); const int bs = sample ? (r0 - MPR) >> 4 : (r0 >> 12);
            float w[4][8], cb[8];
#pragma unroll
            for (int j = 0; j < 4; ++j) { const f32x4 a = *(const f32x4*)(F.in[15] + ((size_t)l * 4 + j) * 4096 + c0), b = *(const f32x4*)(F.in[15] + ((size_t)l * 4 + j) * 4096 + c0 + 4);
                w[j][0] = a.x; w[j][1] = a.y; w[j][2] = a.z; w[j][3] = a.w; w[j][4] = b.x; w[j][5] = b.y; w[j][6] = b.z; w[j][7] = b.w; }
            { const f32x4 a = *(const f32x4*)(F.in[16] + (size_t)l * 4096 + c0), b = *(const f32x4*)(F.in[16] + (size_t)l * 4096 + c0 + 4);
                cb[0] = a.x; cb[1] = a.y; cb[2] = a.z; cb[3] = a.w; cb[4] = b.x; cb[5] = b.y; cb[6] = b.z; cb[7] = b.w; }
            float z0[8], z1[8], z2[8];
            if (t0 == 0) {
                if (sample) { const float* cc = F.in[2] + (((size_t)l * NSB + bs) * 3) * 4096 + c0;
#pragma unroll
                    for (int e = 0; e < 8; ++e) { z0[e] = cc[e]; z1[e] = cc[4096 + e]; z2[e] = cc[8192 + e]; } }
                else {
#pragma unroll
                    for (int e = 0; e < 8; ++e) { z0[e] = 0.f; z1[e] = 0.f; z2[e] = 0.f; } }
            } else {
                pg8::unpack8(*(const u32x4*)(Z + (size_t)(r0 - 3) * NINP + c0), z0); pg8::unpack8(*(const u32x4*)(Z + (size_t)(r0 - 2) * NINP + c0), z1); pg8::unpack8(*(const u32x4*)(Z + (size_t)(r0 - 1) * NINP + c0), z2);
            }
            const bool last = sample || (t0 + 16 == SEQ);
            float* cout = F.out + (sample ? O_CONVS + (((size_t)l * NSB + bs) * 3) * 4096 : O_CONVP + (((size_t)l * NB + bs) * 3) * 4096) + c0;
#pragma unroll
            for (int rr = 0; rr < 16; ++rr) {
                float z3[8]; pg8::unpack8(*(const u32x4*)(Z + (size_t)(r0 + rr) * NINP + c0), z3);
                float y[8];
#pragma unroll
                for (int e = 0; e < 8; ++e) { const float a = cb[e] + w[0][e] * z0[e] + w[1][e] * z1[e] + w[2][e] * z2[e] + w[3][e] * z3[e]; y[e] = a * sigm(a); }
                if (c0 < 2048) { u32x4 o; o.x = pk2(y[0], y[1]); o.y = pk2(y[2], y[3]); o.z = pk2(y[4], y[5]); o.w = pk2(y[6], y[7]); *(u32x4*)(QA + (size_t)(r0 + rr) * D + c0) = o; }
                else { u32x4 o; o.x = pk2(y[0] * 0.0625f, y[1] * 0.0625f); o.y = pk2(y[2] * 0.0625f, y[3] * 0.0625f); o.z = pk2(y[4] * 0.0625f, y[5] * 0.0625f); o.w = pk2(y[6] * 0.0625f, y[7] * 0.0625f);
                    *(u32x4*)(KA + (size_t)(r0 + rr) * D + (c0 - 2048)) = o; }
                if (last && rr >= 13) { float* cp = cout + (size_t)(rr - 13) * 4096; *(f32x4*)cp = (f32x4){z3[0], z3[1], z3[2], z3[3]}; *(f32x4*)(cp + 4) = (f32x4){z3[4], z3[5], z3[6], z3[7]}; }
#pragma unroll
                for (int e = 0; e < 8; ++e) { z0[e] = z1[e]; z1[e] = z2[e]; z2[e] = z3[e]; }
            }
        } else {
            const int hi = it - NCONV, ci = hi >> 3, cbase = (hi & 7) * 256, d = F.tid & 255, hf = F.tid >> 8;
            const bool sample = ci >= NB * 64; const int r0 = sample ? MPR + (ci - NB * 64) * 16 : ci * 64; const int Tv = sample ? 16 : 64;
            LAS unsigned char* FBs = F.lds; LAS unsigned char* QBs = F.lds + 32768; LAS float* xch = (LAS float*)(F.lds + 65536);
#pragma unroll
            for (int i = 0; i < 4; ++i) { const int idx = F.tid + 512 * i, rr = idx >> 5, sg = idx & 31;
                if (rr < Tv) { *(LAS u32x4*)(FBs + rr * 512 + sg * 16) = *(const GAS u32x4*)(Z + (size_t)(r0 + rr) * NINP + ZFB + cbase + 8 * sg);
                               *(LAS u32x4*)(QBs + rr * 512 + sg * 16) = *(const GAS u32x4*)(Z + (size_t)(r0 + rr) * NINP + ZQB + cbase + 8 * sg); } }
            __syncthreads();
            const float lb = LB[cbase + d], oml = 1.0f - lb;
            float bc[32]; float run = 0.f;
#pragma unroll
            for (int i = 0; i < 32; ++i) { const int t = 32 * hf + i;
                if (t < Tv) { const float fb = fminf(fmaxf(bf2f(*(const LAS unsigned short*)(FBs + t * 512 + d * 2)), -30.f), 30.f); const float f = lb + oml * __builtin_amdgcn_rcpf(1.0f + __expf(-fb)); run += fmaxf(__logf(f), -60.0f); }
                bc[i] = run; }
            if (hf == 0) xch[d] = run;
            __syncthreads();
            const float base = hf ? xch[d] : 0.f; const float bR = hf ? base : run;
            if (hf) { E1[(size_t)ci * 2048 + cbase + d] = __expf(bR); E2[(size_t)ci * 2048 + cbase + d] = __expf(run); }
#pragma unroll
            for (int i = 0; i < 32; ++i) { const int t = 32 * hf + i;
                if (t < Tv) { const float fb = fminf(fmaxf(bf2f(*(const LAS unsigned short*)(FBs + t * 512 + d * 2)), -30.f), 30.f), qv = bf2f(*(const LAS unsigned short*)(QBs + t * 512 + d * 2));
                    const float e = __expf(-fb), s = __builtin_amdgcn_rcpf(1.0f + e), bt = base + bc[i];
                    const float q = qv * sigm(qv) * __expf(bt - bR), k = oml * e * s * __expf(bR - bt);
                    *(LAS unsigned short*)(QBs + t * 512 + d * 2) = (unsigned short)f2bf(q); *(LAS unsigned short*)(FBs + t * 512 + d * 2) = (unsigned short)f2bf(k); } }
            __syncthreads();
#pragma unroll
            for (int i = 0; i < 4; ++i) { const int idx = F.tid + 512 * i, rr = idx >> 5, sg = idx & 31;
                if (rr < Tv) { *(GAS u32x4*)(QB + (size_t)(r0 + rr) * D + cbase + 8 * sg) = *(const LAS u32x4*)(QBs + rr * 512 + sg * 16);
                               *(GAS u32x4*)(KB + (size_t)(r0 + rr) * D + cbase + 8 * sg) = *(const LAS u32x4*)(FBs + rr * 512 + sg * 16); } }
            __syncthreads();
        }
    }
}

DI void headnorm_phase(const Ctx& F, int l) {
    const int gw = F.bid * 8 + F.wave, NGW = F.G * 8;
    const bf16* Z = (const bf16*)(F.ws + WS_Z); const bf16* HA = (const bf16*)(F.ws + WS_HA); const bf16* HB = (const bf16*)(F.ws + WS_HB);
    bf16* YA = (bf16*)(F.ws + WS_QA); bf16* YB = (bf16*)(F.ws + WS_KA);
    const float* ga = F.in[17] + (size_t)l * 2048; const float* gb = F.in[19] + (size_t)l * 2048;
    for (int row = gw; row < M; row += NGW) {
        u32x4 ha[4], hb[4], oa[4], ob[4];
#pragma unroll
        for (int j = 0; j < 4; ++j) { const int c = 512 * j + 8 * F.lane;
            ha[j] = *(const GAS u32x4*)(HA + (size_t)row * D + c); hb[j] = *(const GAS u32x4*)(HB + (size_t)row * D + c);
            oa[j] = *(const GAS u32x4*)(Z + (size_t)row * NINP + ZOA + c); ob[j] = *(const GAS u32x4*)(Z + (size_t)row * NINP + ZOGB + c); }
#pragma unroll
        for (int j = 0; j < 4; ++j) { const int c = 512 * j + 8 * F.lane;
            { float hv[8], ov[8]; pg8::unpack8(ha[j], hv); pg8::unpack8(oa[j], ov); float ss = 0.f;
#pragma unroll
              for (int e = 0; e < 8; ++e) ss += hv[e] * hv[e];
#pragma unroll
              for (int o = 1; o < 32; o <<= 1) ss += __shfl_xor(ss, o);
              const float rs = rsqrtf(ss * (1.0f / 256.0f) + EPS); const f32x4 g0 = *(const f32x4*)(ga + c), g1 = *(const f32x4*)(ga + c + 4); float y[8];
#pragma unroll
              for (int e = 0; e < 8; ++e) y[e] = hv[e] * rs * (e < 4 ? g0[e] : g1[e - 4]) * sigm(ov[e]);
              u32x4 w; w.x = pk2(y[0], y[1]); w.y = pk2(y[2], y[3]); w.z = pk2(y[4], y[5]); w.w = pk2(y[6], y[7]); *(GAS u32x4*)(YA + (size_t)row * D + c) = w; }
            { float hv[8], ov[8]; pg8::unpack8(hb[j], hv); pg8::unpack8(ob[j], ov); float ss = 0.f;
#pragma unroll
              for (int e = 0; e < 8; ++e) ss += hv[e] * hv[e];
#pragma unroll
              for (int o = 1; o < 16; o <<= 1) ss += __shfl_xor(ss, o);
              const float rs = rsqrtf(ss * (1.0f / 128.0f) + EPS); const f32x4 g0 = *(const f32x4*)(gb + c), g1 = *(const f32x4*)(gb + c + 4); float y[8];
#pragma unroll
              for (int e = 0; e < 8; ++e) y[e] = hv[e] * rs * (e < 4 ? g0[e] : g1[e - 4]) * sigm(ov[e]);
              u32x4 w; w.x = pk2(y[0], y[1]); w.y = pk2(y[2], y[3]); w.z = pk2(y[4], y[5]); w.w = pk2(y[6], y[7]); *(GAS u32x4*)(YB + (size_t)row * D + c) = w; }
        }
    }
}

DI bf16x8 frag(const LAS unsigned char* base, int row, int ldb, int kbyte) { return *(const LAS bf16x8*)(base + row * ldb + kbyte); }
DI bf16x8 frag_t(const LAS unsigned char* base, int k0, int ldb, int col) {
    const LAS unsigned short* p = (const LAS unsigned short*)(base + k0 * ldb + col * 2); bf16x8 r;
#pragma unroll
    for (int j = 0; j < 8; ++j) r[j] = (short)p[j * (ldb / 2)];
    return r;
}
#define LBAR() do { asm volatile("s_waitcnt lgkmcnt(0)" ::: "memory"); __builtin_amdgcn_s_barrier(); asm volatile("" ::: "memory"); } while (0)
#ifndef PROBE_ST
#define PROBE_ST 1
#endif
#ifndef PROBE_S2
#define PROBE_S2 1
#endif
#ifndef PROBE_S3
#define PROBE_S3 1
#endif
#ifndef PROBE_S4
#define PROBE_S4 1
#endif
#define PROBE_LOOP(n) int reps_ = (n); asm volatile("" : "+s"(reps_)); _Pragma("nounroll") for (int rp_ = 0; rp_ < reps_; ++rp_)
#define MFMA16(a, b, c) __builtin_amdgcn_mfma_f32_16x16x32_bf16((a), (b), (c), 0, 0, 0)

DI void mlstm_unit(LAS unsigned char* lds, const bf16* QA, const bf16* KA, const bf16* Z, const float* GP, bf16* HA,
                   int row0, int nchunk, int Tv, int h, int vs, const float* C0, const float* n0, const float* m0p, float* Cout, float* nout, float* mout) {
    int tid_ = threadIdx.x; asm volatile("" : "+v"(tid_));
    const int tid = tid_, lane = tid & 63, W = __builtin_amdgcn_readfirstlane(tid >> 6), g = lane >> 4, li = lane & 15;
    LAS unsigned char* Qs = lds + SC_Q; LAS unsigned char* Ks = lds + SC_K; LAS unsigned char* VT = lds + SC_VT; LAS unsigned char* VW = lds + SC_VW;
    LAS unsigned char* CTs = lds + SC_CT; LAS unsigned char* Ps = lds + SC_P; LAS unsigned char* Hs = lds + SC_H;
    f32x4 cacc[2][5];
#pragma unroll
    for (int di = 0; di < 2; ++di)
#pragma unroll
        for (int vi = 0; vi < 5; ++vi)
#pragma unroll
            for (int r = 0; r < 4; ++r) { const int d = 16 * (2 * W + di) + 4 * g + r; float v = 0.f;
                if (C0) { if (vi < 4) v = C0[(size_t)d * 256 + 64 * vs + 16 * vi + li]; else if (li == 0) v = n0[d]; }
                cacc[di][vi][r] = v; }
    float m_prev = m0p ? *m0p : 0.f;
    for (int i = tid; i < 16 * 72; i += 512) { const int rr = 64 + i / 72, cc = i % 72;
        *(LAS unsigned short*)(VT + rr * LVB + cc * 2) = (rr == 64 && cc < 64) ? (unsigned short)0x3F80 : (unsigned short)0; *(LAS unsigned short*)(VW + rr * LVB + cc * 2) = 0; }
    u32x4 pq[4], pk[4]; u32x2 pva, pvb; f32x4 pg0, pg1;
#define ML_PREFETCH(c) do { const int r0_ = row0 + 64 * (c); \
        _Pragma("unroll") for (int i = 0; i < 4; ++i) { const int idx = tid + 512 * i, rr = idx >> 5, sg = idx & 31; \
            if (rr < Tv) { pq[i] = *(const GAS u32x4*)(QA + (size_t)(r0_ + rr) * D + 256 * h + 8 * sg); pk[i] = *(const GAS u32x4*)(KA + (size_t)(r0_ + rr) * D + 256 * h + 8 * sg); } \
            else { pq[i] = (u32x4){0u, 0u, 0u, 0u}; pk[i] = (u32x4){0u, 0u, 0u, 0u}; } } \
        { const int fp = tid & 31, vq = tid >> 5; const bf16* vp_ = Z + (size_t)(r0_ + 2 * fp) * NINP + ZVA + 256 * h + 64 * vs + 4 * vq; \
          pva = 2 * fp < Tv ? *(const GAS u32x2*)vp_ : (u32x2){0u, 0u}; pvb = 2 * fp + 1 < Tv ? *(const GAS u32x2*)(vp_ + NINP) : (u32x2){0u, 0u}; } \
        if (lane < Tv) { const float* gp_ = GP + ((size_t)(r0_ + lane) * 8 + h) * 8; pg0 = *(const GAS f32x4*)gp_; pg1 = *(const GAS f32x4*)(gp_ + 4); } \
        else { pg0 = (f32x4){0.f, -1e30f, 0.f, 1.f}; pg1 = (f32x4){0.f, 0.f, 0.f, 0.f}; } } while (0)
    ML_PREFETCH(0);
    for (int c = 0; c < nchunk; ++c) {
        const int r0 = row0 + 64 * c;
        const float gx = pg0[0], gy = pg0[1], winter = pg0[2], enm = pg0[3], wlast = pg1[0];
        const float m_last = __shfl(pg1[1], Tv - 1), decay = __shfl(winter, Tv - 1);
        { PROBE_LOOP(PROBE_ST) { asm volatile("" ::: "memory");
#pragma unroll
        for (int i = 0; i < 4; ++i) { const int idx = tid + 512 * i, rr = idx >> 5, sg = idx & 31; *(LAS u32x4*)(Qs + rr * LQB + sg * 16) = pq[i]; *(LAS u32x4*)(Ks + rr * LQB + sg * 16) = pk[i]; }
        {
          const int fp = tid & 31, vq = tid >> 5; const float wa = __shfl(wlast, 2 * fp), wb = __shfl(wlast, 2 * fp + 1);
          const unsigned a0 = pva.x, a1 = pva.y, b0 = pvb.x, b1 = pvb.y;
          const unsigned r0w = (a0 & 0xffffu) | (b0 << 16), r1w = (a0 >> 16) | (b0 & 0xffff0000u), r2w = (a1 & 0xffffu) | (b1 << 16), r3w = (a1 >> 16) | (b1 & 0xffff0000u);
          const unsigned s0w = cvtpk(__uint_as_float(a0 << 16) * wa, __uint_as_float(b0 << 16) * wb), s1w = cvtpk(__uint_as_float(a0 & 0xffff0000u) * wa, __uint_as_float(b0 & 0xffff0000u) * wb);
          const unsigned s2w = cvtpk(__uint_as_float(a1 << 16) * wa, __uint_as_float(b1 << 16) * wb), s3w = cvtpk(__uint_as_float(a1 & 0xffff0000u) * wa, __uint_as_float(b1 & 0xffff0000u) * wb);
          LAS unsigned char* vt = VT + (4 * vq) * LVB + 4 * fp; LAS unsigned char* vw = VW + (4 * vq) * LVB + 4 * fp;
          *(LAS unsigned*)(vt) = r0w; *(LAS unsigned*)(vt + LVB) = r1w; *(LAS unsigned*)(vt + 2 * LVB) = r2w; *(LAS unsigned*)(vt + 3 * LVB) = r3w;
          *(LAS unsigned*)(vw) = s0w; *(LAS unsigned*)(vw + LVB) = s1w; *(LAS unsigned*)(vw + 2 * LVB) = s2w; *(LAS unsigned*)(vw + 3 * LVB) = s3w; }
        if (W == 0) *(LAS unsigned short*)(VW + 64 * LVB + lane * 2) = (unsigned short)(cvtpk(wlast, wlast) & 0xffffu);
#pragma unroll
        for (int di = 0; di < 2; ++di)
#pragma unroll
            for (int vi = 0; vi < 5; ++vi) { u32x2 w; w.x = cvtpk(cacc[di][vi][0], cacc[di][vi][1]); w.y = cvtpk(cacc[di][vi][2], cacc[di][vi][3]);
                *(LAS u32x2*)(CTs + (16 * vi + li) * LQB + (16 * (2 * W + di) + 4 * g) * 2) = w; }
        } }
        LBAR();
        if (c + 1 < nchunk) ML_PREFETCH(c + 1);
        { PROBE_LOOP(PROBE_S2)
        { asm volatile("" ::: "memory");
            const int tt = W & 3, sh = W >> 2;
            f32x4 sacc[2] = {{0.f, 0.f, 0.f, 0.f}, {0.f, 0.f, 0.f, 0.f}};
#pragma unroll
            for (int kk = 0; kk < 8; ++kk) { const bf16x8 bq = frag(Qs, 16 * tt + li, LQB, 64 * kk + 16 * g);
#pragma unroll
                for (int i = 0; i < 2; ++i) if (2 * sh + i <= tt) { const bf16x8 ak = frag(Ks, 16 * (2 * sh + i) + li, LQB, 64 * kk + 16 * g); sacc[i] = MFMA16(ak, bq, sacc[i]); } }
            const int t = 16 * tt + li; const float xt = __shfl(gx, t);
#pragma unroll
            for (int i = 0; i < 2; ++i) { float p[4];
#pragma unroll
                for (int r = 0; r < 4; ++r) { const int s = 16 * (2 * sh + i) + 4 * g + r; const float ys = __shfl(gy, s);
                    p[r] = (s <= t) ? sacc[i][r] * __expf(xt + ys) : 0.f; }
                u32x2 w; w.x = cvtpk(p[0], p[1]); w.y = cvtpk(p[2], p[3]); *(LAS u32x2*)(Ps + t * LVB + (16 * (2 * sh + i) + 4 * g) * 2) = w; }
        } }
        LBAR();
        { PROBE_LOOP(PROBE_S3)
        { asm volatile("" ::: "memory");
            const int tt = W & 3, vh = W >> 2; const int vt0 = 2 * vh, vt1 = 2 * vh + 1;
            f32x4 a1[3], a2[3];
#pragma unroll
            for (int i = 0; i < 3; ++i) { a1[i] = (f32x4){0.f, 0.f, 0.f, 0.f}; a2[i] = (f32x4){0.f, 0.f, 0.f, 0.f}; }
#pragma unroll
            for (int kk = 0; kk < 2; ++kk) { const bf16x8 ap = frag(Ps, 16 * tt + li, LVB, 64 * kk + 16 * g);
                a1[0] = MFMA16(ap, frag(VT, 16 * vt0 + li, LVB, 64 * kk + 16 * g), a1[0]); a1[1] = MFMA16(ap, frag(VT, 16 * vt1 + li, LVB, 64 * kk + 16 * g), a1[1]);
                a1[2] = MFMA16(ap, frag(VT, 64 + li, LVB, 64 * kk + 16 * g), a1[2]); }
#pragma unroll
            for (int kk = 0; kk < 8; ++kk) { const bf16x8 aq = frag(Qs, 16 * tt + li, LQB, 64 * kk + 16 * g);
                a2[0] = MFMA16(aq, frag(CTs, 16 * vt0 + li, LQB, 64 * kk + 16 * g), a2[0]); a2[1] = MFMA16(aq, frag(CTs, 16 * vt1 + li, LQB, 64 * kk + 16 * g), a2[1]);
                a2[2] = MFMA16(aq, frag(CTs, 64 + li, LQB, 64 * kk + 16 * g), a2[2]); }
#pragma unroll
            for (int r = 0; r < 4; ++r) { const int t = 16 * tt + 4 * g + r; const float wi = __shfl(winter, t), en = __shfl(enm, t);
                const float o2 = a1[2][r] + wi * a2[2][r]; const float qn = __shfl(o2, lane & 48); const float inv = __builtin_amdgcn_rcpf(fmaxf(fabsf(qn), en));
                const unsigned hw = cvtpk((a1[0][r] + wi * a2[0][r]) * inv, (a1[1][r] + wi * a2[1][r]) * inv);
                *(LAS unsigned short*)(Hs + t * LVB + (16 * vt0 + li) * 2) = (unsigned short)(hw & 0xffffu); *(LAS unsigned short*)(Hs + t * LVB + (16 * vt1 + li) * 2) = (unsigned short)(hw >> 16); }
        } }
#pragma unroll
        for (int di = 0; di < 2; ++di)
#pragma unroll
            for (int vi = 0; vi < 5; ++vi) cacc[di][vi] = cacc[di][vi] * decay;
#pragma unroll
        for (int kk = 0; kk < 2; ++kk) { bf16x8 ak[2];
#pragma unroll
            for (int di = 0; di < 2; ++di) ak[di] = frag_t(Ks, 32 * kk + 8 * g, LQB, 16 * (2 * W + di) + li);
#pragma unroll
            for (int vi = 0; vi < 5; ++vi) { const bf16x8 bv = frag(VW, 16 * vi + li, LVB, 64 * kk + 16 * g);
#pragma unroll
                for (int di = 0; di < 2; ++di) cacc[di][vi] = MFMA16(ak[di], bv, cacc[di][vi]); } }
        if (PROBE_S4 > 1) { PROBE_LOOP(PROBE_S4 - 1) { asm volatile("" ::: "memory"); f32x4 dacc[2][5];
#pragma unroll
            for (int di = 0; di < 2; ++di)
#pragma unroll
                for (int vi = 0; vi < 5; ++vi) dacc[di][vi] = (f32x4){0.f, 0.f, 0.f, 0.f};
#pragma unroll
            for (int kk = 0; kk < 2; ++kk) { bf16x8 ak[2];
#pragma unroll
                for (int di = 0; di < 2; ++di) ak[di] = frag_t(Ks, 32 * kk + 8 * g, LQB, 16 * (2 * W + di) + li);
#pragma unroll
                for (int vi = 0; vi < 5; ++vi) { const bf16x8 bv = frag(VW, 16 * vi + li, LVB, 64 * kk + 16 * g);
#pragma unroll
                    for (int di = 0; di < 2; ++di) dacc[di][vi] = MFMA16(ak[di], bv, dacc[di][vi]); } }
#pragma unroll
            for (int di = 0; di < 2; ++di)
#pragma unroll
                for (int vi = 0; vi < 5; ++vi) asm volatile("" :: "v"(dacc[di][vi])); } }
        m_prev = m_last;
        LBAR();
        { const int rr = tid >> 3, sg = tid & 7; if (rr < Tv) *(GAS u32x4*)(HA + (size_t)(r0 + rr) * D + 256 * h + 64 * vs + 8 * sg) = *(const LAS u32x4*)(Hs + rr * LVB + sg * 16); }
    }
#undef ML_PREFETCH
#pragma unroll
    for (int di = 0; di < 2; ++di)
#pragma unroll
        for (int r = 0; r < 4; ++r) { const int d = 16 * (2 * W + di) + 4 * g + r;
#pragma unroll
            for (int vi = 0; vi < 4; ++vi) Cout[(size_t)d * 256 + 64 * vs + 16 * vi + li] = cacc[di][vi][r];
            if (vs == 0 && li == 0) nout[d] = cacc[di][4][r]; }
    if (vs == 0 && tid == 0) *mout = m_prev;
}

DI void hgrn_unit(LAS unsigned char* lds, const bf16* QB, const bf16* KB, const bf16* Z, const float* E1, const float* E2, bf16* HB,
                  int row0, int nchunk, int Tv, int h, int vs, int ci0, const float* S0, float* Sout) {
    int tid_ = threadIdx.x; asm volatile("" : "+v"(tid_));
    const int tid = tid_, lane = tid & 63, W = __builtin_amdgcn_readfirstlane(tid >> 6), g = lane >> 4, li = lane & 15;
    LAS unsigned char* Qs = lds + HS_Q; LAS unsigned char* Ks = lds + HS_K; LAS unsigned char* VT = lds + HS_VT; LAS unsigned char* STs = lds + HS_ST; LAS unsigned char* Ps = lds + HS_P; LAS unsigned char* Hs = lds + HS_H;
    f32x4 sacc[4];
#pragma unroll
    for (int vi = 0; vi < 4; ++vi)
#pragma unroll
        for (int r = 0; r < 4; ++r) sacc[vi][r] = S0 ? S0[(size_t)(16 * W + 4 * g + r) * 128 + 64 * vs + 16 * vi + li] : 0.f;
    u32x4 pq[2], pk[2]; u32x2 pva, pvb; f32x4 pe1, pe2;
#define HG_PREFETCH(c) do { const int r0_ = row0 + 64 * (c); \
        _Pragma("unroll") for (int i = 0; i < 2; ++i) { const int idx = tid + 512 * i, rr = idx >> 4, sg = idx & 15; \
            if (rr < Tv) { pq[i] = *(const GAS u32x4*)(QB + (size_t)(r0_ + rr) * D + 128 * h + 8 * sg); pk[i] = *(const GAS u32x4*)(KB + (size_t)(r0_ + rr) * D + 128 * h + 8 * sg); } \
            else { pq[i] = (u32x4){0u, 0u, 0u, 0u}; pk[i] = (u32x4){0u, 0u, 0u, 0u}; } } \
        { const int fp = tid & 31, vq = tid >> 5; const bf16* vp_ = Z + (size_t)(r0_ + 2 * fp) * NINP + ZIB + 128 * h + 64 * vs + 4 * vq; \
          pva = 2 * fp < Tv ? *(const GAS u32x2*)vp_ : (u32x2){0u, 0u}; pvb = 2 * fp + 1 < Tv ? *(const GAS u32x2*)(vp_ + NINP) : (u32x2){0u, 0u}; } \
        pe1 = *(const GAS f32x4*)(E1 + (size_t)(ci0 + (c)) * 2048 + 128 * h + 16 * W + 4 * g); pe2 = *(const GAS f32x4*)(E2 + (size_t)(ci0 + (c)) * 2048 + 128 * h + 16 * W + 4 * g); } while (0)
    HG_PREFETCH(0);
    for (int c = 0; c < nchunk; ++c) {
        const int r0 = row0 + 64 * c;
        const f32x4 e2 = pe2;
        f32x4 smid[4];
#pragma unroll
        for (int vi = 0; vi < 4; ++vi) smid[vi] = sacc[vi] * pe1;
#pragma unroll
        for (int i = 0; i < 2; ++i) { const int idx = tid + 512 * i, rr = idx >> 4, sg = idx & 15; *(LAS u32x4*)(Qs + rr * LHB + sg * 16) = pq[i]; *(LAS u32x4*)(Ks + rr * LHB + sg * 16) = pk[i]; }
        { const int fp = tid & 31, vq = tid >> 5; const unsigned a0 = pva.x, a1 = pva.y, b0 = pvb.x, b1 = pvb.y; LAS unsigned char* vt = VT + (4 * vq) * LVB + 4 * fp;
          *(LAS unsigned*)(vt) = (a0 & 0xffffu) | (b0 << 16); *(LAS unsigned*)(vt + LVB) = (a0 >> 16) | (b0 & 0xffff0000u); *(LAS unsigned*)(vt + 2 * LVB) = (a1 & 0xffffu) | (b1 << 16); *(LAS unsigned*)(vt + 3 * LVB) = (a1 >> 16) | (b1 & 0xffff0000u); }
#pragma unroll
        for (int vi = 0; vi < 4; ++vi) { u32x2 w; w.x = cvtpk(smid[vi][0], smid[vi][1]); w.y = cvtpk(smid[vi][2], smid[vi][3]); *(LAS u32x2*)(STs + (16 * vi + li) * LHB + (16 * W + 4 * g) * 2) = w; }
        LBAR();
        if (c + 1 < nchunk) HG_PREFETCH(c + 1);
        {
            const int tt = W & 3, sh = W >> 2;
            f32x4 a[2] = {{0.f, 0.f, 0.f, 0.f}, {0.f, 0.f, 0.f, 0.f}};
#pragma unroll
            for (int kk = 0; kk < 4; ++kk) { const bf16x8 bq = frag(Qs, 16 * tt + li, LHB, 64 * kk + 16 * g);
#pragma unroll
                for (int i = 0; i < 2; ++i) if (2 * sh + i <= tt) a[i] = MFMA16(frag(Ks, 16 * (2 * sh + i) + li, LHB, 64 * kk + 16 * g), bq, a[i]); }
            const int t = 16 * tt + li;
#pragma unroll
            for (int i = 0; i < 2; ++i) { float p[4];
#pragma unroll
                for (int r = 0; r < 4; ++r) { const int s = 16 * (2 * sh + i) + 4 * g + r; p[r] = (s <= t) ? a[i][r] : 0.f; }
                u32x2 w; w.x = cvtpk(p[0], p[1]); w.y = cvtpk(p[2], p[3]); *(LAS u32x2*)(Ps + t * LVB + (16 * (2 * sh + i) + 4 * g) * 2) = w; }
        }
        LBAR();
        {
            const int tt = W & 3, vh = W >> 2;
            f32x4 o[2] = {{0.f, 0.f, 0.f, 0.f}, {0.f, 0.f, 0.f, 0.f}};
#pragma unroll
            for (int kk = 0; kk < 2; ++kk) { const bf16x8 ap = frag(Ps, 16 * tt + li, LVB, 64 * kk + 16 * g);
#pragma unroll
                for (int i = 0; i < 2; ++i) o[i] = MFMA16(ap, frag(VT, 16 * (2 * vh + i) + li, LVB, 64 * kk + 16 * g), o[i]); }
#pragma unroll
            for (int kk = 0; kk < 4; ++kk) { const bf16x8 aq = frag(Qs, 16 * tt + li, LHB, 64 * kk + 16 * g);
#pragma unroll
                for (int i = 0; i < 2; ++i) o[i] = MFMA16(aq, frag(STs, 16 * (2 * vh + i) + li, LHB, 64 * kk + 16 * g), o[i]); }
#pragma unroll
            for (int r = 0; r < 4; ++r) { const int t = 16 * tt + 4 * g + r;
                const unsigned hw = cvtpk(o[0][r], o[1][r]); *(LAS unsigned short*)(Hs + t * LVB + (16 * (2 * vh) + li) * 2) = (unsigned short)(hw & 0xffffu); *(LAS unsigned short*)(Hs + t * LVB + (16 * (2 * vh + 1) + li) * 2) = (unsigned short)(hw >> 16); }
        }
#pragma unroll
        for (int vi = 0; vi < 4; ++vi) sacc[vi] = smid[vi];
#pragma unroll
        for (int kk = 0; kk < 2; ++kk) { const bf16x8 ak = frag_t(Ks, 32 * kk + 8 * g, LHB, 16 * W + li);
#pragma unroll
            for (int vi = 0; vi < 4; ++vi) sacc[vi] = MFMA16(ak, frag(VT, 16 * vi + li, LVB, 64 * kk + 16 * g), sacc[vi]); }
#pragma unroll
        for (int vi = 0; vi < 4; ++vi) sacc[vi] = sacc[vi] * e2;
        LBAR();
        { const int rr = tid >> 3, sg = tid & 7; if (rr < Tv) *(GAS u32x4*)(HB + (size_t)(r0 + rr) * D + 128 * h + 64 * vs + 8 * sg) = *(const LAS u32x4*)(Hs + rr * LVB + sg * 16); }
    }
#undef HG_PREFETCH
#pragma unroll
    for (int vi = 0; vi < 4; ++vi)
#pragma unroll
        for (int r = 0; r < 4; ++r) Sout[(size_t)(16 * W + 4 * g + r) * 128 + 64 * vs + 16 * vi + li] = sacc[vi][r];
}

DI void scan_phase(const Ctx& F, int l) {
    const bf16* Z = (const bf16*)(F.ws + WS_Z);
    const bf16* QA = (const bf16*)(F.ws + WS_QA); const bf16* KA = (const bf16*)(F.ws + WS_KA); const bf16* QB = (const bf16*)(F.ws + WS_QB); const bf16* KB = (const bf16*)(F.ws + WS_KB);
    const float* GP = (const float*)(F.ws + WS_GP); const float* E1 = (const float*)(F.ws + WS_E1); const float* E2 = (const float*)(F.ws + WS_E2);
    bf16* HA = (bf16*)(F.ws + WS_HA); bf16* HB = (bf16*)(F.ws + WS_HB);
    for (int u = F.bid; u < 768; u += F.G) {
        int type, idx, sample;
        if (u < 128) { type = 0; idx = u; sample = 0; } else if (u < 256) { type = 1; idx = u - 128; sample = 0; }
        else if (u < 384) { type = 1; idx = u - 256; sample = 1; } else if (u < 512) { type = 0; idx = u - 384; sample = 1; }
        else if (u < 640) { type = 1; idx = u - 512 + 128; sample = 1; } else { type = 0; idx = u - 640 + 128; sample = 1; }
        if (type == 0) {
            const int b = idx >> 5, h = (idx >> 2) & 7, vs = idx & 3;
            const size_t so = sample ? (size_t)l * NSB + b : (size_t)l * NB + b;
            const float* C0 = sample ? F.in[3] + (so * 8 + h) * 65536 : nullptr; const float* n0 = sample ? F.in[4] + (so * 8 + h) * 256 : nullptr; const float* m0 = sample ? F.in[5] + so * 8 + h : nullptr;
            float* Co = F.out + (sample ? O_CS : O_CP) + (so * 8 + h) * 65536; float* no = F.out + (sample ? O_NS : O_NP) + (so * 8 + h) * 256; float* mo = F.out + (sample ? O_MS : O_MP) + so * 8 + h;
            mlstm_unit(F.lds, QA, KA, Z, GP, HA, sample ? MPR + b * SSEQ : b * SEQ, sample ? 1 : SEQ / 64, sample ? SSEQ : 64, h, vs, C0, n0, m0, Co, no, mo);
        } else {
            const int b = idx >> 5, h = (idx >> 1) & 15, vs = idx & 1;
            const size_t so = sample ? (size_t)l * NSB + b : (size_t)l * NB + b;
            const float* S0 = sample ? F.in[6] + (so * 16 + h) * 16384 : nullptr; float* So = F.out + (sample ? O_SS : O_SP) + (so * 16 + h) * 16384;
            hgrn_unit(F.lds, QB, KB, Z, E1, E2, HB, sample ? MPR + b * SSEQ : b * SEQ, sample ? 1 : SEQ / 64, sample ? SSEQ : 64, h, vs, sample ? NB * 64 + b : b * 64, S0, So);
        }
        __syncthreads();
    }
}

constexpr int NPH_LAYER = 10, NPHASES = 1 + DEPTH * NPH_LAYER + 1;
struct Args { const float* in[26]; float* out; unsigned char* ws; int ph_lo, ph_hi; };
static_assert(sizeof(Args) == 26 * 8 + 8 + 8 + 8, "Args has no padding");

__global__ void __launch_bounds__(512, 2) trunk_fwd(Args args) {
    extern __shared__ __attribute__((aligned(16))) unsigned char lds_raw[];
    Ctx F;
    F.lds = (LAS unsigned char*)lds_raw; F.ws = args.ws; F.in = args.in; F.out = args.out;
    F.tid = threadIdx.x; F.lane = F.tid & 63; F.wave = __builtin_amdgcn_readfirstlane(F.tid >> 6); F.G = gridDim.x; F.bid = blockIdx.x;
    volatile LAS unsigned* MISC = (volatile LAS unsigned*)(F.lds + MISC_OFF);
    if (F.tid < 64) MISC[F.tid] = 0u;
    __syncthreads();
    gu32* ctl = (gu32*)(F.ws + WS_CTL);
#if MK_PER_PHASE
#define GRID_BAR() do { } while (0)
#else
    XcdBarrier bar = xcd_barrier_post((unsigned*)(ctl + CW_BAR), MISC + 8);
#define GRID_BAR() xcd_barrier(bar)
#endif
#define LAUNDER() do { unsigned char* w_ = args.ws; float* o_ = args.out; int b_ = blockIdx.x, g_ = gridDim.x; asm volatile("" : "+s"(w_), "+s"(o_), "+s"(b_), "+s"(g_)); F.ws = w_; F.out = o_; F.bid = b_; F.G = g_; } while (0)
    const int lo = args.ph_lo, hi = args.ph_hi;
#ifndef PH_MASK
#define PH_MASK 0xFFFFu
#endif
#define IN(k) (lo <= (k) && (k) < hi)
#define EN(j) ((PH_MASK >> (j)) & 1u)
#ifndef DUP_MASK
#define DUP_MASK 0x0u
#endif
#define DUP(j) ((int)((DUP_MASK >> (j)) & 1u))
#define BOTH(k) (IN(k) && IN((k) + 1))
    if (EN(10) && IN(0)) { for (int rep_ = 0; rep_ <= DUP(10); ++rep_) { LAUNDER(); p0_prologue(F); if (rep_ < DUP(10) || BOTH(0)) GRID_BAR(); } }
    for (int l = 0; l < DEPTH; ++l) {
        const int pb = 1 + NPH_LAYER * l;
        { int t_ = threadIdx.x; asm volatile("" : "+v"(t_)); F.tid = t_; F.lane = t_ & 63; F.wave = __builtin_amdgcn_readfirstlane(t_ >> 6); }
        { unsigned char* w_ = args.ws; float* o_ = args.out; asm volatile("" : "+s"(w_), "+s"(o_)); F.ws = w_; F.out = o_; }
        unsigned char* wl = F.ws + WS_W + (size_t)l * W_LAYER;
        const float* modl = (const float*)(F.ws + WS_MOD) + (size_t)l * 12 * MODW;
        if (EN(0) && IN(pb + 0)) { for (int rep_ = 0; rep_ <= DUP(0); ++rep_) { LAUNDER(); norm_phase(F, F.in[11] + (size_t)l * D, modl, 0, D, l == 0 ? F.in[0] : (const float*)(F.ws + WS_X)); if (rep_ < DUP(0) || BOTH(pb + 0)) GRID_BAR(); } }
        if (EN(1) && IN(pb + 1)) { for (int rep_ = 0; rep_ <= DUP(1); ++rep_) { LAUNDER();
            pg8::Gemm gm{(const pg8::bf16_t*)(F.ws + WS_H), (const pg8::bf16_t*)(wl + W_WIN), MP, NINP, D}; pg8::SplitOrder S; S.init(MPR, NINP, D, 1, F.G, F.bid);
            pg8::EpiZ E{(pg8::bf16_t*)(F.ws + WS_Z), (const float*)(F.ws + WS_BIN) + (size_t)l * NINP, (float*)(F.ws + WS_G)};
            pg8::gemm_phase<pg8::EpiZ, pg8::SplitOrder, true, true>(F.lds + RING_OFF, gm, S, E);
            if (rep_ < DUP(1) || BOTH(pb + 1)) GRID_BAR();
        } }
        if (EN(2) && IN(pb + 2)) { for (int rep_ = 0; rep_ <= DUP(2); ++rep_) { LAUNDER(); prep_phase(F, l); if (rep_ < DUP(2) || BOTH(pb + 2)) GRID_BAR(); } }
        if (EN(3) && IN(pb + 3)) { for (int rep_ = 0; rep_ <= DUP(3); ++rep_) { LAUNDER(); scan_phase(F, l); if (rep_ < DUP(3) || BOTH(pb + 3)) GRID_BAR(); } }
        if (EN(4) && IN(pb + 4)) { for (int rep_ = 0; rep_ <= DUP(4); ++rep_) { LAUNDER(); headnorm_phase(F, l); if (rep_ < DUP(4) || BOTH(pb + 4)) GRID_BAR(); } }
        if (EN(5) && IN(pb + 5)) { for (int rep_ = 0; rep_ <= DUP(5); ++rep_) { LAUNDER();
            { pg8::Gemm gm{(const pg8::bf16_t*)(F.ws + WS_KA), (const pg8::bf16_t*)(wl + W_WBB), MP, D, D}; pg8::SplitOrder S; S.init(MPR, D, D, 1, F.G, F.bid);
              pg8::EpiGateTmp E{(const pg8::bf16_t*)(F.ws + WS_Z) + ZGB, (float*)(F.ws + WS_HA)};
              pg8::gemm_phase<pg8::EpiGateTmp, pg8::SplitOrder, true, true>(F.lds + RING_OFF, gm, S, E); }
            VM_WAIT(); __syncthreads();
            { pg8::Gemm gm{(const pg8::bf16_t*)(F.ws + WS_QA), (const pg8::bf16_t*)(wl + W_WBA), MP, D, D}; pg8::SplitOrder S; S.init(MPR, D, D, 1, F.G, F.bid);
              pg8::EpiMerge E{(const pg8::bf16_t*)(F.ws + WS_Z) + ZGA, (const float*)(F.ws + WS_HA), (pg8::bf16_t*)(F.ws + WS_QB)};
              pg8::gemm_phase<pg8::EpiMerge, pg8::SplitOrder, true, true>(F.lds + RING_OFF, gm, S, E); }
            if (rep_ < DUP(5) || BOTH(pb + 5)) GRID_BAR();
        } }
        if (EN(6) && IN(pb + 6)) { for (int rep_ = 0; rep_ <= DUP(6); ++rep_) { LAUNDER();
            pg8::Gemm gm{(const pg8::bf16_t*)(F.ws + WS_QB), (const pg8::bf16_t*)(wl + W_WO), MP, D, D}; pg8::SplitOrder S; S.init(MPR, D, D, 4, F.G, F.bid);
            pg8::EpiResid E{(float*)(F.ws + (rep_ < DUP(6) ? WS_HB : WS_X)), modl + 2 * D, l == 0 ? F.in[0] : (const float*)(F.ws + WS_X)};
            pg8::gemm_phase<pg8::EpiResid, pg8::SplitOrder, true, true>(F.lds + RING_OFF, gm, S, E);
            if (rep_ < DUP(6) || BOTH(pb + 6)) GRID_BAR();
        } }
        if (EN(7) && IN(pb + 7)) { for (int rep_ = 0; rep_ <= DUP(7); ++rep_) { LAUNDER(); norm_phase(F, F.in[12] + (size_t)l * D, modl, 3 * D, 4 * D, (const float*)(F.ws + WS_X)); if (rep_ < DUP(7) || BOTH(pb + 7)) GRID_BAR(); } }
        if (EN(8) && IN(pb + 8)) { for (int rep_ = 0; rep_ <= DUP(8); ++rep_) { LAUNDER();
            pg8::Gemm gm{(const pg8::bf16_t*)(F.ws + WS_H), (const pg8::bf16_t*)(wl + W_WUP), MP, DFF, D}; pg8::SplitOrder S; S.init(MPR, DFF, D, 1, F.G, F.bid);
            pg8::EpiRelu2 E{(pg8::bf16_t*)(F.ws + WS_Z), DFF};
            pg8::gemm_phase<pg8::EpiRelu2, pg8::SplitOrder, true, true>(F.lds + RING_OFF, gm, S, E);
            if (rep_ < DUP(8) || BOTH(pb + 8)) GRID_BAR();
        } }
        if (EN(9) && IN(pb + 9)) { for (int rep_ = 0; rep_ <= DUP(9); ++rep_) { LAUNDER();
            pg8::Gemm gm{(const pg8::bf16_t*)(F.ws + WS_Z), (const pg8::bf16_t*)(wl + W_WDN), MP, D, DFF}; pg8::SplitOrder S; S.init(MPR, D, DFF, 16, F.G, F.bid, 4);
            pg8::EpiResid E{(float*)(F.ws + (rep_ < DUP(9) ? WS_HB : WS_X)), modl + 5 * D, (const float*)(F.ws + WS_X)};
            pg8::gemm_phase<pg8::EpiResid, pg8::SplitOrder, true, true>(F.lds + RING_OFF, gm, S, E);
            if (rep_ < DUP(9) || BOTH(pb + 9)) GRID_BAR();
        } }
    }
    if (EN(11) && IN(NPHASES - 1)) final_norm_phase(F);
#undef IN
#undef BOTH
}

extern "C" void kernel_launch(void* const* d_in, const int* in_sizes, int n_in, void* d_out, int out_size, void* d_ws, size_t ws_size, hipStream_t stream) {
    static int grid = 0;
    if (grid == 0) {
        if (n_in != 26 || (size_t)out_size != O_END || ws_size < WS_END) { fprintf(stderr, "kernel_launch: shape mismatch: n_in %d out %d (want %zu) ws %zu (want %zu)\n", n_in, out_size, (size_t)O_END, ws_size, (size_t)WS_END); grid = -1; return; }
        int dev = 0, cus = 0, per_cu = 0;
        if (hipGetDevice(&dev) != hipSuccess || hipDeviceGetAttribute(&cus, hipDeviceAttributeMultiprocessorCount, dev) != hipSuccess) { grid = -1; return; }
        if (hipFuncSetAttribute((const void*)trunk_fwd, hipFuncAttributeMaxDynamicSharedMemorySize, LDS_BYTES) != hipSuccess) { fprintf(stderr, "kernel_launch: hipFuncSetAttribute failed\n"); grid = -1; return; }
        if (hipOccupancyMaxActiveBlocksPerMultiprocessor(&per_cu, (const void*)trunk_fwd, 512, LDS_BYTES) != hipSuccess || per_cu < 1) fprintf(stderr, "kernel_launch: occupancy query says %d\n", per_cu);
        (void)hipGetLastError();
        grid = cus;
    }
    if (grid < 0) return;
    (void)in_sizes;
    if (hipMemsetAsync((char*)d_ws + WS_CTL, 0, CTL_ZERO_BYTES, stream) != hipSuccess) { fprintf(stderr, "kernel_launch: memset failed\n"); return; }
    Args a{};
    for (int i = 0; i < 26; ++i) a.in[i] = (const float*)d_in[i];
    a.out = (float*)d_out; a.ws = (unsigned char*)d_ws;
#if MK_PER_PHASE
    for (int p = 0; p < NPHASES; ++p) { a.ph_lo = p; a.ph_hi = p + 1; hipLaunchKernelGGL(trunk_fwd, dim3(grid), dim3(512), LDS_BYTES, stream, a); }
#else
    a.ph_lo = 0; a.ph_hi = NPHASES;
    hipLaunchKernelGGL(trunk_fwd, dim3(grid), dim3(512), LDS_BYTES, stream, a);
#endif
    const hipError_t le = hipPeekAtLastError();
    if (le != hipSuccess) fprintf(stderr, "kernel_launch: launch failed: %s\n", hipGetErrorName(le));
}
```

```cpp
#include <hip/hip_runtime.h>
#include <cstdio>
#include <cstdint>
#ifndef MK_PER_PHASE
#define MK_PER_PHASE 0
#endif
namespace pg8 {
#define PG8_LAS __attribute__((address_space(3)))
typedef unsigned short bf16_t;
typedef short bf16x8 __attribute__((ext_vector_type(8)));
typedef float f32x4 __attribute__((ext_vector_type(4)));
typedef unsigned u32x4 __attribute__((ext_vector_type(4)));
constexpr int BM = 256, BK = 64, HALF = 128, HTB = HALF * BK * 2  , STAGE_BYTES = 8 * HTB, NXCD = 8, WGM = 8;

__host__ __device__ __forceinline__ int lds_byte(int r, int c) { const int st = (r >> 4) * 2 + (c >> 5), rr = r & 15, cc = c & 31, ob = rr * 64 + cc * 2; return st * 1024 + (ob ^ (((ob >> 9) & 1) << 5)); }
__host__ __device__ __forceinline__ void stage_rc(int b, int& R, int& C) { const int st = b / 1024, sb = b % 1024, swz = sb ^ (((sb >> 9) & 1) << 5); R = (st >> 1) * 16 + swz / 64; C = (st & 1) * 32 + (swz % 64) / 2; }
__host__ __device__ __forceinline__ int perm32(int rho) { const int n = rho >> 4, i = rho & 15; return 8 * (i >> 2) + 4 * n + (i & 3); }

struct Unit { int pm, pn, k0, nt, half; };
struct Gemm { const bf16_t* A; const bf16_t* Bt; int M, N, K; };

struct StaticOrder {
    int nM, nN, nwg, G, c;
    __host__ __device__ void init(int M, int N, int G_, int c_) { nM = M / BM; nN = N / BM; nwg = nM * nN; G = G_; c = c_; }
    __host__ __device__ __forceinline__ bool next(int i, Unit& u) const {
        const long L = (long)i * G + c; if (L >= nwg) return false;
        int wgid = (int)L; { const int q = nwg / NXCD, r = nwg % NXCD, xcd = wgid % NXCD, off = wgid / NXCD; wgid = (xcd < r ? xcd * (q + 1) : r * (q + 1) + (xcd - r) * q) + off; }
        const int nig = WGM * nN, gid = wgid / nig, fm = gid * WGM, gsz = (nM - fm) < WGM ? (nM - fm) : WGM;
        u.pm = fm + ((wgid % nig) % gsz); u.pn = (wgid % nig) / gsz; return true;
    }
    __device__ __forceinline__ void a_ready(const Unit&) const {}
    __device__ __forceinline__ void done(const Unit&) const {}
};

struct SplitOrder {
    int nM, nN, nwg, G, c, S, ntK, wgm;
    __device__ __forceinline__ void init(int Mfull, int N, int K, int S_, int G_, int c_, int wgm_ = 4) { nM = Mfull / BM; nN = N / BM; nwg = nM * nN; G = G_; c = c_; S = S_; ntK = K / BK; wgm = wgm_; }
    __device__ __forceinline__ bool next(int i, Unit& u) const {
        const long L = (long)i * G + c; const bool full = L < nwg; const int j = full ? 0 : (int)(L - nwg);
        if (!full && j >= nN * S) return false;
        int wgid = full ? (int)L : 0; { const int q = nwg / NXCD, r = nwg % NXCD, xcd = wgid % NXCD, off = wgid / NXCD; wgid = (xcd < r ? xcd * (q + 1) : r * (q + 1) + (xcd - r) * q) + off; }
        const int nig = wgm * nN, gid = wgid / nig, fm = gid * wgm, gsz = (nM - fm) < wgm ? (nM - fm) : wgm;
        const int pm_f = fm + ((wgid % nig) % gsz), pn_f = (wgid % nig) / gsz;
        const int nts = ntK / S;
        const int pm = full ? pm_f : nM, pn = full ? pn_f : (j % nN), k0 = full ? 0 : (j / nN) * nts, nt = full ? ntK : nts, half = full ? 0 : 1;
        u = Unit{pm, pn, k0, nt, half}; return true;
    }
    __device__ __forceinline__ void a_ready(const Unit&) const {}
    __device__ __forceinline__ void done(const Unit&) const {}
};

__device__ __forceinline__ unsigned cvt_pk_bf16(float lo, float hi) { unsigned r; asm volatile("v_cvt_pk_bf16_f32 %0, %1, %2" : "=v"(r) : "v"(lo), "v"(hi)); return r; }
typedef float f32x2 __attribute__((ext_vector_type(2)));
template <class Epi, class Sched, bool ALIGN_EPI = false, bool SP2 = false>
__device__ __forceinline__ void gemm_phase(PG8_LAS unsigned char* lds, const Gemm g, const Sched& S, const Epi& E) {
    int tid_ = threadIdx.x; asm volatile("" : "+v"(tid_));
    const int tid = tid_, wid = __builtin_amdgcn_readfirstlane(tid >> 6), lane = tid & 63, wr = wid >> 2, wc = wid & 3, fr = lane & 15, fq = lane >> 4;
    const int K = g.K;
    unsigned voffA[2], voffB[2];
#pragma unroll
    for (int i = 0; i < 2; ++i) { int R, C; stage_rc(tid * 16 + i * 8192, R, C); const int Rb = Epi::PERM ? ((R & ~31) + perm32(R & 31)) : R;
        voffA[i] = (unsigned)(R * K + C) * 2u; voffB[i] = (unsigned)(Rb * K + C) * 2u; }
    const size_t kstep = (size_t)(BK * 2);
    const size_t hstep = (size_t)HALF * K * 2;
    const size_t tstep = 2 * hstep;
    const unsigned ldsw = (unsigned)wid * 1024u;
    const int aoff = lds_byte(wr * 64 + fr, fq * 8), boff = lds_byte(wc * 32 + fr, fq * 8);
#define PG8_SA(b, h) (((b) * 2 + (h)) * HTB)
#define PG8_SB(b, h) ((4 + (b) * 2 + (h)) * HTB)
#define PG8_STAGE(bufoff, gbase, voff) do { _Pragma("unroll") for (int _i = 0; _i < 2; ++_i) \
        __builtin_amdgcn_global_load_lds((const unsigned*)((const char*)(gbase) + (voff)[_i]), (PG8_LAS unsigned*)(lds + (bufoff) + ldsw + _i * 8192), 16, 0, 0); } while (0)
#define PG8_LDA(dst, b, h) do { _Pragma("unroll") for (int m = 0; m < 4; ++m) _Pragma("unroll") for (int k = 0; k < 2; ++k) dst[m][k] = *(const PG8_LAS bf16x8*)(lds + PG8_SA(b, h) + aoff + m * 2048 + k * 1024); } while (0)
#define PG8_LDB(dst, b, h) do { _Pragma("unroll") for (int n = 0; n < 2; ++n) _Pragma("unroll") for (int k = 0; k < 2; ++k) dst[n][k] = *(const PG8_LAS bf16x8*)(lds + PG8_SB(b, h) + boff + n * 2048 + k * 1024); } while (0)
#define PG8_MMA(ai, bj, At, Bt) do { __builtin_amdgcn_s_setprio(1); _Pragma("unroll") for (int m = 0; m < 4; ++m) _Pragma("unroll") for (int n = 0; n < 2; ++n) _Pragma("unroll") for (int k = 0; k < 2; ++k) \
        acc[ai][bj][m][n] = __builtin_amdgcn_mfma_f32_16x16x32_bf16(Bt[n][k], At[m][k], acc[ai][bj][m][n], 0, 0, 0); __builtin_amdgcn_s_setprio(0); } while (0)
#define PG8_WAIT_V(n) asm volatile("s_waitcnt vmcnt(" #n ")" ::: "memory")
#define PG8_WAIT_L(n) asm volatile("s_waitcnt lgkmcnt(" #n ")" ::: "memory")
#define PG8_BAR __builtin_amdgcn_s_barrier()
#define PG8_SCHED __builtin_amdgcn_sched_barrier(0)
    Unit cur, nxt; int ui = 0;
    if (!S.next(0, cur)) return;
    f32x4 acc[2][2][4][2];
#pragma unroll
    for (int a = 0; a < 2; ++a)
#pragma unroll
        for (int b = 0; b < 2; ++b)
#pragma unroll
            for (int m = 0; m < 4; ++m)
#pragma unroll
                for (int n = 0; n < 2; ++n) acc[a][b][m][n] = (f32x4){0.f, 0.f, 0.f, 0.f};
    bf16x8 At[4][2], B0[2][2], B1[2][2];
    const char* cA = (const char*)g.A + (size_t)cur.pm * tstep + (size_t)cur.k0 * kstep; const char* cB = (const char*)g.Bt + (size_t)cur.pn * tstep + (size_t)cur.k0 * kstep;
    S.a_ready(cur);
    if constexpr (SP2) {
        PG8_STAGE(PG8_SB(0, 0), cB, voffB); PG8_STAGE(PG8_SB(0, 1), cB + hstep, voffB); PG8_STAGE(PG8_SA(0, 0), cA, voffA); PG8_STAGE(PG8_SA(0, 1), cA + hstep, voffA);
        if (wr == 1) PG8_BAR;
        PG8_WAIT_V(2); PG8_BAR;
        PG8_STAGE(PG8_SB(1, 0), cB + kstep, voffB); PG8_STAGE(PG8_SA(1, 0), cA + kstep, voffA); PG8_STAGE(PG8_SB(1, 1), cB + hstep + kstep, voffB);
        PG8_WAIT_V(6); PG8_BAR;
    } else {
        PG8_STAGE(PG8_SB(0, 0), cB, voffB); PG8_STAGE(PG8_SA(0, 0), cA, voffA); PG8_STAGE(PG8_SB(0, 1), cB + hstep, voffB); PG8_STAGE(PG8_SA(0, 1), cA + hstep, voffA);
        if (wr == 1) PG8_BAR;
        PG8_WAIT_V(4); PG8_BAR;
        PG8_STAGE(PG8_SB(1, 0), cB + kstep, voffB); PG8_STAGE(PG8_SA(1, 0), cA + kstep, voffA); PG8_STAGE(PG8_SB(1, 1), cB + hstep + kstep, voffB);
        PG8_WAIT_V(6); PG8_BAR;
    }
    for (;;) {
        const bool has_next = S.next(ui + 1, nxt);
        const char* nA = has_next ? (const char*)g.A + (size_t)nxt.pm * tstep + (size_t)nxt.k0 * kstep : cA; const char* nB = has_next ? (const char*)g.Bt + (size_t)nxt.pn * tstep + (size_t)nxt.k0 * kstep : cB;
        const int nt = cur.nt; const bool fullrows = (cur.half == 0);
#ifdef PROBE_KTWICE
        _Pragma("nounroll") for (int pass_ = 0; pass_ < 2; ++pass_) { const char* nA_ = pass_ == 0 ? cA : nA; const char* nB_ = pass_ == 0 ? cB : nB;
#else
        { const char* nA_ = nA; const char* nB_ = nB;
#endif
        for (int t = 0; t < nt; t += 2) {
            const bool last = (t == nt - 2);
            const char* a1 = cA + (size_t)(t + 1) * kstep;
            const char* a2 = last ? nA_ : cA + (size_t)(t + 2) * kstep; const char* b2 = last ? nB_ : cB + (size_t)(t + 2) * kstep;
            const char* a3 = a2 + kstep; const char* b3 = b2 + kstep;
            if (last && has_next) S.a_ready(nxt);
            if constexpr (SP2) {
            PG8_LDB(B0, 0, 0); PG8_LDB(B1, 0, 1); PG8_SCHED; PG8_LDA(At, 0, 0); PG8_STAGE(PG8_SA(1, 1), a1 + hstep, voffA);
            PG8_WAIT_V(8); PG8_WAIT_L(0); PG8_BAR; PG8_MMA(0, 0, At, B0); PG8_MMA(0, 1, At, B1); PG8_BAR; PG8_SCHED;
            PG8_LDA(At, 0, 1); PG8_STAGE(PG8_SB(0, 0), b2, voffB); PG8_STAGE(PG8_SB(0, 1), b2 + hstep, voffB); PG8_STAGE(PG8_SA(0, 0), a2, voffA);
            PG8_WAIT_V(8); PG8_WAIT_L(0); PG8_BAR; if (fullrows) { PG8_MMA(1, 0, At, B0); PG8_MMA(1, 1, At, B1); } PG8_BAR; PG8_SCHED;
            PG8_LDB(B0, 1, 0); PG8_LDB(B1, 1, 1); PG8_SCHED; PG8_LDA(At, 1, 0); PG8_STAGE(PG8_SA(0, 1), a2 + hstep, voffA);
            PG8_WAIT_V(8); PG8_WAIT_L(0); PG8_BAR; PG8_MMA(0, 0, At, B0); PG8_MMA(0, 1, At, B1); PG8_BAR; PG8_SCHED;
            PG8_LDA(At, 1, 1); PG8_STAGE(PG8_SB(1, 0), b3, voffB); PG8_STAGE(PG8_SB(1, 1), b3 + hstep, voffB); PG8_STAGE(PG8_SA(1, 0), a3, voffA);
            PG8_WAIT_V(8); PG8_WAIT_L(0); PG8_BAR; if (fullrows) { PG8_MMA(1, 0, At, B0); PG8_MMA(1, 1, At, B1); } PG8_BAR; PG8_SCHED;
            } else {
            PG8_LDB(B0, 0, 0); PG8_SCHED; PG8_LDA(At, 0, 0); PG8_STAGE(PG8_SA(1, 1), a1 + hstep, voffA);
            PG8_WAIT_L(8); PG8_BAR; PG8_WAIT_L(0); PG8_MMA(0, 0, At, B0); PG8_BAR; PG8_SCHED;
            PG8_LDB(B1, 0, 1); PG8_STAGE(PG8_SB(0, 0), b2, voffB);
            PG8_BAR; PG8_WAIT_L(0); PG8_MMA(0, 1, At, B1); PG8_BAR;
            PG8_LDA(At, 0, 1); PG8_STAGE(PG8_SA(0, 0), a2, voffA);
            PG8_BAR; PG8_WAIT_L(0); if (fullrows) PG8_MMA(1, 0, At, B0); PG8_BAR; PG8_SCHED;
            PG8_STAGE(PG8_SB(0, 1), b2 + hstep, voffB);
            PG8_WAIT_V(6); PG8_BAR; if (fullrows) PG8_MMA(1, 1, At, B1); PG8_BAR;
            PG8_LDB(B0, 1, 0); PG8_SCHED; PG8_LDA(At, 1, 0); PG8_STAGE(PG8_SA(0, 1), a2 + hstep, voffA);
            PG8_WAIT_L(8); PG8_BAR; PG8_WAIT_L(0); PG8_MMA(0, 0, At, B0); PG8_BAR; PG8_SCHED;
            PG8_LDB(B1, 1, 1); PG8_STAGE(PG8_SB(1, 0), b3, voffB);
            PG8_BAR; PG8_WAIT_L(0); PG8_MMA(0, 1, At, B1); PG8_BAR;
            PG8_LDA(At, 1, 1); PG8_STAGE(PG8_SA(1, 0), a3, voffA);
            PG8_BAR; PG8_WAIT_L(0); if (fullrows) PG8_MMA(1, 0, At, B0); PG8_BAR; PG8_SCHED;
            PG8_STAGE(PG8_SB(1, 1), b3 + hstep, voffB);
            PG8_WAIT_V(6); PG8_BAR; if (fullrows) PG8_MMA(1, 1, At, B1); PG8_BAR;
            }
        }
        }
#ifdef PROBE_KTWICE
        _Pragma("unroll") for (int a_ = 0; a_ < 2; ++a_) _Pragma("unroll") for (int b_ = 0; b_ < 2; ++b_) _Pragma("unroll") for (int m_ = 0; m_ < 4; ++m_) _Pragma("unroll") for (int n_ = 0; n_ < 2; ++n_) acc[a_][b_][m_][n_] = acc[a_][b_][m_][n_] * 0.5f;
#endif
        if constexpr (ALIGN_EPI) { if (wr == 0) PG8_BAR; }
        if constexpr (!Epi::AFTER_DRAIN) { E(acc, cur, wr, wc, fr, fq);
#ifdef PROBE_EPI_TWICE
            if constexpr (Epi::IDEMPOTENT) { asm volatile("" ::: "memory"); E(acc, cur, wr, wc, fr, fq); }
#endif
            S.done(cur); }
        if (!has_next) break;
#pragma unroll
        for (int a = 0; a < 2; ++a)
#pragma unroll
            for (int b = 0; b < 2; ++b)
#pragma unroll
                for (int m = 0; m < 4; ++m)
#pragma unroll
                    for (int n = 0; n < 2; ++n) acc[a][b][m][n] = (f32x4){0.f, 0.f, 0.f, 0.f};
        cur = nxt; cA = nA; cB = nB; ++ui;
        if constexpr (ALIGN_EPI) { if (wr == 1) PG8_BAR; }
    }
    PG8_WAIT_V(0);
    if constexpr (!ALIGN_EPI) { if (wr == 0) PG8_BAR; }
    PG8_BAR;
    if constexpr (Epi::AFTER_DRAIN) { E.fused(acc, cur, wr, wc, fr, fq, lds, wid, lane); S.done(cur); }
#undef PG8_SA
#undef PG8_SB
#undef PG8_STAGE
#undef PG8_LDA
#undef PG8_LDB
#undef PG8_MMA
#undef PG8_WAIT_V
#undef PG8_WAIT_L
#undef PG8_BAR
#undef PG8_SCHED
}
}

constexpr int D = 2048, NB = 4, SEQ = 4096, DEPTH = 4, NSB = 8, SSEQ = 16;
constexpr int MPR = NB * SEQ;
constexpr int MS = NSB * SSEQ;
constexpr int M = MPR + MS;
constexpr int MP = 16640;
constexpr int NIN = 20496, NINP = 20736;
constexpr int DFF = 8192;
constexpr int ZQK = 0, ZVA = 4096, ZOA = 6144, ZQB = 8192, ZFB = 10240, ZIB = 12288, ZOGB = 14336, ZGA = 16384, ZGB = 18432, ZGT = 20480;
constexpr int MODW = 6 * D;
constexpr float EPS = 1e-6f;
constexpr int NCHUNKS = NB * (SEQ / 64) + NSB;

__device__ __forceinline__ int row_batch(int r) { int b = r < MPR ? (r >> 12) : 4 + ((r - MPR) >> 4); return b > 11 ? 11 : b; }
__device__ __forceinline__ float bf2f(unsigned short b) { return __uint_as_float(((unsigned)b) << 16); }
__device__ __forceinline__ float sigm(float x) { return __builtin_amdgcn_rcpf(1.0f + __expf(-x)); }

namespace pg8 {
__device__ __forceinline__ void unpack8(const u32x4 w, float (&f)[8]) {
    f[0] = __uint_as_float(w.x << 16); f[1] = __uint_as_float(w.x & 0xffff0000u); f[2] = __uint_as_float(w.y << 16); f[3] = __uint_as_float(w.y & 0xffff0000u);
    f[4] = __uint_as_float(w.z << 16); f[5] = __uint_as_float(w.z & 0xffff0000u); f[6] = __uint_as_float(w.w << 16); f[7] = __uint_as_float(w.w & 0xffff0000u);
}
struct EpiZ {
    static constexpr bool PERM = true, AFTER_DRAIN = false, IDEMPOTENT = true;
    bf16_t* Z; const float* bias; float* G;
    __device__ __forceinline__ void operator()(const f32x4 (&acc)[2][2][4][2], const Unit& u, int wr, int wc, int fr, int fq) const {
        const int row0 = u.pm * BM + wr * 64 + fr, col0 = u.pn * BM + wc * 32 + 8 * fq;
        const bool gates = (u.pn == 80) && (wc == 0) && (fq < 2);
        const f32x4 bb[2][2] = {{*(const f32x4*)(bias + col0), *(const f32x4*)(bias + col0 + 4)}, {*(const f32x4*)(bias + col0 + HALF), *(const f32x4*)(bias + col0 + HALF + 4)}};
#pragma unroll
        for (int bj = 0; bj < 2; ++bj) {
            const f32x4 b0 = bb[bj][0], b1 = bb[bj][1];
#pragma unroll
            for (int ai = 0; ai < 2; ++ai)
#pragma unroll
                for (int m = 0; m < 4; ++m) { const int row = row0 + ai * HALF + m * 16; bf16_t* rowp = Z + (size_t)row * NINP + col0;
                    const f32x4 v0 = acc[ai][bj][m][0] + b0, v1 = acc[ai][bj][m][1] + b1;
                    u32x4 w; w.x = cvt_pk_bf16(v0[0], v0[1]); w.y = cvt_pk_bf16(v0[2], v0[3]); w.z = cvt_pk_bf16(v1[0], v1[1]); w.w = cvt_pk_bf16(v1[2], v1[3]);
                    *(u32x4*)(rowp + bj * HALF) = w;
                    if (bj == 0 && gates) { float* gp = G + (size_t)row * 16 + 8 * fq; *(f32x4*)gp = v0; *(f32x4*)(gp + 4) = v1; } }
        }
    }
};
struct EpiGateTmp {
    static constexpr bool PERM = true, AFTER_DRAIN = false, IDEMPOTENT = false;
    const bf16_t* Zg; float* T;
    __device__ __forceinline__ void operator()(const f32x4 (&acc)[2][2][4][2], const Unit& u, int wr, int wc, int fr, int fq) const {
        const int row0 = u.pm * BM + wr * 64 + fr, col0 = u.pn * BM + wc * 32 + 8 * fq;
#pragma unroll
        for (int ai = 0; ai < 2; ++ai) {
            u32x4 gz[4][2];
#pragma unroll
            for (int m = 0; m < 4; ++m)
#pragma unroll
                for (int bj = 0; bj < 2; ++bj) gz[m][bj] = *(const u32x4*)(Zg + (size_t)(row0 + ai * HALF + m * 16) * NINP + col0 + bj * HALF);
#pragma unroll
            for (int m = 0; m < 4; ++m) { const int row = row0 + ai * HALF + m * 16;
#pragma unroll
                for (int bj = 0; bj < 2; ++bj) { const int c = col0 + bj * HALF; float gf[8]; unpack8(gz[m][bj], gf);
                    f32x4 v0 = acc[ai][bj][m][0], v1 = acc[ai][bj][m][1];
#pragma unroll
                    for (int j = 0; j < 4; ++j) { v0[j] *= sigm(gf[j]); v1[j] *= sigm(gf[4 + j]); }
                    float* tp = T + (size_t)row * D + c; *(f32x4*)tp = v0; *(f32x4*)(tp + 4) = v1; } }
            asm volatile("" ::: "memory");
        }
    }
};
struct EpiMerge {
    static constexpr bool PERM = true, AFTER_DRAIN = false, IDEMPOTENT = false;
    const bf16_t* Zg; const float* T; bf16_t* O;
    __device__ __forceinline__ void operator()(const f32x4 (&acc)[2][2][4][2], const Unit& u, int wr, int wc, int fr, int fq) const {
        const int row0 = u.pm * BM + wr * 64 + fr, col0 = u.pn * BM + wc * 32 + 8 * fq;
#pragma unroll
        for (int ai = 0; ai < 2; ++ai)
#pragma unroll
            for (int mp = 0; mp < 2; ++mp) {
                u32x4 gz[2][2]; f32x4 t0[2][2], t1[2][2];
#pragma unroll
                for (int mm = 0; mm < 2; ++mm)
#pragma unroll
                    for (int bj = 0; bj < 2; ++bj) { const int row = row0 + ai * HALF + (2 * mp + mm) * 16, c = col0 + bj * HALF; gz[mm][bj] = *(const u32x4*)(Zg + (size_t)row * NINP + c);
                        const float* tp = T + (size_t)row * D + c; t0[mm][bj] = *(const f32x4*)tp; t1[mm][bj] = *(const f32x4*)(tp + 4); }
#pragma unroll
                for (int mm = 0; mm < 2; ++mm)
#pragma unroll
                    for (int bj = 0; bj < 2; ++bj) { const int m = 2 * mp + mm, row = row0 + ai * HALF + m * 16, c = col0 + bj * HALF; float gf[8]; unpack8(gz[mm][bj], gf);
                        f32x4 v0 = t0[mm][bj], v1 = t1[mm][bj];
#pragma unroll
                        for (int j = 0; j < 4; ++j) { v0[j] += acc[ai][bj][m][0][j] * sigm(gf[j]); v1[j] += acc[ai][bj][m][1][j] * sigm(gf[4 + j]); }
                        u32x4 w; w.x = cvt_pk_bf16(v0[0], v0[1]); w.y = cvt_pk_bf16(v0[2], v0[3]); w.z = cvt_pk_bf16(v1[0], v1[1]); w.w = cvt_pk_bf16(v1[2], v1[3]);
                        *(u32x4*)(O + (size_t)row * D + c) = w; }
                asm volatile("" ::: "memory");
            }
    }
};
struct EpiResid {
    static constexpr bool PERM = false, AFTER_DRAIN = false, IDEMPOTENT = false;
    float* X; const float* gate; const float* Xsrc;
    __device__ __forceinline__ void operator()(const f32x4 (&acc)[2][2][4][2], const Unit& u, int wr, int wc, int fr, int fq) const {
        const int row0 = u.pm * BM + wr * 64 + fr, col0 = u.pn * BM + wc * 32 + 4 * fq;
        if (!u.half) {
            const float* gp = gate + (size_t)row_batch(u.pm * BM) * MODW + col0;
            const f32x4 gv[2][2] = {{*(const f32x4*)gp, *(const f32x4*)(gp + 16)}, {*(const f32x4*)(gp + HALF), *(const f32x4*)(gp + HALF + 16)}};
#pragma unroll
            for (int ai = 0; ai < 2; ++ai) {
                f32x4 xv[4][2][2];
#pragma unroll
                for (int m = 0; m < 4; ++m)
#pragma unroll
                    for (int bj = 0; bj < 2; ++bj)
#pragma unroll
                        for (int n = 0; n < 2; ++n) xv[m][bj][n] = *(const f32x4*)(Xsrc + (size_t)(row0 + ai * HALF + m * 16) * D + col0 + bj * HALF + n * 16);
#pragma unroll
                for (int m = 0; m < 4; ++m)
#pragma unroll
                    for (int bj = 0; bj < 2; ++bj)
#pragma unroll
                        for (int n = 0; n < 2; ++n) *(f32x4*)(X + (size_t)(row0 + ai * HALF + m * 16) * D + col0 + bj * HALF + n * 16) = xv[m][bj][n] + gv[bj][n] * acc[ai][bj][m][n];
                asm volatile("" ::: "memory");
            }
        } else {
#pragma unroll
            for (int m = 0; m < 4; ++m) { const int row = row0 + m * 16; const float* gp = gate + (size_t)row_batch(row) * MODW + col0; float* xp = X + (size_t)row * D + col0;
#pragma unroll
                for (int bj = 0; bj < 2; ++bj)
#pragma unroll
                    for (int n = 0; n < 2; ++n) { const int o = bj * HALF + n * 16; const f32x4 d = *(const f32x4*)(gp + o) * acc[0][bj][m][n];
#pragma unroll
                        for (int e = 0; e < 4; ++e) __hip_atomic_fetch_add(xp + o + e, d[e], __ATOMIC_RELAXED, __HIP_MEMORY_SCOPE_AGENT); } }
        }
    }
};
struct EpiRelu2 {
    static constexpr bool PERM = true, AFTER_DRAIN = false, IDEMPOTENT = true;
    bf16_t* O; int ldc;
    __device__ __forceinline__ void operator()(const f32x4 (&acc)[2][2][4][2], const Unit& u, int wr, int wc, int fr, int fq) const {
        const int row0 = u.pm * BM + wr * 64 + fr, col0 = u.pn * BM + wc * 32 + 8 * fq;
#pragma unroll
        for (int ai = 0; ai < 2; ++ai)
#pragma unroll
            for (int m = 0; m < 4; ++m) { bf16_t* rowp = O + (size_t)(row0 + ai * HALF + m * 16) * ldc + col0;
#pragma unroll
                for (int bj = 0; bj < 2; ++bj) { f32x4 v0 = acc[ai][bj][m][0], v1 = acc[ai][bj][m][1];
#pragma unroll
                    for (int j = 0; j < 4; ++j) { const float a = fmaxf(v0[j], 0.f), b = fmaxf(v1[j], 0.f); v0[j] = a * a; v1[j] = b * b; }
                    u32x4 w; w.x = cvt_pk_bf16(v0[0], v0[1]); w.y = cvt_pk_bf16(v0[2], v0[3]); w.z = cvt_pk_bf16(v1[0], v1[1]); w.w = cvt_pk_bf16(v1[2], v1[3]);
                    *(u32x4*)(rowp + bj * HALF) = w; } }
    }
};
}

constexpr size_t MiB = 1u << 20;
constexpr size_t WS_CTL = 0, CTL_ZERO_BYTES = 1 * MiB;
constexpr size_t WS_MOD = 1 * MiB;
constexpr size_t WS_LB = 4 * MiB;
constexpr size_t WS_BIN = 4 * MiB + 65536;
constexpr size_t WS_E1 = 5 * MiB, WS_E2 = 8 * MiB;
constexpr size_t WS_G = 11 * MiB;
constexpr size_t WS_W = 16 * MiB;
constexpr size_t W_WIN = 0, W_WBA = 81 * MiB, W_WBB = 89 * MiB, W_WO = 97 * MiB, W_WUP = 105 * MiB, W_WDN = 137 * MiB, W_LAYER = 169 * MiB;
constexpr size_t WS_X = 692 * MiB;
constexpr size_t WS_H = 822 * MiB;
constexpr size_t WS_Z = 887 * MiB;
constexpr size_t WS_QA = 1546 * MiB;
constexpr size_t WS_KA = 1611 * MiB;
constexpr size_t WS_QB = 1676 * MiB;
constexpr size_t WS_KB = 1741 * MiB;
constexpr size_t WS_HA = 1806 * MiB;
constexpr size_t WS_HB = 1936 * MiB;
constexpr size_t WS_GP = 2066 * MiB;
constexpr size_t WS_END = 2072 * MiB;
static_assert((size_t)NINP * D * 2 <= 81 * MiB && (size_t)MP * NINP * 2 <= (WS_QA - WS_Z) && (size_t)MP * D * 2 == 65 * MiB && WS_W + 4 * W_LAYER <= WS_X, "ws map");
constexpr int CW_BAR = 4096;

constexpr size_t O_YP = 0, O_YS = O_YP + (size_t)MPR * D, O_CONVP = O_YS + (size_t)MS * D, O_CP = O_CONVP + (size_t)DEPTH * NB * 3 * 4096,
    O_NP = O_CP + (size_t)DEPTH * NB * 8 * 65536, O_MP = O_NP + (size_t)DEPTH * NB * 8 * 256, O_SP = O_MP + (size_t)DEPTH * NB * 8,
    O_CONVS = O_SP + (size_t)DEPTH * NB * 16 * 16384, O_CS = O_CONVS + (size_t)DEPTH * NSB * 3 * 4096, O_NS = O_CS + (size_t)DEPTH * NSB * 8 * 65536,
    O_MS = O_NS + (size_t)DEPTH * NSB * 8 * 256, O_SS = O_MS + (size_t)DEPTH * NSB * 8, O_END = O_SS + (size_t)DEPTH * NSB * 16 * 16384;

constexpr int RING_OFF = 0, RING_BYTES = 131072;
constexpr int LDS_BYTES = 155648;
constexpr int MISC_OFF = LDS_BYTES - 256;
constexpr int SC_Q = 0, SC_K = 33792, SC_VT = 67584, SC_VW = 79104, SC_CT = 90624, SC_P = 132864, SC_H = 142080, SC_END = 151296;
constexpr int LQB = 528;
constexpr int LVB = 144;
constexpr int HS_Q = 0, HS_K = 17408, HS_VT = 34816, HS_ST = 44032, HS_P = 61440, HS_H = 70656;
constexpr int LHB = 272;
static_assert(SC_END <= MISC_OFF, "LDS map");

#define GAS __attribute__((address_space(1)))
#define LAS __attribute__((address_space(3)))
#define DI __device__ __forceinline__
typedef unsigned short bf16;
typedef float f32x4 __attribute__((ext_vector_type(4)));
typedef unsigned u32x2 __attribute__((ext_vector_type(2)));
typedef unsigned u32x4 __attribute__((ext_vector_type(4)));
typedef short bf16x8 __attribute__((ext_vector_type(8)));
typedef GAS unsigned gu32;
#define RLX_AGENT __ATOMIC_RELAXED, __HIP_MEMORY_SCOPE_AGENT
#define LDS_WAIT() asm volatile("s_waitcnt lgkmcnt(0)" ::: "memory")
#define VM_WAIT() asm volatile("s_waitcnt vmcnt(0)" ::: "memory")
DI unsigned f2bf(float f) { unsigned u = __float_as_uint(f); return (u + 0x7fffu + ((u >> 16) & 1u)) >> 16; }
DI unsigned pk2(float lo, float hi) { return f2bf(lo) | (f2bf(hi) << 16); }
DI float wave_sum(float v) {
#pragma unroll
    for (int o = 1; o < 64; o <<= 1) v += __shfl_xor(v, o);
    return v;
}
#define LBAR() do { asm volatile("s_waitcnt lgkmcnt(0)" ::: "memory"); __builtin_amdgcn_s_barrier(); asm volatile("" ::: "memory"); } while (0)
DI unsigned cvtpk(float lo, float hi) { unsigned r; asm volatile("v_cvt_pk_bf16_f32 %0, %1, %2" : "=v"(r) : "v"(lo), "v"(hi)); return r; }
DI float logsig(float x) { return fminf(x, 0.f) - __logf(1.0f + __expf(-fabsf(x))); }
#define XB_TMO      128
#define XB_XCNT(j)  (256  + 64 * (j))
#define XB_XSUB(j)  (1280 + 64 * (j))
#define XB_XGEN(j)  (2304 + 64 * (j))
#define XB_TOP      3328
#define XB_TOPGEN   3392
#define XCD_BAR_WORDS 3456
#define XB_SPIN_CAP (1u << 18)

__device__ __forceinline__ unsigned xb_ld(unsigned* p)              { return __hip_atomic_load(p, __ATOMIC_RELAXED, __HIP_MEMORY_SCOPE_AGENT); }
__device__ __forceinline__ unsigned xb_add(unsigned* p, unsigned v) { return __hip_atomic_fetch_add(p, v, __ATOMIC_RELAXED, __HIP_MEMORY_SCOPE_AGENT); }
__device__ __forceinline__ unsigned xb_xcc_id() { return (unsigned)__builtin_amdgcn_s_getreg((3 << 11) | 20) & 0xFu; }
#define XB_SPIN(cond, bar) do { unsigned _sp = 0; while (cond) { __builtin_amdgcn_s_sleep(1); \
    if ((++_sp & 255u) == 0u) { if (xb_ld(&(bar)[XB_TMO])) break; if (_sp > XB_SPIN_CAP) { atomicAdd(&(bar)[XB_TMO], 1u); break; } } } } while (0)

__device__ __forceinline__ bool xb_tid0() { int t = threadIdx.x; asm volatile("" : "+v"(t)); return t == 0; }
struct XcdBarrier {
    unsigned* bar; unsigned x;
    volatile LAS unsigned* st;
};

__device__ __forceinline__ XcdBarrier xcd_barrier_post(unsigned* bar, volatile LAS unsigned* st) {
    XcdBarrier b; b.bar = bar; b.x = xb_xcc_id(); b.st = st;
    if (xb_tid0()) (void)xb_add(&bar[XB_XCNT(b.x)], 1u);
    return b;
}
__device__ __forceinline__ void xcd_barrier_complete(unsigned* bar, unsigned x, unsigned& nloc, unsigned& nx) {
    const unsigned G = gridDim.x * gridDim.y * gridDim.z;
    unsigned sum, cnt, mine, sp = 0u;
    for (;;) {
        sum = 0u; cnt = 0u; mine = 0u;
#pragma unroll
        for (unsigned j = 0; j < 16; ++j) { const unsigned c = xb_ld(&bar[XB_XCNT(j)]); sum += c; cnt += (c > 0u) ? 1u : 0u; mine = (j == x) ? c : mine; }
        if (sum == G) break;
        __builtin_amdgcn_s_sleep(1);
        if ((++sp & 255u) == 0u) { if (xb_ld(&bar[XB_TMO])) break; if (sp > XB_SPIN_CAP) { atomicAdd(&bar[XB_TMO], 1u); break; } }
    }
    nloc = mine > 0u ? mine : 1u; nx = cnt > 0u ? cnt : 1u;
}

__device__ __forceinline__ void xcd_barrier(const XcdBarrier& b) {
    asm volatile("s_waitcnt vmcnt(0)" ::: "memory");
    __syncthreads();
    if (xb_tid0()) {
        unsigned* bar = b.bar;
        __builtin_amdgcn_s_waitcnt(0);
        unsigned nloc = b.st[0], nx = b.st[1];
        if (nloc == 0u) { xcd_barrier_complete(bar, b.x, nloc, nx); b.st[0] = nloc; b.st[1] = nx; }
        const unsigned old = xb_add(&bar[XB_XSUB(b.x)], 1u);
        const unsigned gen = old / nloc;
        if (old + 1u == (gen + 1u) * nloc) {
            __builtin_amdgcn_fence(__ATOMIC_RELEASE, "agent");
            asm volatile("s_waitcnt vmcnt(0)" ::: "memory");
            const unsigned og = xb_add(&bar[XB_TOP], 1u);
            const unsigned tg = og / nx;
            if (og + 1u == (tg + 1u) * nx) xb_add(&bar[XB_TOPGEN], 1u);
            else XB_SPIN(xb_ld(&bar[XB_TOPGEN]) == tg, bar);
            __builtin_amdgcn_fence(__ATOMIC_ACQUIRE, "agent");
            xb_add(&bar[XB_XGEN(b.x)], 1u);
            asm volatile("s_waitcnt vmcnt(0)" ::: "memory");
        } else {
            XB_SPIN(xb_ld(&bar[XB_XGEN(b.x)]) == gen, bar);
            __builtin_amdgcn_fence(__ATOMIC_ACQUIRE, "agent");
            asm volatile("s_waitcnt vmcnt(0)" ::: "memory");
        }
    }
    __syncthreads();
}

struct Ctx { LAS unsigned char* lds; unsigned char* ws; const float* const* in; float* out; int tid, lane, wave, G, bid; };

struct TItem { const float* W; bf16* WT; int K, Nsrc, k0, n0; };
DI void p0_item_decode(const Ctx& F, int it, TItem& t) {
    constexpr int I0 = 32 * (NINP / 64), I1 = 32 * 32, I4 = 32 * 128, I5 = 128 * 32, IL = I0 + 3 * I1 + I4 + I5;
    const int l = it / IL; int r = it % IL; unsigned char* wl = F.ws + WS_W + (size_t)l * W_LAYER; const float* const* in = F.in;
    const float* W; bf16* WT; int K, Nsrc, Npad;
    if (r < I0) { W = in[13] + (size_t)l * D * NIN; WT = (bf16*)(wl + W_WIN); K = D; Nsrc = NIN; Npad = NINP; }
    else if ((r -= I0) < I1) { W = in[20] + (size_t)l * D * D; WT = (bf16*)(wl + W_WBA); K = D; Nsrc = D; Npad = D; }
    else if ((r -= I1) < I1) { W = in[21] + (size_t)l * D * D; WT = (bf16*)(wl + W_WBB); K = D; Nsrc = D; Npad = D; }
    else if ((r -= I1) < I1) { W = in[22] + (size_t)l * D * D; WT = (bf16*)(wl + W_WO); K = D; Nsrc = D; Npad = D; }
    else if ((r -= I1) < I4) { W = in[23] + (size_t)l * D * DFF; WT = (bf16*)(wl + W_WUP); K = D; Nsrc = DFF; Npad = DFF; }
    else { r -= I4; W = in[24] + (size_t)l * DFF * D; WT = (bf16*)(wl + W_WDN); K = DFF; Nsrc = D; Npad = D; }
    const int nblk = Npad / 64; t.W = W; t.WT = WT; t.K = K; t.Nsrc = Nsrc; t.k0 = 64 * (r / nblk); t.n0 = 64 * (r % nblk);
}
DI void p0_item_load(const TItem& t, int lane, f32x4 (&v)[16]) {
    const int nq = lane & 15, kr = lane >> 4, n = t.n0 + 4 * nq; const bool ok = n < t.Nsrc;
#pragma unroll
    for (int i = 0; i < 16; ++i) v[i] = ok ? *(const GAS f32x4*)(t.W + (size_t)(t.k0 + 4 * i + kr) * t.Nsrc + n) : (f32x4){0.f, 0.f, 0.f, 0.f};
}
DI void p0_item_store(const TItem& t, int lane, const f32x4 (&v)[16], LAS float* scr) {
    const int nq = lane & 15, kr = lane >> 4;
#pragma unroll
    for (int i = 0; i < 16; ++i) { LAS float* s = scr + (4 * i + kr) * 65 + 4 * nq; s[0] = v[i].x; s[1] = v[i].y; s[2] = v[i].z; s[3] = v[i].w; }
    LDS_WAIT(); asm volatile("" ::: "memory");
#pragma unroll
    for (int j = 0; j < 8; ++j) { const int pr = lane + 64 * j, nn = pr >> 3, c = pr & 7; const LAS float* s = scr + (8 * c) * 65 + nn;
        u32x4 o; o.x = cvtpk(s[0 * 65], s[1 * 65]); o.y = cvtpk(s[2 * 65], s[3 * 65]); o.z = cvtpk(s[4 * 65], s[5 * 65]); o.w = cvtpk(s[6 * 65], s[7 * 65]);
        *(GAS u32x4*)(t.WT + (size_t)(t.n0 + nn) * t.K + t.k0 + 8 * c) = o; }
    LDS_WAIT(); asm volatile("" ::: "memory");
}

DI void p0_convert_weights(const Ctx& F, int l0, int l1, int w, int nw) {
    LAS float* scr = (LAS float*)(F.lds + F.wave * 16640);
    constexpr int IL = 32 * (NINP / 64) + 3 * 32 * 32 + 32 * 128 + 128 * 32;
    const int first = l0 * IL, NIT = l1 * IL;
    f32x4 va[16], vb[16]; TItem ta, tb;
    int it = first + w;
    if (it < NIT) { p0_item_decode(F, it, ta); p0_item_load(ta, F.lane, va); }
    while (it < NIT) {
        const int itn = it + nw;
        if (itn < NIT) { p0_item_decode(F, itn, tb); p0_item_load(tb, F.lane, vb); }
        p0_item_store(ta, F.lane, va, scr);
        it = itn; if (it >= NIT) break;
        const int itn2 = it + nw;
        if (itn2 < NIT) { p0_item_decode(F, itn2, ta); p0_item_load(ta, F.lane, va); }
        p0_item_store(tb, F.lane, vb, scr);
        it = itn2;
    }
}

DI void p0_prologue(const Ctx& F) {
    const float* const* in = F.in;
    const int gw = F.bid * 8 + F.wave, NGW = F.G * 8;
    const int gt = F.bid * 512 + F.tid, NGT = F.G * 512;
    {
        LAS float* csT = (LAS float*)F.lds;
        LAS float* red = (LAS float*)(F.lds + 98304);
        for (int i = F.tid; i < 12 * D; i += 512) { const int r = i / D, k = i % D; const float c = r < 4 ? in[7][r * D + k] : in[8][(r - 4) * D + k]; csT[k * 12 + r] = c * sigm(c); }
        __syncthreads();
        float* MOD = (float*)(F.ws + WS_MOD);
        for (int u = F.bid; u < DEPTH * (MODW / 256); u += F.G) {
            const int l = u / (MODW / 256), j0 = (u % (MODW / 256)) * 256;
            const float* wp = in[9] + (size_t)l * D * MODW + (size_t)(256 * F.wave) * MODW + j0 + 4 * F.lane;
            f32x4 acc[12];
#pragma unroll
            for (int r = 0; r < 12; ++r) acc[r] = (f32x4){0.f, 0.f, 0.f, 0.f};
#pragma unroll 8
            for (int k = 0; k < 256; ++k) { const f32x4 w = *(const GAS f32x4*)(wp + (size_t)k * MODW); const LAS f32x4* cp = (const LAS f32x4*)(csT + (256 * F.wave + k) * 12);
                const f32x4 c0 = cp[0], c1 = cp[1], c2 = cp[2];
                acc[0] += w * c0[0]; acc[1] += w * c0[1]; acc[2] += w * c0[2]; acc[3] += w * c0[3]; acc[4] += w * c1[0]; acc[5] += w * c1[1]; acc[6] += w * c1[2]; acc[7] += w * c1[3];
                acc[8] += w * c2[0]; acc[9] += w * c2[1]; acc[10] += w * c2[2]; acc[11] += w * c2[3]; }
#pragma unroll
            for (int hf = 0; hf < 2; ++hf) {
#pragma unroll
                for (int r = 0; r < 6; ++r) *(LAS f32x4*)(red + ((F.wave * 6 + r) * 256 + 4 * F.lane)) = acc[6 * hf + r];
                __syncthreads();
                for (int i = F.tid; i < 6 * 256; i += 512) { const int r = i / 256, c = i % 256; float s = 0.f;
#pragma unroll
                    for (int w = 0; w < 8; ++w) s += red[(w * 6 + r) * 256 + c];
                    MOD[((size_t)l * 12 + 6 * hf + r) * MODW + j0 + c] = s + in[10][(size_t)l * MODW + j0 + c]; }
                __syncthreads();
            }
        }
    }
    p0_convert_weights(F, 0, F.G == 256 ? 1 : DEPTH, gw, NGW);
    {
        f32x4* Xs = (f32x4*)(F.ws + WS_X) + (size_t)MPR * D / 4; const f32x4* xs = (const f32x4*)in[1];
        for (size_t i = gt; i < (size_t)MS * D / 4; i += NGT) Xs[i] = xs[i];
        const size_t pad0 = (size_t)M * D * 2 / 16, pad1 = (size_t)MP * D * 2 / 16;
        u32x4* h4 = (u32x4*)(F.ws + WS_H); u32x4* a4 = (u32x4*)(F.ws + WS_QA); u32x4* b4 = (u32x4*)(F.ws + WS_KA);
        for (size_t i = pad0 + gt; i < pad1; i += NGT) { const u32x4 z = {0u, 0u, 0u, 0u}; h4[i] = z; a4[i] = z; b4[i] = z; }
    }
    {
        float* LB = (float*)(F.ws + WS_LB);
        for (int d = gt; d < 2048; d += NGT) { float r[4], mx = -1e30f;
#pragma unroll
            for (int l = 0; l < 4; ++l) { r[l] = in[18][l * 2048 + d]; mx = fmaxf(mx, r[l]); }
            float e[4], s = 0.f;
#pragma unroll
            for (int l = 0; l < 4; ++l) { e[l] = __expf(r[l] - mx); s += e[l]; }
            const float inv = 1.0f / s; float cum = 0.f;
#pragma unroll
            for (int l = 0; l < 4; ++l) { if (l > 0) cum += e[l] * inv; LB[l * 2048 + d] = cum; } }
        float* BIN = (float*)(F.ws + WS_BIN);
        for (int i = gt; i < DEPTH * NINP; i += NGT) { const int l = i / NINP, c = i % NINP; BIN[i] = c < NIN ? in[14][(size_t)l * NIN + c] : 0.f; }
    }
}

DI void norm_phase(const Ctx& F, const float* gain, const float* modl  , int sh_off, int sc_off, const float* Xp  ) {
    const int gw = F.bid * 8 + F.wave, NGW = F.G * 8;
    const float* X = (const float*)(F.ws + WS_X); bf16* H = (bf16*)(F.ws + WS_H);
    f32x4 v[8], nv[8];
#define NM_LOAD(row_, V_) do { const GAS f32x4* xr_ = (const GAS f32x4*)(((row_) < MPR ? Xp : X) + (size_t)(row_) * D) + F.lane; _Pragma("unroll") for (int j = 0; j < 8; ++j) V_[j] = xr_[64 * j]; } while (0)
    int row = gw;
    if (row < M) NM_LOAD(row, v);
    for (; row < M; row += NGW) {
        const int nrow = row + NGW;
        if (nrow < M) NM_LOAD(nrow, nv);
        float ss = 0.f;
#pragma unroll
        for (int j = 0; j < 8; ++j) ss += (v[j].x * v[j].x + v[j].y * v[j].y) + (v[j].z * v[j].z + v[j].w * v[j].w);
        const float rs = rsqrtf(wave_sum(ss) * (1.0f / D) + EPS);
        const float* mb = modl + (size_t)row_batch(row) * MODW;
        GAS u32x2* o8 = (GAS u32x2*)(H + (size_t)row * D) + F.lane;
#pragma unroll
        for (int j = 0; j < 8; ++j) { const int c = 4 * F.lane + 256 * j; const f32x4 g = *(const f32x4*)(gain + c), sc = *(const f32x4*)(mb + sc_off + c), sh = *(const f32x4*)(mb + sh_off + c);
            const f32x4 y = (v[j] * rs) * g * (sc + 1.0f) + sh; u32x2 w; w.x = cvtpk(y.x, y.y); w.y = cvtpk(y.z, y.w); o8[64 * j] = w; }
#pragma unroll
        for (int j = 0; j < 8; ++j) v[j] = nv[j];
    }
#undef NM_LOAD
}
DI void final_norm_phase(const Ctx& F) {
    const int gw = F.bid * 8 + F.wave, NGW = F.G * 8;
    const float* X = (const float*)(F.ws + WS_X); const float* gain = F.in[25];
    for (int row = gw; row < M; row += NGW) {
        const GAS f32x4* xr = (const GAS f32x4*)(X + (size_t)row * D) + F.lane;
        f32x4 v[8]; float ss = 0.f;
#pragma unroll
        for (int j = 0; j < 8; ++j) { v[j] = xr[64 * j]; ss += (v[j].x * v[j].x + v[j].y * v[j].y) + (v[j].z * v[j].z + v[j].w * v[j].w); }
        const float rs = rsqrtf(wave_sum(ss) * (1.0f / D) + EPS);
        GAS f32x4* o = (GAS f32x4*)(F.out + (size_t)row * D) + F.lane;
#pragma unroll
        for (int j = 0; j < 8; ++j) { const f32x4 g = *(const f32x4*)(gain + 4 * F.lane + 256 * j); o[64 * j] = (v[j] * rs) * g; }
    }
}

DI void prep_phase(const Ctx& F, int l) {
    const bf16* Z = (const bf16*)(F.ws + WS_Z);
    bf16* QA = (bf16*)(F.ws + WS_QA); bf16* KA = (bf16*)(F.ws + WS_KA); bf16* QB = (bf16*)(F.ws + WS_QB); bf16* KB = (bf16*)(F.ws + WS_KB);
    float* E1 = (float*)(F.ws + WS_E1); float* E2 = (float*)(F.ws + WS_E2);
    const float* LB = (const float*)(F.ws + WS_LB) + l * 2048;
    constexpr int NGC = 12, CR = 8, NCONV = M / CR, NHG = NCHUNKS * 8;
    const float* G = (const float*)(F.ws + WS_G); float* GP = (float*)(F.ws + WS_GP);
    const bool split = F.G > 2 * NGC;
    if (F.bid < NGC) {
        const int chain = F.bid * 8 + F.wave, lane = F.lane;
        const bool sample = chain >= 32; const int cc = sample ? chain - 32 : chain, b = cc >> 3, h = cc & 7;
        const int row0 = sample ? MPR + b * SSEQ : b * SEQ, nchunk = sample ? 1 : SEQ / 64, Tv = sample ? SSEQ : 64;
        float m_prev = sample ? F.in[5][((size_t)l * NSB + b) * 8 + h] : 0.f;
        float nig = lane < Tv ? G[(size_t)(row0 + lane) * 16 + h] : -1e30f, nfg = lane < Tv ? G[(size_t)(row0 + lane) * 16 + 8 + h] : 0.f;
        for (int c = 0; c < nchunk; ++c) {
            const int r0 = row0 + 64 * c; const float igv = nig, fgv = nfg;
            if (c + 1 < nchunk) { nig = G[(size_t)(r0 + 64 + lane) * 16 + h]; nfg = G[(size_t)(r0 + 64 + lane) * 16 + 8 + h]; }
            const float lfv = lane < Tv ? logsig(fgv) : 0.f;
            float bc = lfv;
#pragma unroll
            for (int o = 1; o < 64; o <<= 1) { const float y = __shfl_up(bc, o); if (lane >= o) bc += y; }
            float gm = igv - bc;
#pragma unroll
            for (int o = 1; o < 64; o <<= 1) { const float y = __shfl_up(gm, o); if (lane >= o) gm = fmaxf(gm, y); }
            const float mt = bc + fmaxf(gm, m_prev);
            const float winter = __expf(bc + m_prev - mt), enm = __expf(-mt);
            const float m_last = __shfl(mt, 63), b_last = __shfl(bc, 63);
            const float wlast = __expf(b_last - bc + igv - m_last);
            if (lane < Tv) { float* gp = GP + ((size_t)(r0 + lane) * 8 + h) * 8; *(f32x4*)gp = (f32x4){bc - mt, igv - bc, winter, enm}; *(f32x4*)(gp + 4) = (f32x4){wlast, mt, 0.f, 0.f}; }
            m_prev = m_last;
        }
        if (split) return;
    }
    const int nb = split ? F.G - NGC : F.G, me = split ? F.bid - NGC : F.bid;
    {
        const int c0 = 8 * F.tid;
        float w[4][8], cb[8];
#pragma unroll
        for (int j = 0; j < 4; ++j) { const f32x4 a = *(const f32x4*)(F.in[15] + ((size_t)l * 4 + j) * 4096 + c0), b = *(const f32x4*)(F.in[15] + ((size_t)l * 4 + j) * 4096 + c0 + 4);
            w[j][0] = a.x; w[j][1] = a.y; w[j][2] = a.z; w[j][3] = a.w; w[j][4] = b.x; w[j][5] = b.y; w[j][6] = b.z; w[j][7] = b.w; }
        { const f32x4 a = *(const f32x4*)(F.in[16] + (size_t)l * 4096 + c0), b = *(const f32x4*)(F.in[16] + (size_t)l * 4096 + c0 + 4);
            cb[0] = a.x; cb[1] = a.y; cb[2] = a.z; cb[3] = a.w; cb[4] = b.x; cb[5] = b.y; cb[6] = b.z; cb[7] = b.w; }
        u32x4 cur[CR + 3], nxt[CR + 3];
#define CV_LOAD(it_, V_) do { const int r0_ = (it_) * CR; const bool hist_ = (r0_ >= MPR) ? (((r0_ - MPR) & (SSEQ - 1)) != 0) : ((r0_ & (SEQ - 1)) != 0); \
        _Pragma("unroll") for (int j = 0; j < CR + 3; ++j) V_[j] = (j >= 3 || hist_) ? *(const GAS u32x4*)(Z + (size_t)(r0_ - 3 + j) * NINP + c0) : (u32x4){0u, 0u, 0u, 0u}; } while (0)
        int it = me;
        if (it < NCONV) CV_LOAD(it, cur);
        for (; it < NCONV; it += nb) {
            const int itn = it + nb;
            if (itn < NCONV) CV_LOAD(itn, nxt);
            const int r0 = it * CR; const bool sample = r0 >= MPR;
            const int t0 = sample ? ((r0 - MPR) & (SSEQ - 1)) : (r0 & (SEQ - 1)); const int bs = sample ? (r0 - MPR) >> 4 : (r0 >> 12);
            float z0[8], z1[8], z2[8];
            if (t0 == 0 && sample) { const float* cc = F.in[2] + (((size_t)l * NSB + bs) * 3) * 4096 + c0;
#pragma unroll
                for (int e = 0; e < 8; ++e) { z0[e] = cc[e]; z1[e] = cc[4096 + e]; z2[e] = cc[8192 + e]; } }
            else { pg8::unpack8(cur[0], z0); pg8::unpack8(cur[1], z1); pg8::unpack8(cur[2], z2); }
            const bool last = sample ? (t0 + CR == SSEQ) : (t0 + CR == SEQ);
            float* cout = F.out + (sample ? O_CONVS + (((size_t)l * NSB + bs) * 3) * 4096 : O_CONVP + (((size_t)l * NB + bs) * 3) * 4096) + c0;
#pragma unroll
            for (int rr = 0; rr < CR; ++rr) {
                float z3[8]; pg8::unpack8(cur[3 + rr], z3);
                float y[8];
#pragma unroll
                for (int e = 0; e < 8; ++e) { const float a = cb[e] + w[0][e] * z0[e] + w[1][e] * z1[e] + w[2][e] * z2[e] + w[3][e] * z3[e]; y[e] = a * sigm(a); }
                if (c0 < 2048) { u32x4 o; o.x = cvtpk(y[0], y[1]); o.y = cvtpk(y[2], y[3]); o.z = cvtpk(y[4], y[5]); o.w = cvtpk(y[6], y[7]); *(GAS u32x4*)(QA + (size_t)(r0 + rr) * D + c0) = o; }
                else { u32x4 o; o.x = cvtpk(y[0] * 0.0625f, y[1] * 0.0625f); o.y = cvtpk(y[2] * 0.0625f, y[3] * 0.0625f); o.z = cvtpk(y[4] * 0.0625f, y[5] * 0.0625f); o.w = cvtpk(y[6] * 0.0625f, y[7] * 0.0625f);
                    *(GAS u32x4*)(KA + (size_t)(r0 + rr) * D + (c0 - 2048)) = o; }
                if (last && rr >= CR - 3) { float* cp = cout + (size_t)(rr - (CR - 3)) * 4096; *(f32x4*)cp = (f32x4){z3[0], z3[1], z3[2], z3[3]}; *(f32x4*)(cp + 4) = (f32x4){z3[4], z3[5], z3[6], z3[7]}; }
#pragma unroll
                for (int e = 0; e < 8; ++e) { z0[e] = z1[e]; z1[e] = z2[e]; z2[e] = z3[e]; }
            }
#pragma unroll
            for (int j = 0; j < CR + 3; ++j) cur[j] = nxt[j];
        }
#undef CV_LOAD
    }
    {
        const int d = F.tid & 255, hf = F.tid >> 8;
        LAS unsigned char* FBs = F.lds; LAS unsigned char* QBs = F.lds + 32768; LAS float* xch = (LAS float*)(F.lds + 65536);
        u32x4 pf[4], pq[4];
#define HG_LOAD(hi_) do { const int ci_ = (hi_) >> 3, cb_ = ((hi_) & 7) * 256; const bool sm_ = ci_ >= NB * 64; const int r0_ = sm_ ? MPR + (ci_ - NB * 64) * 16 : ci_ * 64, Tv_ = sm_ ? 16 : 64; \
        _Pragma("unroll") for (int i = 0; i < 4; ++i) { const int idx = F.tid + 512 * i, rr = idx >> 5, sg = idx & 31; \
            if (rr < Tv_) { pf[i] = *(const GAS u32x4*)(Z + (size_t)(r0_ + rr) * NINP + ZFB + cb_ + 8 * sg); pq[i] = *(const GAS u32x4*)(Z + (size_t)(r0_ + rr) * NINP + ZQB + cb_ + 8 * sg); } } } while (0)
        int hi = (me + 56) % nb;
        if (hi < NHG) HG_LOAD(hi);
        for (; hi < NHG; hi += nb) {
            const int ci = hi >> 3, cbase = (hi & 7) * 256;
            const bool sample = ci >= NB * 64; const int r0 = sample ? MPR + (ci - NB * 64) * 16 : ci * 64; const int Tv = sample ? 16 : 64;
#pragma unroll
            for (int i = 0; i < 4; ++i) { const int idx = F.tid + 512 * i, rr = idx >> 5, sg = idx & 31;
                if (rr < Tv) { *(LAS u32x4*)(FBs + rr * 512 + sg * 16) = pf[i]; *(LAS u32x4*)(QBs + rr * 512 + sg * 16) = pq[i]; } }
            LBAR();
            if (hi + nb < NHG) HG_LOAD(hi + nb);
            const float lb = LB[cbase + d], oml = 1.0f - lb;
            float bc[32]; float run = 0.f;
#pragma unroll
            for (int i = 0; i < 32; ++i) { const int t = 32 * hf + i;
                if (t < Tv) { const float fb = fminf(fmaxf(bf2f(*(const LAS unsigned short*)(FBs + t * 512 + d * 2)), -30.f), 30.f); const float f = lb + oml * __builtin_amdgcn_rcpf(1.0f + __expf(-fb)); run += fmaxf(__logf(f), -60.0f); }
                bc[i] = run; }
            if (hf == 0) xch[d] = run;
            LBAR();
            const float base = hf ? xch[d] : 0.f; const float bR = hf ? base : run;
            if (hf) { E1[(size_t)ci * 2048 + cbase + d] = __expf(bR); E2[(size_t)ci * 2048 + cbase + d] = __expf(run); }
#pragma unroll
            for (int i = 0; i < 32; ++i) { const int t = 32 * hf + i;
                if (t < Tv) { const float fb = fminf(fmaxf(bf2f(*(const LAS unsigned short*)(FBs + t * 512 + d * 2)), -30.f), 30.f), qv = bf2f(*(const LAS unsigned short*)(QBs + t * 512 + d * 2));
                    const float e = __expf(-fb), s = __builtin_amdgcn_rcpf(1.0f + e), bt = base + bc[i];
                    const float q = qv * sigm(qv) * __expf(bt - bR), k = oml * e * s * __expf(bR - bt);
                    *(LAS unsigned short*)(QBs + t * 512 + d * 2) = (unsigned short)(cvtpk(q, q) & 0xffffu); *(LAS unsigned short*)(FBs + t * 512 + d * 2) = (unsigned short)(cvtpk(k, k) & 0xffffu); } }
            LBAR();
#pragma unroll
            for (int i = 0; i < 4; ++i) { const int idx = F.tid + 512 * i, rr = idx >> 5, sg = idx & 31;
                if (rr < Tv) { *(GAS u32x4*)(QB + (size_t)(r0 + rr) * D + cbase + 8 * sg) = *(const LAS u32x4*)(QBs + rr * 512 + sg * 16);
                               *(GAS u32x4*)(KB + (size_t)(r0 + rr) * D + cbase + 8 * sg) = *(const LAS u32x4*)(FBs + rr * 512 + sg * 16); } }
            LBAR();
        }
#undef HG_LOAD
    }
}

DI void headnorm_phase(const Ctx& F, int l) {
    const int gw = F.bid * 8 + F.wave, NGW = F.G * 8;
    const bf16* Z = (const bf16*)(F.ws + WS_Z); const bf16* HA = (const bf16*)(F.ws + WS_HA); const bf16* HB = (const bf16*)(F.ws + WS_HB);
    bf16* YA = (bf16*)(F.ws + WS_QA); bf16* YB = (bf16*)(F.ws + WS_KA);
    const float* ga = F.in[17] + (size_t)l * 2048; const float* gb = F.in[19] + (size_t)l * 2048;
    u32x4 ha[4], hb[4], oa[4], ob[4], na[4], nb[4], noa[4], nob[4];
#define HN_LOAD(row_, A_, B_, OA_, OB_) do { _Pragma("unroll") for (int j = 0; j < 4; ++j) { const int c_ = 512 * j + 8 * F.lane; \
        A_[j] = *(const GAS u32x4*)(HA + (size_t)(row_) * D + c_); B_[j] = *(const GAS u32x4*)(HB + (size_t)(row_) * D + c_); \
        OA_[j] = *(const GAS u32x4*)(Z + (size_t)(row_) * NINP + ZOA + c_); OB_[j] = *(const GAS u32x4*)(Z + (size_t)(row_) * NINP + ZOGB + c_); } } while (0)
    int row = gw;
    if (row < M) HN_LOAD(row, ha, hb, oa, ob);
    for (; row < M; row += NGW) {
        const int nrow = row + NGW;
        if (nrow < M) HN_LOAD(nrow, na, nb, noa, nob);
#pragma unroll
        for (int j = 0; j < 4; ++j) { const int c = 512 * j + 8 * F.lane;
            { float hv[8], ov[8]; pg8::unpack8(ha[j], hv); pg8::unpack8(oa[j], ov); float ss = 0.f;
#pragma unroll
              for (int e = 0; e < 8; ++e) ss += hv[e] * hv[e];
#pragma unroll
              for (int o = 1; o < 32; o <<= 1) ss += __shfl_xor(ss, o);
              const float rs = rsqrtf(ss * (1.0f / 256.0f) + EPS); const f32x4 g0 = *(const f32x4*)(ga + c), g1 = *(const f32x4*)(ga + c + 4); float y[8];
#pragma unroll
              for (int e = 0; e < 8; ++e) y[e] = hv[e] * rs * (e < 4 ? g0[e] : g1[e - 4]) * sigm(ov[e]);
              u32x4 w; w.x = cvtpk(y[0], y[1]); w.y = cvtpk(y[2], y[3]); w.z = cvtpk(y[4], y[5]); w.w = cvtpk(y[6], y[7]); *(GAS u32x4*)(YA + (size_t)row * D + c) = w; }
            { float hv[8], ov[8]; pg8::unpack8(hb[j], hv); pg8::unpack8(ob[j], ov); float ss = 0.f;
#pragma unroll
              for (int e = 0; e < 8; ++e) ss += hv[e] * hv[e];
#pragma unroll
              for (int o = 1; o < 16; o <<= 1) ss += __shfl_xor(ss, o);
              const float rs = rsqrtf(ss * (1.0f / 128.0f) + EPS); const f32x4 g0 = *(const f32x4*)(gb + c), g1 = *(const f32x4*)(gb + c + 4); float y[8];
#pragma unroll
              for (int e = 0; e < 8; ++e) y[e] = hv[e] * rs * (e < 4 ? g0[e] : g1[e - 4]) * sigm(ov[e]);
              u32x4 w; w.x = cvtpk(y[0], y[1]); w.y = cvtpk(y[2], y[3]); w.z = cvtpk(y[4], y[5]); w.w = cvtpk(y[6], y[7]); *(GAS u32x4*)(YB + (size_t)row * D + c) = w; }
        }
#pragma unroll
        for (int j = 0; j < 4; ++j) { ha[j] = na[j]; hb[j] = nb[j]; oa[j] = noa[j]; ob[j] = nob[j]; }
    }
#undef HN_LOAD
}

DI bf16x8 frag(const LAS unsigned char* base, int row, int ldb, int kbyte) { return *(const LAS bf16x8*)(base + row * ldb + kbyte); }
DI bf16x8 frag_t(const LAS unsigned char* base, int k0, int ldb, int col) {
    const LAS unsigned short* p = (const LAS unsigned short*)(base + k0 * ldb + col * 2); bf16x8 r;
#pragma unroll
    for (int j = 0; j < 8; ++j) r[j] = (short)p[j * (ldb / 2)];
    return r;
}
#ifndef PROBE_ST
#define PROBE_ST 1
#endif
#ifndef PROBE_S2
#define PROBE_S2 1
#endif
#ifndef PROBE_S3
#define PROBE_S3 1
#endif
#ifndef PROBE_S4
#define PROBE_S4 1
#endif
#define PROBE_LOOP(n) int reps_ = (n); asm volatile("" : "+s"(reps_)); _Pragma("nounroll") for (int rp_ = 0; rp_ < reps_; ++rp_)
#define MFMA16(a, b, c) __builtin_amdgcn_mfma_f32_16x16x32_bf16((a), (b), (c), 0, 0, 0)

DI void mlstm_unit(LAS unsigned char* lds, const bf16* QA, const bf16* KA, const bf16* Z, const float* GP, bf16* HA,
                   int row0, int nchunk, int Tv, int h, int vs, const float* C0, const float* n0, const float* m0p, float* Cout, float* nout, float* mout) {
    int tid_ = threadIdx.x; asm volatile("" : "+v"(tid_));
    const int tid = tid_, lane = tid & 63, W = __builtin_amdgcn_readfirstlane(tid >> 6), g = lane >> 4, li = lane & 15;
    LAS unsigned char* Qs = lds + SC_Q; LAS unsigned char* Ks = lds + SC_K; LAS unsigned char* VT = lds + SC_VT; LAS unsigned char* VW = lds + SC_VW;
    LAS unsigned char* CTs = lds + SC_CT; LAS unsigned char* Ps = lds + SC_P; LAS unsigned char* Hs = lds + SC_H;
    f32x4 cacc[2][5];
#pragma unroll
    for (int di = 0; di < 2; ++di)
#pragma unroll
        for (int vi = 0; vi < 5; ++vi)
#pragma unroll
            for (int r = 0; r < 4; ++r) { const int d = 16 * (2 * W + di) + 4 * g + r; float v = 0.f;
                if (C0) { if (vi < 4) v = C0[(size_t)d * 256 + 64 * vs + 16 * vi + li]; else if (li == 0) v = n0[d]; }
                cacc[di][vi][r] = v; }
    float m_prev = m0p ? *m0p : 0.f;
    for (int i = tid; i < 16 * 72; i += 512) { const int rr = 64 + i / 72, cc = i % 72;
        *(LAS unsigned short*)(VT + rr * LVB + cc * 2) = (rr == 64 && cc < 64) ? (unsigned short)0x3F80 : (unsigned short)0; *(LAS unsigned short*)(VW + rr * LVB + cc * 2) = 0; }
    u32x4 pq[4], pk[4]; u32x2 pva, pvb; f32x4 pg0, pg1;
#define ML_PREFETCH(c) do { const int r0_ = row0 + 64 * (c); \
        _Pragma("unroll") for (int i = 0; i < 4; ++i) { const int idx = tid + 512 * i, rr = idx >> 5, sg = idx & 31; \
            if (rr < Tv) { pq[i] = *(const GAS u32x4*)(QA + (size_t)(r0_ + rr) * D + 256 * h + 8 * sg); pk[i] = *(const GAS u32x4*)(KA + (size_t)(r0_ + rr) * D + 256 * h + 8 * sg); } \
            else { pq[i] = (u32x4){0u, 0u, 0u, 0u}; pk[i] = (u32x4){0u, 0u, 0u, 0u}; } } \
        { const int fp = tid & 31, vq = tid >> 5; const bf16* vp_ = Z + (size_t)(r0_ + 2 * fp) * NINP + ZVA + 256 * h + 64 * vs + 4 * vq; \
          pva = 2 * fp < Tv ? *(const GAS u32x2*)vp_ : (u32x2){0u, 0u}; pvb = 2 * fp + 1 < Tv ? *(const GAS u32x2*)(vp_ + NINP) : (u32x2){0u, 0u}; } \
        if (lane < Tv) { const float* gp_ = GP + ((size_t)(r0_ + lane) * 8 + h) * 8; pg0 = *(const GAS f32x4*)gp_; pg1 = *(const GAS f32x4*)(gp_ + 4); } \
        else { pg0 = (f32x4){0.f, -1e30f, 0.f, 1.f}; pg1 = (f32x4){0.f, 0.f, 0.f, 0.f}; } } while (0)
    ML_PREFETCH(0);
    for (int c = 0; c < nchunk; ++c) {
        const int r0 = row0 + 64 * c;
        const float gx = pg0[0], gy = pg0[1], winter = pg0[2], enm = pg0[3], wlast = pg1[0];
        const float m_last = __shfl(pg1[1], Tv - 1), decay = __shfl(winter, Tv - 1);
        { PROBE_LOOP(PROBE_ST) { asm volatile("" ::: "memory");
#pragma unroll
        for (int i = 0; i < 4; ++i) { const int idx = tid + 512 * i, rr = idx >> 5, sg = idx & 31; *(LAS u32x4*)(Qs + rr * LQB + sg * 16) = pq[i]; *(LAS u32x4*)(Ks + rr * LQB + sg * 16) = pk[i]; }
        {
          const int fp = tid & 31, vq = tid >> 5; const float wa = __shfl(wlast, 2 * fp), wb = __shfl(wlast, 2 * fp + 1);
          const unsigned a0 = pva.x, a1 = pva.y, b0 = pvb.x, b1 = pvb.y;
          const unsigned r0w = (a0 & 0xffffu) | (b0 << 16), r1w = (a0 >> 16) | (b0 & 0xffff0000u), r2w = (a1 & 0xffffu) | (b1 << 16), r3w = (a1 >> 16) | (b1 & 0xffff0000u);
          const unsigned s0w = cvtpk(__uint_as_float(a0 << 16) * wa, __uint_as_float(b0 << 16) * wb), s1w = cvtpk(__uint_as_float(a0 & 0xffff0000u) * wa, __uint_as_float(b0 & 0xffff0000u) * wb);
          const unsigned s2w = cvtpk(__uint_as_float(a1 << 16) * wa, __uint_as_float(b1 << 16) * wb), s3w = cvtpk(__uint_as_float(a1 & 0xffff0000u) * wa, __uint_as_float(b1 & 0xffff0000u) * wb);
          LAS unsigned char* vt = VT + (4 * vq) * LVB + 4 * fp; LAS unsigned char* vw = VW + (4 * vq) * LVB + 4 * fp;
          *(LAS unsigned*)(vt) = r0w; *(LAS unsigned*)(vt + LVB) = r1w; *(LAS unsigned*)(vt + 2 * LVB) = r2w; *(LAS unsigned*)(vt + 3 * LVB) = r3w;
          *(LAS unsigned*)(vw) = s0w; *(LAS unsigned*)(vw + LVB) = s1w; *(LAS unsigned*)(vw + 2 * LVB) = s2w; *(LAS unsigned*)(vw + 3 * LVB) = s3w; }
        if (W == 0) *(LAS unsigned short*)(VW + 64 * LVB + lane * 2) = (unsigned short)(cvtpk(wlast, wlast) & 0xffffu);
#pragma unroll
        for (int di = 0; di < 2; ++di)
#pragma unroll
            for (int vi = 0; vi < 5; ++vi) { u32x2 w; w.x = cvtpk(cacc[di][vi][0], cacc[di][vi][1]); w.y = cvtpk(cacc[di][vi][2], cacc[di][vi][3]);
                *(LAS u32x2*)(CTs + (16 * vi + li) * LQB + (16 * (2 * W + di) + 4 * g) * 2) = w; }
        } }
        LBAR();
        if (c + 1 < nchunk) ML_PREFETCH(c + 1);
        { PROBE_LOOP(PROBE_S2)
        { asm volatile("" ::: "memory");
            const int tt = W & 3, sh = W >> 2;
            f32x4 sacc[2] = {{0.f, 0.f, 0.f, 0.f}, {0.f, 0.f, 0.f, 0.f}};
#pragma unroll
            for (int kk = 0; kk < 8; ++kk) { const bf16x8 bq = frag(Qs, 16 * tt + li, LQB, 64 * kk + 16 * g);
#pragma unroll
                for (int i = 0; i < 2; ++i) if (2 * sh + i <= tt) { const bf16x8 ak = frag(Ks, 16 * (2 * sh + i) + li, LQB, 64 * kk + 16 * g); sacc[i] = MFMA16(ak, bq, sacc[i]); } }
            const int t = 16 * tt + li; const float xt = __shfl(gx, t);
#pragma unroll
            for (int i = 0; i < 2; ++i) { float p[4];
#pragma unroll
                for (int r = 0; r < 4; ++r) { const int s = 16 * (2 * sh + i) + 4 * g + r; const float ys = __shfl(gy, s);
                    p[r] = (s <= t) ? sacc[i][r] * __expf(xt + ys) : 0.f; }
                u32x2 w; w.x = cvtpk(p[0], p[1]); w.y = cvtpk(p[2], p[3]); *(LAS u32x2*)(Ps + t * LVB + (16 * (2 * sh + i) + 4 * g) * 2) = w; }
        } }
        LBAR();
        { PROBE_LOOP(PROBE_S3)
        { asm volatile("" ::: "memory");
            const int tt = W & 3, vh = W >> 2; const int vt0 = 2 * vh, vt1 = 2 * vh + 1;
            f32x4 a1[3], a2[3];
#pragma unroll
            for (int i = 0; i < 3; ++i) { a1[i] = (f32x4){0.f, 0.f, 0.f, 0.f}; a2[i] = (f32x4){0.f, 0.f, 0.f, 0.f}; }
#pragma unroll
            for (int kk = 0; kk < 2; ++kk) { const bf16x8 ap = frag(Ps, 16 * tt + li, LVB, 64 * kk + 16 * g);
                a1[0] = MFMA16(ap, frag(VT, 16 * vt0 + li, LVB, 64 * kk + 16 * g), a1[0]); a1[1] = MFMA16(ap, frag(VT, 16 * vt1 + li, LVB, 64 * kk + 16 * g), a1[1]);
                a1[2] = MFMA16(ap, frag(VT, 64 + li, LVB, 64 * kk + 16 * g), a1[2]); }
#pragma unroll
            for (int kk = 0; kk < 8; ++kk) { const bf16x8 aq = frag(Qs, 16 * tt + li, LQB, 64 * kk + 16 * g);
                a2[0] = MFMA16(aq, frag(CTs, 16 * vt0 + li, LQB, 64 * kk + 16 * g), a2[0]); a2[1] = MFMA16(aq, frag(CTs, 16 * vt1 + li, LQB, 64 * kk + 16 * g), a2[1]);
                a2[2] = MFMA16(aq, frag(CTs, 64 + li, LQB, 64 * kk + 16 * g), a2[2]); }
#pragma unroll
            for (int r = 0; r < 4; ++r) { const int t = 16 * tt + 4 * g + r; const float wi = __shfl(winter, t), en = __shfl(enm, t);
                const float o2 = a1[2][r] + wi * a2[2][r]; const float qn = __shfl(o2, lane & 48); const float inv = __builtin_amdgcn_rcpf(fmaxf(fabsf(qn), en));
                const unsigned hw = cvtpk((a1[0][r] + wi * a2[0][r]) * inv, (a1[1][r] + wi * a2[1][r]) * inv);
                *(LAS unsigned short*)(Hs + t * LVB + (16 * vt0 + li) * 2) = (unsigned short)(hw & 0xffffu); *(LAS unsigned short*)(Hs + t * LVB + (16 * vt1 + li) * 2) = (unsigned short)(hw >> 16); }
        } }
#pragma unroll
        for (int di = 0; di < 2; ++di)
#pragma unroll
            for (int vi = 0; vi < 5; ++vi) cacc[di][vi] = cacc[di][vi] * decay;
#pragma unroll
        for (int kk = 0; kk < 2; ++kk) { bf16x8 ak[2];
#pragma unroll
            for (int di = 0; di < 2; ++di) ak[di] = frag_t(Ks, 32 * kk + 8 * g, LQB, 16 * (2 * W + di) + li);
#pragma unroll
            for (int vi = 0; vi < 5; ++vi) { const bf16x8 bv = frag(VW, 16 * vi + li, LVB, 64 * kk + 16 * g);
#pragma unroll
                for (int di = 0; di < 2; ++di) cacc[di][vi] = MFMA16(ak[di], bv, cacc[di][vi]); } }
        if (PROBE_S4 > 1) { PROBE_LOOP(PROBE_S4 - 1) { asm volatile("" ::: "memory"); f32x4 dacc[2][5];
#pragma unroll
            for (int di = 0; di < 2; ++di)
#pragma unroll
                for (int vi = 0; vi < 5; ++vi) dacc[di][vi] = (f32x4){0.f, 0.f, 0.f, 0.f};
#pragma unroll
            for (int kk = 0; kk < 2; ++kk) { bf16x8 ak[2];
#pragma unroll
                for (int di = 0; di < 2; ++di) ak[di] = frag_t(Ks, 32 * kk + 8 * g, LQB, 16 * (2 * W + di) + li);
#pragma unroll
                for (int vi = 0; vi < 5; ++vi) { const bf16x8 bv = frag(VW, 16 * vi + li, LVB, 64 * kk + 16 * g);
#pragma unroll
                    for (int di = 0; di < 2; ++di) dacc[di][vi] = MFMA16(ak[di], bv, dacc[di][vi]); } }
#pragma unroll
            for (int di = 0; di < 2; ++di)
#pragma unroll
                for (int vi = 0; vi < 5; ++vi) asm volatile("" :: "v"(dacc[di][vi])); } }
        m_prev = m_last;
        LBAR();
        { const int rr = tid >> 3, sg = tid & 7; if (rr < Tv) *(GAS u32x4*)(HA + (size_t)(r0 + rr) * D + 256 * h + 64 * vs + 8 * sg) = *(const LAS u32x4*)(Hs + rr * LVB + sg * 16); }
    }
#undef ML_PREFETCH
#pragma unroll
    for (int di = 0; di < 2; ++di)
#pragma unroll
        for (int r = 0; r < 4; ++r) { const int d = 16 * (2 * W + di) + 4 * g + r;
#pragma unroll
            for (int vi = 0; vi < 4; ++vi) Cout[(size_t)d * 256 + 64 * vs + 16 * vi + li] = cacc[di][vi][r];
            if (vs == 0 && li == 0) nout[d] = cacc[di][4][r]; }
    if (vs == 0 && tid == 0) *mout = m_prev;
}

DI void hgrn_unit(LAS unsigned char* lds, const bf16* QB, const bf16* KB, const bf16* Z, const float* E1, const float* E2, bf16* HB,
                  int row0, int nchunk, int Tv, int h, int vs, int ci0, const float* S0, float* Sout) {
    int tid_ = threadIdx.x; asm volatile("" : "+v"(tid_));
    const int tid = tid_, lane = tid & 63, W = __builtin_amdgcn_readfirstlane(tid >> 6), g = lane >> 4, li = lane & 15;
    LAS unsigned char* Qs = lds + HS_Q; LAS unsigned char* Ks = lds + HS_K; LAS unsigned char* VT = lds + HS_VT; LAS unsigned char* STs = lds + HS_ST; LAS unsigned char* Ps = lds + HS_P; LAS unsigned char* Hs = lds + HS_H;
    f32x4 sacc[4];
#pragma unroll
    for (int vi = 0; vi < 4; ++vi)
#pragma unroll
        for (int r = 0; r < 4; ++r) sacc[vi][r] = S0 ? S0[(size_t)(16 * W + 4 * g + r) * 128 + 64 * vs + 16 * vi + li] : 0.f;
    u32x4 pq[2], pk[2]; u32x2 pva, pvb; f32x4 pe1, pe2;
#define HG_PREFETCH(c) do { const int r0_ = row0 + 64 * (c); \
        _Pragma("unroll") for (int i = 0; i < 2; ++i) { const int idx = tid + 512 * i, rr = idx >> 4, sg = idx & 15; \
            if (rr < Tv) { pq[i] = *(const GAS u32x4*)(QB + (size_t)(r0_ + rr) * D + 128 * h + 8 * sg); pk[i] = *(const GAS u32x4*)(KB + (size_t)(r0_ + rr) * D + 128 * h + 8 * sg); } \
            else { pq[i] = (u32x4){0u, 0u, 0u, 0u}; pk[i] = (u32x4){0u, 0u, 0u, 0u}; } } \
        { const int fp = tid & 31, vq = tid >> 5; const bf16* vp_ = Z + (size_t)(r0_ + 2 * fp) * NINP + ZIB + 128 * h + 64 * vs + 4 * vq; \
          pva = 2 * fp < Tv ? *(const GAS u32x2*)vp_ : (u32x2){0u, 0u}; pvb = 2 * fp + 1 < Tv ? *(const GAS u32x2*)(vp_ + NINP) : (u32x2){0u, 0u}; } \
        pe1 = *(const GAS f32x4*)(E1 + (size_t)(ci0 + (c)) * 2048 + 128 * h + 16 * W + 4 * g); pe2 = *(const GAS f32x4*)(E2 + (size_t)(ci0 + (c)) * 2048 + 128 * h + 16 * W + 4 * g); } while (0)
    HG_PREFETCH(0);
    for (int c = 0; c < nchunk; ++c) {
        const int r0 = row0 + 64 * c;
        const f32x4 e2 = pe2;
        f32x4 smid[4];
#pragma unroll
        for (int vi = 0; vi < 4; ++vi) smid[vi] = sacc[vi] * pe1;
#pragma unroll
        for (int i = 0; i < 2; ++i) { const int idx = tid + 512 * i, rr = idx >> 4, sg = idx & 15; *(LAS u32x4*)(Qs + rr * LHB + sg * 16) = pq[i]; *(LAS u32x4*)(Ks + rr * LHB + sg * 16) = pk[i]; }
        { const int fp = tid & 31, vq = tid >> 5; const unsigned a0 = pva.x, a1 = pva.y, b0 = pvb.x, b1 = pvb.y; LAS unsigned char* vt = VT + (4 * vq) * LVB + 4 * fp;
          *(LAS unsigned*)(vt) = (a0 & 0xffffu) | (b0 << 16); *(LAS unsigned*)(vt + LVB) = (a0 >> 16) | (b0 & 0xffff0000u); *(LAS unsigned*)(vt + 2 * LVB) = (a1 & 0xffffu) | (b1 << 16); *(LAS unsigned*)(vt + 3 * LVB) = (a1 >> 16) | (b1 & 0xffff0000u); }
#pragma unroll
        for (int vi = 0; vi < 4; ++vi) { u32x2 w; w.x = cvtpk(smid[vi][0], smid[vi][1]); w.y = cvtpk(smid[vi][2], smid[vi][3]); *(LAS u32x2*)(STs + (16 * vi + li) * LHB + (16 * W + 4 * g) * 2) = w; }
        LBAR();
        if (c + 1 < nchunk) HG_PREFETCH(c + 1);
        {
            const int tt = W & 3, sh = W >> 2;
            f32x4 a[2] = {{0.f, 0.f, 0.f, 0.f}, {0.f, 0.f, 0.f, 0.f}};
#pragma unroll
            for (int kk = 0; kk < 4; ++kk) { const bf16x8 bq = frag(Qs, 16 * tt + li, LHB, 64 * kk + 16 * g);
#pragma unroll
                for (int i = 0; i < 2; ++i) if (2 * sh + i <= tt) a[i] = MFMA16(frag(Ks, 16 * (2 * sh + i) + li, LHB, 64 * kk + 16 * g), bq, a[i]); }
            const int t = 16 * tt + li;
#pragma unroll
            for (int i = 0; i < 2; ++i) { float p[4];
#pragma unroll
                for (int r = 0; r < 4; ++r) { const int s = 16 * (2 * sh + i) + 4 * g + r; p[r] = (s <= t) ? a[i][r] : 0.f; }
                u32x2 w; w.x = cvtpk(p[0], p[1]); w.y = cvtpk(p[2], p[3]); *(LAS u32x2*)(Ps + t * LVB + (16 * (2 * sh + i) + 4 * g) * 2) = w; }
        }
        LBAR();
        {
            const int tt = W & 3, vh = W >> 2;
            f32x4 o[2] = {{0.f, 0.f, 0.f, 0.f}, {0.f, 0.f, 0.f, 0.f}};
#pragma unroll
            for (int kk = 0; kk < 2; ++kk) { const bf16x8 ap = frag(Ps, 16 * tt + li, LVB, 64 * kk + 16 * g);
#pragma unroll
                for (int i = 0; i < 2; ++i) o[i] = MFMA16(ap, frag(VT, 16 * (2 * vh + i) + li, LVB, 64 * kk + 16 * g), o[i]); }
#pragma unroll
            for (int kk = 0; kk < 4; ++kk) { const bf16x8 aq = frag(Qs, 16 * tt + li, LHB, 64 * kk + 16 * g);
#pragma unroll
                for (int i = 0; i < 2; ++i) o[i] = MFMA16(aq, frag(STs, 16 * (2 * vh + i) + li, LHB, 64 * kk + 16 * g), o[i]); }
#pragma unroll
            for (int r = 0; r < 4; ++r) { const int t = 16 * tt + 4 * g + r;
                const unsigned hw = cvtpk(o[0][r], o[1][r]); *(LAS unsigned short*)(Hs + t * LVB + (16 * (2 * vh) + li) * 2) = (unsigned short)(hw & 0xffffu); *(LAS unsigned short*)(Hs + t * LVB + (16 * (2 * vh + 1) + li) * 2) = (unsigned short)(hw >> 16); }
        }
#pragma unroll
        for (int vi = 0; vi < 4; ++vi) sacc[vi] = smid[vi];
#pragma unroll
        for (int kk = 0; kk < 2; ++kk) { const bf16x8 ak = frag_t(Ks, 32 * kk + 8 * g, LHB, 16 * W + li);
#pragma unroll
            for (int vi = 0; vi < 4; ++vi) sacc[vi] = MFMA16(ak, frag(VT, 16 * vi + li, LVB, 64 * kk + 16 * g), sacc[vi]); }
#pragma unroll
        for (int vi = 0; vi < 4; ++vi) sacc[vi] = sacc[vi] * e2;
        LBAR();
        { const int rr = tid >> 3, sg = tid & 7; if (rr < Tv) *(GAS u32x4*)(HB + (size_t)(r0 + rr) * D + 128 * h + 64 * vs + 8 * sg) = *(const LAS u32x4*)(Hs + rr * LVB + sg * 16); }
    }
#undef HG_PREFETCH
#pragma unroll
    for (int vi = 0; vi < 4; ++vi)
#pragma unroll
        for (int r = 0; r < 4; ++r) Sout[(size_t)(16 * W + 4 * g + r) * 128 + 64 * vs + 16 * vi + li] = sacc[vi][r];
}

DI void scan_phase(const Ctx& F, int l) {
    const bf16* Z = (const bf16*)(F.ws + WS_Z);
    const bf16* QA = (const bf16*)(F.ws + WS_QA); const bf16* KA = (const bf16*)(F.ws + WS_KA); const bf16* QB = (const bf16*)(F.ws + WS_QB); const bf16* KB = (const bf16*)(F.ws + WS_KB);
    const float* GP = (const float*)(F.ws + WS_GP); const float* E1 = (const float*)(F.ws + WS_E1); const float* E2 = (const float*)(F.ws + WS_E2);
    bf16* HA = (bf16*)(F.ws + WS_HA); bf16* HB = (bf16*)(F.ws + WS_HB);
    for (int u = F.bid; u < 768; u += F.G) {
        int type, idx, sample;
        if (u < 128) { type = 0; idx = u; sample = 0; } else if (u < 256) { type = 1; idx = u - 128; sample = 0; }
        else if (u < 384) { type = 1; idx = u - 256; sample = 1; } else if (u < 512) { type = 0; idx = u - 384; sample = 1; }
        else if (u < 640) { type = 1; idx = u - 512 + 128; sample = 1; } else { type = 0; idx = u - 640 + 128; sample = 1; }
        if (type == 0) {
            const int b = idx >> 5, h = (idx >> 2) & 7, vs = idx & 3;
            const size_t so = sample ? (size_t)l * NSB + b : (size_t)l * NB + b;
            const float* C0 = sample ? F.in[3] + (so * 8 + h) * 65536 : nullptr; const float* n0 = sample ? F.in[4] + (so * 8 + h) * 256 : nullptr; const float* m0 = sample ? F.in[5] + so * 8 + h : nullptr;
            float* Co = F.out + (sample ? O_CS : O_CP) + (so * 8 + h) * 65536; float* no = F.out + (sample ? O_NS : O_NP) + (so * 8 + h) * 256; float* mo = F.out + (sample ? O_MS : O_MP) + so * 8 + h;
            mlstm_unit(F.lds, QA, KA, Z, GP, HA, sample ? MPR + b * SSEQ : b * SEQ, sample ? 1 : SEQ / 64, sample ? SSEQ : 64, h, vs, C0, n0, m0, Co, no, mo);
        } else {
            const int b = idx >> 5, h = (idx >> 1) & 15, vs = idx & 1;
            const size_t so = sample ? (size_t)l * NSB + b : (size_t)l * NB + b;
            const float* S0 = sample ? F.in[6] + (so * 16 + h) * 16384 : nullptr; float* So = F.out + (sample ? O_SS : O_SP) + (so * 16 + h) * 16384;
            hgrn_unit(F.lds, QB, KB, Z, E1, E2, HB, sample ? MPR + b * SSEQ : b * SEQ, sample ? 1 : SEQ / 64, sample ? SSEQ : 64, h, vs, sample ? NB * 64 + b : b * 64, S0, So);
        }
        __syncthreads();
    }
    if (F.G == 256 && l + 1 < DEPTH && F.bid >= 128) p0_convert_weights(F, l + 1, l + 2, (F.bid - 128) * 8 + F.wave, 128 * 8);
}

constexpr int NPH_LAYER = 10, NPHASES = 1 + DEPTH * NPH_LAYER + 1;
struct Args { const float* in[26]; float* out; unsigned char* ws; int ph_lo, ph_hi; };
static_assert(sizeof(Args) == 26 * 8 + 8 + 8 + 8, "Args has no padding");

__global__ void __launch_bounds__(512, 2) trunk_fwd(Args args) {
    extern __shared__ __attribute__((aligned(16))) unsigned char lds_raw[];
    Ctx F;
    F.lds = (LAS unsigned char*)lds_raw; F.ws = args.ws; F.in = args.in; F.out = args.out;
    F.tid = threadIdx.x; F.lane = F.tid & 63; F.wave = __builtin_amdgcn_readfirstlane(F.tid >> 6); F.G = gridDim.x; F.bid = blockIdx.x;
    volatile LAS unsigned* MISC = (volatile LAS unsigned*)(F.lds + MISC_OFF);
    if (F.tid < 64) MISC[F.tid] = 0u;
    __syncthreads();
    gu32* ctl = (gu32*)(F.ws + WS_CTL);
#if MK_PER_PHASE
#define GRID_BAR() do { } while (0)
#else
    XcdBarrier bar = xcd_barrier_post((unsigned*)(ctl + CW_BAR), MISC + 8);
#define GRID_BAR() xcd_barrier(bar)
#endif
#define LAUNDER() do { unsigned char* w_ = args.ws; float* o_ = args.out; int b_ = blockIdx.x, g_ = gridDim.x; asm volatile("" : "+s"(w_), "+s"(o_), "+s"(b_), "+s"(g_)); F.ws = w_; F.out = o_; F.bid = b_; F.G = g_; } while (0)
    const int lo = args.ph_lo, hi = args.ph_hi;
#ifndef PH_MASK
#define PH_MASK 0xFFFFu
#endif
#define IN(k) (lo <= (k) && (k) < hi)
#define EN(j) ((PH_MASK >> (j)) & 1u)
#ifndef DUP_MASK
#define DUP_MASK 0x0u
#endif
#define DUP(j) ((int)((DUP_MASK >> (j)) & 1u))
#define BOTH(k) (IN(k) && IN((k) + 1))
    if (EN(10) && IN(0)) { for (int rep_ = 0; rep_ <= DUP(10); ++rep_) { LAUNDER(); p0_prologue(F); if (rep_ < DUP(10) || BOTH(0)) GRID_BAR(); } }
    for (int l = 0; l < DEPTH; ++l) {
        const int pb = 1 + NPH_LAYER * l;
        { int t_ = threadIdx.x; asm volatile("" : "+v"(t_)); F.tid = t_; F.lane = t_ & 63; F.wave = __builtin_amdgcn_readfirstlane(t_ >> 6); }
        { unsigned char* w_ = args.ws; float* o_ = args.out; asm volatile("" : "+s"(w_), "+s"(o_)); F.ws = w_; F.out = o_; }
        unsigned char* wl = F.ws + WS_W + (size_t)l * W_LAYER;
        const float* modl = (const float*)(F.ws + WS_MOD) + (size_t)l * 12 * MODW;
        if (EN(0) && IN(pb + 0)) { for (int rep_ = 0; rep_ <= DUP(0); ++rep_) { LAUNDER(); norm_phase(F, F.in[11] + (size_t)l * D, modl, 0, D, l == 0 ? F.in[0] : (const float*)(F.ws + WS_X)); if (rep_ < DUP(0) || BOTH(pb + 0)) GRID_BAR(); } }
        if (EN(1) && IN(pb + 1)) { for (int rep_ = 0; rep_ <= DUP(1); ++rep_) { LAUNDER();
            pg8::Gemm gm{(const pg8::bf16_t*)(F.ws + WS_H), (const pg8::bf16_t*)(wl + W_WIN), MP, NINP, D}; pg8::SplitOrder S; S.init(MPR, NINP, D, 1, F.G, F.bid);
            pg8::EpiZ E{(pg8::bf16_t*)(F.ws + WS_Z), (const float*)(F.ws + WS_BIN) + (size_t)l * NINP, (float*)(F.ws + WS_G)};
            pg8::gemm_phase<pg8::EpiZ, pg8::SplitOrder, true, true>(F.lds + RING_OFF, gm, S, E);
            if (rep_ < DUP(1) || BOTH(pb + 1)) GRID_BAR();
        } }
        if (EN(2) && IN(pb + 2)) { for (int rep_ = 0; rep_ <= DUP(2); ++rep_) { LAUNDER(); prep_phase(F, l); if (rep_ < DUP(2) || BOTH(pb + 2)) GRID_BAR(); } }
        if (EN(3) && IN(pb + 3)) { for (int rep_ = 0; rep_ <= DUP(3); ++rep_) { LAUNDER(); scan_phase(F, l); if (rep_ < DUP(3) || BOTH(pb + 3)) GRID_BAR(); } }
        if (EN(4) && IN(pb + 4)) { for (int rep_ = 0; rep_ <= DUP(4); ++rep_) { LAUNDER(); headnorm_phase(F, l); if (rep_ < DUP(4) || BOTH(pb + 4)) GRID_BAR(); } }
        if (EN(5) && IN(pb + 5)) { for (int rep_ = 0; rep_ <= DUP(5); ++rep_) { LAUNDER();
            { pg8::Gemm gm{(const pg8::bf16_t*)(F.ws + WS_KA), (const pg8::bf16_t*)(wl + W_WBB), MP, D, D}; pg8::SplitOrder S; S.init(MPR, D, D, 1, F.G, F.bid);
              pg8::EpiGateTmp E{(const pg8::bf16_t*)(F.ws + WS_Z) + ZGB, (float*)(F.ws + WS_HA)};
              pg8::gemm_phase<pg8::EpiGateTmp, pg8::SplitOrder, true, true>(F.lds + RING_OFF, gm, S, E); }
            VM_WAIT(); __syncthreads();
            { pg8::Gemm gm{(const pg8::bf16_t*)(F.ws + WS_QA), (const pg8::bf16_t*)(wl + W_WBA), MP, D, D}; pg8::SplitOrder S; S.init(MPR, D, D, 1, F.G, F.bid);
              pg8::EpiMerge E{(const pg8::bf16_t*)(F.ws + WS_Z) + ZGA, (const float*)(F.ws + WS_HA), (pg8::bf16_t*)(F.ws + WS_QB)};
              pg8::gemm_phase<pg8::EpiMerge, pg8::SplitOrder, true, true>(F.lds + RING_OFF, gm, S, E); }
            if (rep_ < DUP(5) || BOTH(pb + 5)) GRID_BAR();
        } }
        if (EN(6) && IN(pb + 6)) { for (int rep_ = 0; rep_ <= DUP(6); ++rep_) { LAUNDER();
            pg8::Gemm gm{(const pg8::bf16_t*)(F.ws + WS_QB), (const pg8::bf16_t*)(wl + W_WO), MP, D, D}; pg8::SplitOrder S; S.init(MPR, D, D, 4, F.G, F.bid);
            pg8::EpiResid E{(float*)(F.ws + (rep_ < DUP(6) ? WS_HB : WS_X)), modl + 2 * D, l == 0 ? F.in[0] : (const float*)(F.ws + WS_X)};
            pg8::gemm_phase<pg8::EpiResid, pg8::SplitOrder, true, true>(F.lds + RING_OFF, gm, S, E);
            if (rep_ < DUP(6) || BOTH(pb + 6)) GRID_BAR();
        } }
        if (EN(7) && IN(pb + 7)) { for (int rep_ = 0; rep_ <= DUP(7); ++rep_) { LAUNDER(); norm_phase(F, F.in[12] + (size_t)l * D, modl, 3 * D, 4 * D, (const float*)(F.ws + WS_X)); if (rep_ < DUP(7) || BOTH(pb + 7)) GRID_BAR(); } }
        if (EN(8) && IN(pb + 8)) { for (int rep_ = 0; rep_ <= DUP(8); ++rep_) { LAUNDER();
            pg8::Gemm gm{(const pg8::bf16_t*)(F.ws + WS_H), (const pg8::bf16_t*)(wl + W_WUP), MP, DFF, D}; pg8::SplitOrder S; S.init(MPR, DFF, D, 1, F.G, F.bid);
            pg8::EpiRelu2 E{(pg8::bf16_t*)(F.ws + WS_Z), DFF};
            pg8::gemm_phase<pg8::EpiRelu2, pg8::SplitOrder, true, true>(F.lds + RING_OFF, gm, S, E);
            if (rep_ < DUP(8) || BOTH(pb + 8)) GRID_BAR();
        } }
        if (EN(9) && IN(pb + 9)) { for (int rep_ = 0; rep_ <= DUP(9); ++rep_) { LAUNDER();
            pg8::Gemm gm{(const pg8::bf16_t*)(F.ws + WS_Z), (const pg8::bf16_t*)(wl + W_WDN), MP, D, DFF}; pg8::SplitOrder S; S.init(MPR, D, DFF, 16, F.G, F.bid, 4);
            pg8::EpiResid E{(float*)(F.ws + (rep_ < DUP(9) ? WS_HB : WS_X)), modl + 5 * D, (const float*)(F.ws + WS_X)};
            pg8::gemm_phase<pg8::EpiResid, pg8::SplitOrder, true, true>(F.lds + RING_OFF, gm, S, E);
            if (rep_ < DUP(9) || BOTH(pb + 9)) GRID_BAR();
        } }
    }
    if (EN(11) && IN(NPHASES - 1)) final_norm_phase(F);
#undef IN
#undef BOTH
}

extern "C" void kernel_launch(void* const* d_in, const int* in_sizes, int n_in, void* d_out, int out_size, void* d_ws, size_t ws_size, hipStream_t stream) {
    static int grid = 0;
    if (grid == 0) {
        if (n_in != 26 || (size_t)out_size != O_END || ws_size < WS_END) { fprintf(stderr, "kernel_launch: shape mismatch: n_in %d out %d (want %zu) ws %zu (want %zu)\n", n_in, out_size, (size_t)O_END, ws_size, (size_t)WS_END); grid = -1; return; }
        int dev = 0, cus = 0, per_cu = 0;
        if (hipGetDevice(&dev) != hipSuccess || hipDeviceGetAttribute(&cus, hipDeviceAttributeMultiprocessorCount, dev) != hipSuccess) { grid = -1; return; }
        if (hipFuncSetAttribute((const void*)trunk_fwd, hipFuncAttributeMaxDynamicSharedMemorySize, LDS_BYTES) != hipSuccess) { fprintf(stderr, "kernel_launch: hipFuncSetAttribute failed\n"); grid = -1; return; }
        if (hipOccupancyMaxActiveBlocksPerMultiprocessor(&per_cu, (const void*)trunk_fwd, 512, LDS_BYTES) != hipSuccess || per_cu < 1) fprintf(stderr, "kernel_launch: occupancy query says %d\n", per_cu);
        (void)hipGetLastError();
        grid = cus;
    }
    if (grid < 0) return;
    (void)in_sizes;
    if (hipMemsetAsync((char*)d_ws + WS_CTL, 0, CTL_ZERO_BYTES, stream) != hipSuccess) { fprintf(stderr, "kernel_launch: memset failed\n"); return; }
    Args a{};
    for (int i = 0; i < 26; ++i) a.in[i] = (const float*)d_in[i];
    a.out = (float*)d_out; a.ws = (unsigned char*)d_ws;
#if MK_PER_PHASE
    for (int p = 0; p < NPHASES; ++p) { a.ph_lo = p; a.ph_hi = p + 1; hipLaunchKernelGGL(trunk_fwd, dim3(grid), dim3(512), LDS_BYTES, stream, a); }
#else
    a.ph_lo = 0; a.ph_hi = NPHASES;
    hipLaunchKernelGGL(trunk_fwd, dim3(grid), dim3(512), LDS_BYTES, stream, a);
#endif
    const hipError_t le = hipPeekAtLastError();
    if (le != hipSuccess) fprintf(stderr, "kernel_launch: launch failed: %s\n", hipGetErrorName(le));
}
```

```cpp
#include <hip/hip_runtime.h>
#include <cstdio>
#include <cstdint>
#ifndef MK_PER_PHASE
#define MK_PER_PHASE 0
#endif
namespace pg8 {
#define PG8_LAS __attribute__((address_space(3)))
typedef unsigned short bf16_t;
typedef short bf16x8 __attribute__((ext_vector_type(8)));
typedef float f32x4 __attribute__((ext_vector_type(4)));
typedef unsigned u32x4 __attribute__((ext_vector_type(4)));
constexpr int BM = 256, BK = 64, HALF = 128, HTB = HALF * BK * 2  , STAGE_BYTES = 8 * HTB, NXCD = 8, WGM = 8;

__host__ __device__ __forceinline__ int lds_byte(int r, int c) { const int st = (r >> 4) * 2 + (c >> 5), rr = r & 15, cc = c & 31, ob = rr * 64 + cc * 2; return st * 1024 + (ob ^ (((ob >> 9) & 1) << 5)); }
__host__ __device__ __forceinline__ void stage_rc(int b, int& R, int& C) { const int st = b / 1024, sb = b % 1024, swz = sb ^ (((sb >> 9) & 1) << 5); R = (st >> 1) * 16 + swz / 64; C = (st & 1) * 32 + (swz % 64) / 2; }
__host__ __device__ __forceinline__ int perm32(int rho) { const int n = rho >> 4, i = rho & 15; return 8 * (i >> 2) + 4 * n + (i & 3); }

struct Unit { int pm, pn, k0, nt, half, narrow; };
struct Gemm { const bf16_t* A; const bf16_t* Bt; int M, N, K; };

struct StaticOrder {
    int nM, nN, nwg, G, c;
    __host__ __device__ void init(int M, int N, int G_, int c_) { nM = M / BM; nN = N / BM; nwg = nM * nN; G = G_; c = c_; }
    __host__ __device__ __forceinline__ bool next(int i, Unit& u) const {
        const long L = (long)i * G + c; if (L >= nwg) return false;
        int wgid = (int)L; { const int q = nwg / NXCD, r = nwg % NXCD, xcd = wgid % NXCD, off = wgid / NXCD; wgid = (xcd < r ? xcd * (q + 1) : r * (q + 1) + (xcd - r) * q) + off; }
        const int nig = WGM * nN, gid = wgid / nig, fm = gid * WGM, gsz = (nM - fm) < WGM ? (nM - fm) : WGM;
        u.pm = fm + ((wgid % nig) % gsz); u.pn = (wgid % nig) / gsz; return true;
    }
    __device__ __forceinline__ void a_ready(const Unit&) const {}
    __device__ __forceinline__ void done(const Unit&) const {}
};

struct SplitOrder {
    int nM, nN, nwg, G, c, S, ntK, wgm, npn;
    __device__ __forceinline__ void init(int Mfull, int N, int K, int S_, int G_, int c_, int wgm_ = 4) { nM = Mfull / BM; nN = N / BM; nwg = nM * nN; G = G_; c = c_; S = S_; ntK = K / BK; wgm = wgm_; npn = -1; }
    __device__ __forceinline__ bool next(int i, Unit& u) const {
        const long L = (long)i * G + c; const bool full = L < nwg; const int j = full ? 0 : (int)(L - nwg);
        if (!full && j >= nN * S) return false;
        int wgid = full ? (int)L : 0; { const int q = nwg / NXCD, r = nwg % NXCD, xcd = wgid % NXCD, off = wgid / NXCD; wgid = (xcd < r ? xcd * (q + 1) : r * (q + 1) + (xcd - r) * q) + off; }
        const int nig = wgm * nN, gid = wgid / nig, fm = gid * wgm, gsz = (nM - fm) < wgm ? (nM - fm) : wgm;
        const int pm_f = fm + ((wgid % nig) % gsz), pn_f = (wgid % nig) / gsz;
        const int nts = ntK / S;
        const int pm = full ? pm_f : nM, pn = full ? pn_f : (j % nN), k0 = full ? 0 : (j / nN) * nts, nt = full ? ntK : nts, half = full ? 0 : 1;
        u = Unit{pm, pn, k0, nt, half, pn == npn ? 1 : 0}; return true;
    }
    __device__ __forceinline__ void a_ready(const Unit&) const {}
    __device__ __forceinline__ void done(const Unit&) const {}
};

__device__ __forceinline__ unsigned cvt_pk_bf16(float lo, float hi) { unsigned r; asm volatile("v_cvt_pk_bf16_f32 %0, %1, %2" : "=v"(r) : "v"(lo), "v"(hi)); return r; }
typedef float f32x2 __attribute__((ext_vector_type(2)));
template <class Epi, class Sched, bool ALIGN_EPI = false, bool SP2 = false>
__device__ __forceinline__ void gemm_phase(PG8_LAS unsigned char* lds, const Gemm g, const Sched& S, const Epi& E) {
    int tid_ = threadIdx.x; asm volatile("" : "+v"(tid_));
    const int tid = tid_, wid = __builtin_amdgcn_readfirstlane(tid >> 6), lane = tid & 63, wr = wid >> 2, wc = wid & 3, fr = lane & 15, fq = lane >> 4;
    const int K = g.K;
    unsigned voffA[2], voffB[2];
#pragma unroll
    for (int i = 0; i < 2; ++i) { int R, C; stage_rc(tid * 16 + i * 8192, R, C); const int Rb = Epi::PERM ? ((R & ~31) + perm32(R & 31)) : R;
        voffA[i] = (unsigned)(R * K + C) * 2u; voffB[i] = (unsigned)(Rb * K + C) * 2u; }
    const size_t kstep = (size_t)(BK * 2);
    const size_t hstep = (size_t)HALF * K * 2;
    const size_t tstep = 2 * hstep;
    const unsigned ldsw = (unsigned)wid * 1024u;
    const int aoff = lds_byte(wr * 64 + fr, fq * 8), boff = lds_byte(wc * 32 + fr, fq * 8);
#define PG8_SA(b, h) (((b) * 2 + (h)) * HTB)
#define PG8_SB(b, h) ((4 + (b) * 2 + (h)) * HTB)
#define PG8_STAGE(bufoff, gbase, voff) do { _Pragma("unroll") for (int _i = 0; _i < 2; ++_i) \
        __builtin_amdgcn_global_load_lds((const unsigned*)((const char*)(gbase) + (voff)[_i]), (PG8_LAS unsigned*)(lds + (bufoff) + ldsw + _i * 8192), 16, 0, 0); } while (0)
#define PG8_LDA(dst, b, h) do { _Pragma("unroll") for (int m = 0; m < 4; ++m) _Pragma("unroll") for (int k = 0; k < 2; ++k) dst[m][k] = *(const PG8_LAS bf16x8*)(lds + PG8_SA(b, h) + aoff + m * 2048 + k * 1024); } while (0)
#define PG8_LDB(dst, b, h) do { _Pragma("unroll") for (int n = 0; n < 2; ++n) _Pragma("unroll") for (int k = 0; k < 2; ++k) dst[n][k] = *(const PG8_LAS bf16x8*)(lds + PG8_SB(b, h) + boff + n * 2048 + k * 1024); } while (0)
#define PG8_MMA(ai, bj, At, Bt) do { __builtin_amdgcn_s_setprio(1); _Pragma("unroll") for (int m = 0; m < 4; ++m) _Pragma("unroll") for (int n = 0; n < 2; ++n) _Pragma("unroll") for (int k = 0; k < 2; ++k) \
        acc[ai][bj][m][n] = __builtin_amdgcn_mfma_f32_16x16x32_bf16(Bt[n][k], At[m][k], acc[ai][bj][m][n], 0, 0, 0); __builtin_amdgcn_s_setprio(0); } while (0)
#define PG8_WAIT_V(n) asm volatile("s_waitcnt vmcnt(" #n ")" ::: "memory")
#define PG8_WAIT_L(n) asm volatile("s_waitcnt lgkmcnt(" #n ")" ::: "memory")
#define PG8_BAR __builtin_amdgcn_s_barrier()
#define PG8_SCHED __builtin_amdgcn_sched_barrier(0)
    Unit cur, nxt; int ui = 0;
    if (!S.next(0, cur)) return;
    f32x4 acc[2][2][4][2];
#pragma unroll
    for (int a = 0; a < 2; ++a)
#pragma unroll
        for (int b = 0; b < 2; ++b)
#pragma unroll
            for (int m = 0; m < 4; ++m)
#pragma unroll
                for (int n = 0; n < 2; ++n) acc[a][b][m][n] = (f32x4){0.f, 0.f, 0.f, 0.f};
    bf16x8 At[4][2], B0[2][2], B1[2][2];
    const char* cA = (const char*)g.A + (size_t)cur.pm * tstep + (size_t)cur.k0 * kstep; const char* cB = (const char*)g.Bt + (size_t)cur.pn * tstep + (size_t)cur.k0 * kstep;
    S.a_ready(cur);
    if constexpr (SP2) {
        PG8_STAGE(PG8_SB(0, 0), cB, voffB); PG8_STAGE(PG8_SB(0, 1), cB + hstep, voffB); PG8_STAGE(PG8_SA(0, 0), cA, voffA); PG8_STAGE(PG8_SA(0, 1), cA + hstep, voffA);
        if (wr == 1) PG8_BAR;
        PG8_WAIT_V(2); PG8_BAR;
        PG8_STAGE(PG8_SB(1, 0), cB + kstep, voffB); PG8_STAGE(PG8_SA(1, 0), cA + kstep, voffA); PG8_STAGE(PG8_SB(1, 1), cB + hstep + kstep, voffB);
        PG8_WAIT_V(6); PG8_BAR;
    } else {
        PG8_STAGE(PG8_SB(0, 0), cB, voffB); PG8_STAGE(PG8_SA(0, 0), cA, voffA); PG8_STAGE(PG8_SB(0, 1), cB + hstep, voffB); PG8_STAGE(PG8_SA(0, 1), cA + hstep, voffA);
        if (wr == 1) PG8_BAR;
        PG8_WAIT_V(4); PG8_BAR;
        PG8_STAGE(PG8_SB(1, 0), cB + kstep, voffB); PG8_STAGE(PG8_SA(1, 0), cA + kstep, voffA); PG8_STAGE(PG8_SB(1, 1), cB + hstep + kstep, voffB);
        PG8_WAIT_V(6); PG8_BAR;
    }
    for (;;) {
        const bool has_next = S.next(ui + 1, nxt);
        const char* nA = has_next ? (const char*)g.A + (size_t)nxt.pm * tstep + (size_t)nxt.k0 * kstep : cA; const char* nB = has_next ? (const char*)g.Bt + (size_t)nxt.pn * tstep + (size_t)nxt.k0 * kstep : cB;
        const int nt = cur.nt;
#ifdef PROBE_KTWICE
        _Pragma("nounroll") for (int pass_ = 0; pass_ < 2; ++pass_) { const char* nA_ = pass_ == 0 ? cA : nA; const char* nB_ = pass_ == 0 ? cB : nB;
#else
        { const char* nA_ = nA; const char* nB_ = nB;
#endif
        for (int t = 0; t < nt; t += 2) {
            const bool last = (t == nt - 2);
            const char* a1 = cA + (size_t)(t + 1) * kstep;
            const char* a2 = last ? nA_ : cA + (size_t)(t + 2) * kstep; const char* b2 = last ? nB_ : cB + (size_t)(t + 2) * kstep;
            const char* a3 = a2 + kstep; const char* b3 = b2 + kstep;
            if (last && has_next) S.a_ready(nxt);
            if constexpr (SP2) {
            PG8_LDB(B0, 0, 0); PG8_LDB(B1, 0, 1); PG8_SCHED; PG8_LDA(At, 0, 0); PG8_STAGE(PG8_SA(1, 1), a1 + hstep, voffA);
            PG8_WAIT_V(8); PG8_WAIT_L(0); PG8_BAR; PG8_MMA(0, 0, At, B0); PG8_MMA(0, 1, At, B1); PG8_BAR; PG8_SCHED;
            PG8_LDA(At, 0, 1); PG8_STAGE(PG8_SB(0, 0), b2, voffB); PG8_STAGE(PG8_SB(0, 1), b2 + hstep, voffB); PG8_STAGE(PG8_SA(0, 0), a2, voffA);
            PG8_WAIT_V(8); PG8_WAIT_L(0); PG8_BAR; PG8_MMA(1, 0, At, B0); PG8_MMA(1, 1, At, B1); PG8_BAR; PG8_SCHED;
            PG8_LDB(B0, 1, 0); PG8_LDB(B1, 1, 1); PG8_SCHED; PG8_LDA(At, 1, 0); PG8_STAGE(PG8_SA(0, 1), a2 + hstep, voffA);
            PG8_WAIT_V(8); PG8_WAIT_L(0); PG8_BAR; PG8_MMA(0, 0, At, B0); PG8_MMA(0, 1, At, B1); PG8_BAR; PG8_SCHED;
            PG8_LDA(At, 1, 1); PG8_STAGE(PG8_SB(1, 0), b3, voffB); PG8_STAGE(PG8_SB(1, 1), b3 + hstep, voffB); PG8_STAGE(PG8_SA(1, 0), a3, voffA);
            PG8_WAIT_V(8); PG8_WAIT_L(0); PG8_BAR; PG8_MMA(1, 0, At, B0); PG8_MMA(1, 1, At, B1); PG8_BAR; PG8_SCHED;
            } else {
            PG8_LDB(B0, 0, 0); PG8_SCHED; PG8_LDA(At, 0, 0); PG8_STAGE(PG8_SA(1, 1), a1 + hstep, voffA);
            PG8_WAIT_L(8); PG8_BAR; PG8_WAIT_L(0); PG8_MMA(0, 0, At, B0); PG8_BAR; PG8_SCHED;
            PG8_LDB(B1, 0, 1); PG8_STAGE(PG8_SB(0, 0), b2, voffB);
            PG8_BAR; PG8_WAIT_L(0); PG8_MMA(0, 1, At, B1); PG8_BAR;
            PG8_LDA(At, 0, 1); PG8_STAGE(PG8_SA(0, 0), a2, voffA);
            PG8_BAR; PG8_WAIT_L(0); PG8_MMA(1, 0, At, B0); PG8_BAR; PG8_SCHED;
            PG8_STAGE(PG8_SB(0, 1), b2 + hstep, voffB);
            PG8_WAIT_V(6); PG8_BAR; PG8_MMA(1, 1, At, B1); PG8_BAR;
            PG8_LDB(B0, 1, 0); PG8_SCHED; PG8_LDA(At, 1, 0); PG8_STAGE(PG8_SA(0, 1), a2 + hstep, voffA);
            PG8_WAIT_L(8); PG8_BAR; PG8_WAIT_L(0); PG8_MMA(0, 0, At, B0); PG8_BAR; PG8_SCHED;
            PG8_LDB(B1, 1, 1); PG8_STAGE(PG8_SB(1, 0), b3, voffB);
            PG8_BAR; PG8_WAIT_L(0); PG8_MMA(0, 1, At, B1); PG8_BAR;
            PG8_LDA(At, 1, 1); PG8_STAGE(PG8_SA(1, 0), a3, voffA);
            PG8_BAR; PG8_WAIT_L(0); PG8_MMA(1, 0, At, B0); PG8_BAR; PG8_SCHED;
            PG8_STAGE(PG8_SB(1, 1), b3 + hstep, voffB);
            PG8_WAIT_V(6); PG8_BAR; PG8_MMA(1, 1, At, B1); PG8_BAR;
            }
        }
        }
#ifdef PROBE_KTWICE
        _Pragma("unroll") for (int a_ = 0; a_ < 2; ++a_) _Pragma("unroll") for (int b_ = 0; b_ < 2; ++b_) _Pragma("unroll") for (int m_ = 0; m_ < 4; ++m_) _Pragma("unroll") for (int n_ = 0; n_ < 2; ++n_) acc[a_][b_][m_][n_] = acc[a_][b_][m_][n_] * 0.5f;
#endif
        if constexpr (ALIGN_EPI) { if (wr == 0) PG8_BAR; }
        if constexpr (!Epi::AFTER_DRAIN) { E(acc, cur, wr, wc, fr, fq);
#ifdef PROBE_EPI_TWICE
            if constexpr (Epi::IDEMPOTENT) { asm volatile("" ::: "memory"); E(acc, cur, wr, wc, fr, fq); }
#endif
            S.done(cur); }
        if (!has_next) break;
#pragma unroll
        for (int a = 0; a < 2; ++a)
#pragma unroll
            for (int b = 0; b < 2; ++b)
#pragma unroll
                for (int m = 0; m < 4; ++m)
#pragma unroll
                    for (int n = 0; n < 2; ++n) acc[a][b][m][n] = (f32x4){0.f, 0.f, 0.f, 0.f};
        cur = nxt; cA = nA; cB = nB; ++ui;
        if constexpr (ALIGN_EPI) { if (wr == 1) PG8_BAR; }
    }
    PG8_WAIT_V(0);
    if constexpr (!ALIGN_EPI) { if (wr == 0) PG8_BAR; }
    PG8_BAR;
    if constexpr (Epi::AFTER_DRAIN) { E.fused(acc, cur, wr, wc, fr, fq, lds, wid, lane); S.done(cur); }
#undef PG8_SA
#undef PG8_SB
#undef PG8_STAGE
#undef PG8_LDA
#undef PG8_LDB
#undef PG8_MMA
#undef PG8_WAIT_V
#undef PG8_WAIT_L
#undef PG8_BAR
#undef PG8_SCHED
}
}

constexpr int D = 2048, NB = 4, SEQ = 4096, DEPTH = 4, NSB = 8, SSEQ = 16;
constexpr int MPR = NB * SEQ;
constexpr int MS = NSB * SSEQ;
constexpr int M = MPR + MS;
constexpr int MP = 16640;
constexpr int NIN = 20496, NINP = 20736;
constexpr int DFF = 8192;
constexpr int ZQK = 0, ZVA = 4096, ZOA = 6144, ZQB = 8192, ZFB = 10240, ZIB = 12288, ZOGB = 14336, ZGA = 16384, ZGB = 18432, ZGT = 20480;
constexpr int MODW = 6 * D;
constexpr float EPS = 1e-6f;
constexpr int NCHUNKS = NB * (SEQ / 64) + NSB;

__device__ __forceinline__ int row_batch(int r) { int b = r < MPR ? (r >> 12) : 4 + ((r - MPR) >> 4); return b > 11 ? 11 : b; }
__device__ __forceinline__ float bf2f(unsigned short b) { return __uint_as_float(((unsigned)b) << 16); }
__device__ __forceinline__ float sigm(float x) { return __builtin_amdgcn_rcpf(1.0f + __expf(-x)); }

namespace pg8 {
__device__ __forceinline__ void unpack8(const u32x4 w, float (&f)[8]) {
    f[0] = __uint_as_float(w.x << 16); f[1] = __uint_as_float(w.x & 0xffff0000u); f[2] = __uint_as_float(w.y << 16); f[3] = __uint_as_float(w.y & 0xffff0000u);
    f[4] = __uint_as_float(w.z << 16); f[5] = __uint_as_float(w.z & 0xffff0000u); f[6] = __uint_as_float(w.w << 16); f[7] = __uint_as_float(w.w & 0xffff0000u);
}
struct EpiZ {
    static constexpr bool PERM = true, AFTER_DRAIN = false, IDEMPOTENT = true;
    bf16_t* Z; const float* bias; float* G;
    __device__ __forceinline__ void operator()(const f32x4 (&acc)[2][2][4][2], const Unit& u, int wr, int wc, int fr, int fq) const {
        const int row0 = u.pm * BM + wr * 64 + fr, col0 = u.pn * BM + wc * 32 + 8 * fq;
        const bool gates = (u.pn == 80) && (wc == 0) && (fq < 2);
        const f32x4 bb[2][2] = {{*(const f32x4*)(bias + col0), *(const f32x4*)(bias + col0 + 4)}, {*(const f32x4*)(bias + col0 + HALF), *(const f32x4*)(bias + col0 + HALF + 4)}};
#pragma unroll
        for (int bj = 0; bj < 2; ++bj) {
            const f32x4 b0 = bb[bj][0], b1 = bb[bj][1];
#pragma unroll
            for (int ai = 0; ai < 2; ++ai)
#pragma unroll
                for (int m = 0; m < 4; ++m) { const int row = row0 + ai * HALF + m * 16; bf16_t* rowp = Z + (size_t)row * NINP + col0;
                    const f32x4 v0 = acc[ai][bj][m][0] + b0, v1 = acc[ai][bj][m][1] + b1;
                    u32x4 w; w.x = cvt_pk_bf16(v0[0], v0[1]); w.y = cvt_pk_bf16(v0[2], v0[3]); w.z = cvt_pk_bf16(v1[0], v1[1]); w.w = cvt_pk_bf16(v1[2], v1[3]);
                    *(u32x4*)(rowp + bj * HALF) = w;
                    if (bj == 0 && gates) { float* gp = G + (size_t)row * 16 + 8 * fq; *(f32x4*)gp = v0; *(f32x4*)(gp + 4) = v1; } }
        }
    }
};
struct EpiGateTmp {
    static constexpr bool PERM = true, AFTER_DRAIN = false, IDEMPOTENT = false;
    const bf16_t* Zg; bf16_t* T;
    __device__ __forceinline__ void operator()(const f32x4 (&acc)[2][2][4][2], const Unit& u, int wr, int wc, int fr, int fq) const {
        const int row0 = u.pm * BM + wr * 64 + fr, col0 = u.pn * BM + wc * 32 + 8 * fq;
#pragma unroll
        for (int ai = 0; ai < 2; ++ai) {
            u32x4 gz[4][2];
#pragma unroll
            for (int m = 0; m < 4; ++m)
#pragma unroll
                for (int bj = 0; bj < 2; ++bj) gz[m][bj] = *(const u32x4*)(Zg + (size_t)(row0 + ai * HALF + m * 16) * NINP + col0 + bj * HALF);
#pragma unroll
            for (int m = 0; m < 4; ++m) { const int row = row0 + ai * HALF + m * 16;
#pragma unroll
                for (int bj = 0; bj < 2; ++bj) { const int c = col0 + bj * HALF; float gf[8]; unpack8(gz[m][bj], gf);
                    f32x4 v0 = acc[ai][bj][m][0], v1 = acc[ai][bj][m][1];
#pragma unroll
                    for (int j = 0; j < 4; ++j) { v0[j] *= sigm(gf[j]); v1[j] *= sigm(gf[4 + j]); }
                    u32x4 w; w.x = cvt_pk_bf16(v0[0], v0[1]); w.y = cvt_pk_bf16(v0[2], v0[3]); w.z = cvt_pk_bf16(v1[0], v1[1]); w.w = cvt_pk_bf16(v1[2], v1[3]);
                    *(u32x4*)(T + (size_t)row * D + c) = w; } }
            asm volatile("" ::: "memory");
        }
    }
};
struct EpiMerge {
    static constexpr bool PERM = true, AFTER_DRAIN = false, IDEMPOTENT = false;
    const bf16_t* Zg; const bf16_t* T; bf16_t* O;
    __device__ __forceinline__ void operator()(const f32x4 (&acc)[2][2][4][2], const Unit& u, int wr, int wc, int fr, int fq) const {
        const int row0 = u.pm * BM + wr * 64 + fr, col0 = u.pn * BM + wc * 32 + 8 * fq;
#pragma unroll
        for (int ai = 0; ai < 2; ++ai)
#pragma unroll
            for (int mp = 0; mp < 2; ++mp) {
                u32x4 gz[2][2], tz[2][2];
#pragma unroll
                for (int mm = 0; mm < 2; ++mm)
#pragma unroll
                    for (int bj = 0; bj < 2; ++bj) { const int row = row0 + ai * HALF + (2 * mp + mm) * 16, c = col0 + bj * HALF; gz[mm][bj] = *(const u32x4*)(Zg + (size_t)row * NINP + c);
                        tz[mm][bj] = *(const u32x4*)(T + (size_t)row * D + c); }
#pragma unroll
                for (int mm = 0; mm < 2; ++mm)
#pragma unroll
                    for (int bj = 0; bj < 2; ++bj) { const int m = 2 * mp + mm, row = row0 + ai * HALF + m * 16, c = col0 + bj * HALF; float gf[8]; unpack8(gz[mm][bj], gf);
                        float tf[8]; unpack8(tz[mm][bj], tf); f32x4 v0, v1;
#pragma unroll
                        for (int j = 0; j < 4; ++j) { v0[j] = tf[j] + acc[ai][bj][m][0][j] * sigm(gf[j]); v1[j] = tf[4 + j] + acc[ai][bj][m][1][j] * sigm(gf[4 + j]); }
                        u32x4 w; w.x = cvt_pk_bf16(v0[0], v0[1]); w.y = cvt_pk_bf16(v0[2], v0[3]); w.z = cvt_pk_bf16(v1[0], v1[1]); w.w = cvt_pk_bf16(v1[2], v1[3]);
                        *(u32x4*)(O + (size_t)row * D + c) = w; }
                asm volatile("" ::: "memory");
            }
    }
};
struct EpiResid {
    static constexpr bool PERM = false, AFTER_DRAIN = false, IDEMPOTENT = false;
    float* X; const float* gate; const float* Xsrc;
    __device__ __forceinline__ void operator()(const f32x4 (&acc)[2][2][4][2], const Unit& u, int wr, int wc, int fr, int fq) const {
        const int row0 = u.pm * BM + wr * 64 + fr, col0 = u.pn * BM + wc * 32 + 4 * fq;
        if (!u.half) {
            const float* gp = gate + (size_t)row_batch(u.pm * BM) * MODW + col0;
            const f32x4 gv[2][2] = {{*(const f32x4*)gp, *(const f32x4*)(gp + 16)}, {*(const f32x4*)(gp + HALF), *(const f32x4*)(gp + HALF + 16)}};
#pragma unroll
            for (int ai = 0; ai < 2; ++ai) {
                f32x4 xv[4][2][2];
#pragma unroll
                for (int m = 0; m < 4; ++m)
#pragma unroll
                    for (int bj = 0; bj < 2; ++bj)
#pragma unroll
                        for (int n = 0; n < 2; ++n) xv[m][bj][n] = *(const f32x4*)(Xsrc + (size_t)(row0 + ai * HALF + m * 16) * D + col0 + bj * HALF + n * 16);
#pragma unroll
                for (int m = 0; m < 4; ++m)
#pragma unroll
                    for (int bj = 0; bj < 2; ++bj)
#pragma unroll
                        for (int n = 0; n < 2; ++n) *(f32x4*)(X + (size_t)(row0 + ai * HALF + m * 16) * D + col0 + bj * HALF + n * 16) = xv[m][bj][n] + gv[bj][n] * acc[ai][bj][m][n];
                asm volatile("" ::: "memory");
            }
        } else {
#pragma unroll
            for (int m = 0; m < 4; ++m) { const int row = row0 + m * 16; const float* gp = gate + (size_t)row_batch(row) * MODW + col0; float* xp = X + (size_t)row * D + col0;
#pragma unroll
                for (int bj = 0; bj < 2; ++bj)
#pragma unroll
                    for (int n = 0; n < 2; ++n) { const int o = bj * HALF + n * 16; const f32x4 d = *(const f32x4*)(gp + o) * acc[0][bj][m][n];
#pragma unroll
                        for (int e = 0; e < 4; ++e) __hip_atomic_fetch_add(xp + o + e, d[e], __ATOMIC_RELAXED, __HIP_MEMORY_SCOPE_AGENT); } }
        }
    }
};
struct EpiRelu2 {
    static constexpr bool PERM = true, AFTER_DRAIN = false, IDEMPOTENT = true;
    bf16_t* O; int ldc;
    __device__ __forceinline__ void operator()(const f32x4 (&acc)[2][2][4][2], const Unit& u, int wr, int wc, int fr, int fq) const {
        const int row0 = u.pm * BM + wr * 64 + fr, col0 = u.pn * BM + wc * 32 + 8 * fq;
#pragma unroll
        for (int ai = 0; ai < 2; ++ai)
#pragma unroll
            for (int m = 0; m < 4; ++m) { bf16_t* rowp = O + (size_t)(row0 + ai * HALF + m * 16) * ldc + col0;
#pragma unroll
                for (int bj = 0; bj < 2; ++bj) { f32x4 v0 = acc[ai][bj][m][0], v1 = acc[ai][bj][m][1];
#pragma unroll
                    for (int j = 0; j < 4; ++j) { const float a = fmaxf(v0[j], 0.f), b = fmaxf(v1[j], 0.f); v0[j] = a * a; v1[j] = b * b; }
                    u32x4 w; w.x = cvt_pk_bf16(v0[0], v0[1]); w.y = cvt_pk_bf16(v0[2], v0[3]); w.z = cvt_pk_bf16(v1[0], v1[1]); w.w = cvt_pk_bf16(v1[2], v1[3]);
                    *(u32x4*)(rowp + bj * HALF) = w; } }
    }
};
}

constexpr size_t MiB = 1u << 20;
constexpr size_t WS_CTL = 0, CTL_ZERO_BYTES = 1 * MiB;
constexpr size_t WS_MOD = 1 * MiB;
constexpr size_t WS_LB = 4 * MiB;
constexpr size_t WS_BIN = 4 * MiB + 65536;
constexpr size_t WS_E1 = 5 * MiB, WS_E2 = 8 * MiB;
constexpr size_t WS_G = 11 * MiB;
constexpr size_t WS_W = 16 * MiB;
constexpr size_t W_WIN = 0, W_WBA = 81 * MiB, W_WBB = 89 * MiB, W_WO = 97 * MiB, W_WUP = 105 * MiB, W_WDN = 137 * MiB, W_LAYER = 169 * MiB;
constexpr size_t WS_X = 692 * MiB;
constexpr size_t WS_H = 822 * MiB;
constexpr size_t WS_Z = 887 * MiB;
constexpr size_t WS_QA = 1546 * MiB;
constexpr size_t WS_KA = 1611 * MiB;
constexpr size_t WS_QB = 1676 * MiB;
constexpr size_t WS_KB = 1741 * MiB;
constexpr size_t WS_HA = 1806 * MiB;
constexpr size_t WS_HB = 1936 * MiB;
constexpr size_t WS_GP = 2066 * MiB;
constexpr size_t WS_END = 2072 * MiB;
static_assert((size_t)NINP * D * 2 <= 81 * MiB && (size_t)MP * NINP * 2 <= (WS_QA - WS_Z) && (size_t)MP * D * 2 == 65 * MiB && WS_W + 4 * W_LAYER <= WS_X, "ws map");
constexpr int CW_BAR = 4096;

constexpr size_t O_YP = 0, O_YS = O_YP + (size_t)MPR * D, O_CONVP = O_YS + (size_t)MS * D, O_CP = O_CONVP + (size_t)DEPTH * NB * 3 * 4096,
    O_NP = O_CP + (size_t)DEPTH * NB * 8 * 65536, O_MP = O_NP + (size_t)DEPTH * NB * 8 * 256, O_SP = O_MP + (size_t)DEPTH * NB * 8,
    O_CONVS = O_SP + (size_t)DEPTH * NB * 16 * 16384, O_CS = O_CONVS + (size_t)DEPTH * NSB * 3 * 4096, O_NS = O_CS + (size_t)DEPTH * NSB * 8 * 65536,
    O_MS = O_NS + (size_t)DEPTH * NSB * 8 * 256, O_SS = O_MS + (size_t)DEPTH * NSB * 8, O_END = O_SS + (size_t)DEPTH * NSB * 16 * 16384;

constexpr int RING_OFF = 0, RING_BYTES = 131072;
constexpr int LDS_BYTES = 155648;
constexpr int MISC_OFF = LDS_BYTES - 256;
constexpr int SC_Q = 0, SC_K = 33792, SC_VT = 67584, SC_VW = 79104, SC_CT = 90624, SC_P = 132864, SC_H = 142080, SC_END = 151296;
constexpr int LQB = 528;
constexpr int LVB = 144;
constexpr int HS_Q = 0, HS_K = 17408, HS_VT = 34816, HS_ST = 44032, HS_P = 61440, HS_H = 70656;
constexpr int LHB = 272;
static_assert(SC_END <= MISC_OFF, "LDS map");

#define GAS __attribute__((address_space(1)))
#define LAS __attribute__((address_space(3)))
#define DI __device__ __forceinline__
typedef unsigned short bf16;
typedef float f32x4 __attribute__((ext_vector_type(4)));
typedef unsigned u32x2 __attribute__((ext_vector_type(2)));
typedef unsigned u32x4 __attribute__((ext_vector_type(4)));
typedef short bf16x8 __attribute__((ext_vector_type(8)));
typedef GAS unsigned gu32;
#define RLX_AGENT __ATOMIC_RELAXED, __HIP_MEMORY_SCOPE_AGENT
#define LDS_WAIT() asm volatile("s_waitcnt lgkmcnt(0)" ::: "memory")
#define VM_WAIT() asm volatile("s_waitcnt vmcnt(0)" ::: "memory")
DI unsigned f2bf(float f) { unsigned u = __float_as_uint(f); return (u + 0x7fffu + ((u >> 16) & 1u)) >> 16; }
DI unsigned pk2(float lo, float hi) { return f2bf(lo) | (f2bf(hi) << 16); }
DI float wave_sum(float v) {
#pragma unroll
    for (int o = 1; o < 64; o <<= 1) v += __shfl_xor(v, o);
    return v;
}
#define LBAR() do { asm volatile("s_waitcnt lgkmcnt(0)" ::: "memory"); __builtin_amdgcn_s_barrier(); asm volatile("" ::: "memory"); } while (0)
DI unsigned cvtpk(float lo, float hi) { unsigned r; asm volatile("v_cvt_pk_bf16_f32 %0, %1, %2" : "=v"(r) : "v"(lo), "v"(hi)); return r; }
DI float logsig(float x) { return fminf(x, 0.f) - __logf(1.0f + __expf(-fabsf(x))); }
#define XB_TMO      128
#define XB_XCNT(j)  (256  + 64 * (j))
#define XB_XSUB(j)  (1280 + 64 * (j))
#define XB_XGEN(j)  (2304 + 64 * (j))
#define XB_TOP      3328
#define XB_TOPGEN   3392
#define XCD_BAR_WORDS 3456
#define XB_SPIN_CAP (1u << 18)

__device__ __forceinline__ unsigned xb_ld(unsigned* p)              { return __hip_atomic_load(p, __ATOMIC_RELAXED, __HIP_MEMORY_SCOPE_AGENT); }
__device__ __forceinline__ unsigned xb_add(unsigned* p, unsigned v) { return __hip_atomic_fetch_add(p, v, __ATOMIC_RELAXED, __HIP_MEMORY_SCOPE_AGENT); }
__device__ __forceinline__ unsigned xb_xcc_id() { return (unsigned)__builtin_amdgcn_s_getreg((3 << 11) | 20) & 0xFu; }
#define XB_SPIN(cond, bar) do { unsigned _sp = 0; while (cond) { __builtin_amdgcn_s_sleep(1); \
    if ((++_sp & 255u) == 0u) { if (xb_ld(&(bar)[XB_TMO])) break; if (_sp > XB_SPIN_CAP) { atomicAdd(&(bar)[XB_TMO], 1u); break; } } } } while (0)

__device__ __forceinline__ bool xb_tid0() { int t = threadIdx.x; asm volatile("" : "+v"(t)); return t == 0; }
struct XcdBarrier {
    unsigned* bar; unsigned x;
    volatile LAS unsigned* st;
};

__device__ __forceinline__ XcdBarrier xcd_barrier_post(unsigned* bar, volatile LAS unsigned* st) {
    XcdBarrier b; b.bar = bar; b.x = xb_xcc_id(); b.st = st;
    if (xb_tid0()) (void)xb_add(&bar[XB_XCNT(b.x)], 1u);
    return b;
}
__device__ __forceinline__ void xcd_barrier_complete(unsigned* bar, unsigned x, unsigned& nloc, unsigned& nx) {
    const unsigned G = gridDim.x * gridDim.y * gridDim.z;
    unsigned sum, cnt, mine, sp = 0u;
    for (;;) {
        sum = 0u; cnt = 0u; mine = 0u;
#pragma unroll
        for (unsigned j = 0; j < 16; ++j) { const unsigned c = xb_ld(&bar[XB_XCNT(j)]); sum += c; cnt += (c > 0u) ? 1u : 0u; mine = (j == x) ? c : mine; }
        if (sum == G) break;
        __builtin_amdgcn_s_sleep(1);
        if ((++sp & 255u) == 0u) { if (xb_ld(&bar[XB_TMO])) break; if (sp > XB_SPIN_CAP) { atomicAdd(&bar[XB_TMO], 1u); break; } }
    }
    nloc = mine > 0u ? mine : 1u; nx = cnt > 0u ? cnt : 1u;
}

__device__ __forceinline__ void xcd_barrier(const XcdBarrier& b) {
    asm volatile("s_waitcnt vmcnt(0)" ::: "memory");
    __syncthreads();
    if (xb_tid0()) {
        unsigned* bar = b.bar;
        __builtin_amdgcn_s_waitcnt(0);
        unsigned nloc = b.st[0], nx = b.st[1];
        if (nloc == 0u) { xcd_barrier_complete(bar, b.x, nloc, nx); b.st[0] = nloc; b.st[1] = nx; }
        const unsigned old = xb_add(&bar[XB_XSUB(b.x)], 1u);
        const unsigned gen = old / nloc;
        if (old + 1u == (gen + 1u) * nloc) {
            __builtin_amdgcn_fence(__ATOMIC_RELEASE, "agent");
            asm volatile("s_waitcnt vmcnt(0)" ::: "memory");
            const unsigned og = xb_add(&bar[XB_TOP], 1u);
            const unsigned tg = og / nx;
            if (og + 1u == (tg + 1u) * nx) xb_add(&bar[XB_TOPGEN], 1u);
            else XB_SPIN(xb_ld(&bar[XB_TOPGEN]) == tg, bar);
            __builtin_amdgcn_fence(__ATOMIC_ACQUIRE, "agent");
            xb_add(&bar[XB_XGEN(b.x)], 1u);
            asm volatile("s_waitcnt vmcnt(0)" ::: "memory");
        } else {
            XB_SPIN(xb_ld(&bar[XB_XGEN(b.x)]) == gen, bar);
            __builtin_amdgcn_fence(__ATOMIC_ACQUIRE, "agent");
            asm volatile("s_waitcnt vmcnt(0)" ::: "memory");
        }
    }
    __syncthreads();
}

struct Ctx { LAS unsigned char* lds; unsigned char* ws; const float* const* in; float* out; int tid, lane, wave, G, bid; };

struct TItem { const float* W; bf16* WT; int K, Nsrc, k0, n0; };
DI void p0_item_decode(const Ctx& F, int it, TItem& t) {
    constexpr int I0 = 32 * (NINP / 64), I1 = 32 * 32, I4 = 32 * 128, I5 = 128 * 32, IL = I0 + 3 * I1 + I4 + I5;
    const int l = it / IL; int r = it % IL; unsigned char* wl = F.ws + WS_W + (size_t)l * W_LAYER; const float* const* in = F.in;
    const float* W; bf16* WT; int K, Nsrc, Npad;
    if (r < I0) { W = in[13] + (size_t)l * D * NIN; WT = (bf16*)(wl + W_WIN); K = D; Nsrc = NIN; Npad = NINP; }
    else if ((r -= I0) < I1) { W = in[20] + (size_t)l * D * D; WT = (bf16*)(wl + W_WBA); K = D; Nsrc = D; Npad = D; }
    else if ((r -= I1) < I1) { W = in[21] + (size_t)l * D * D; WT = (bf16*)(wl + W_WBB); K = D; Nsrc = D; Npad = D; }
    else if ((r -= I1) < I1) { W = in[22] + (size_t)l * D * D; WT = (bf16*)(wl + W_WO); K = D; Nsrc = D; Npad = D; }
    else if ((r -= I1) < I4) { W = in[23] + (size_t)l * D * DFF; WT = (bf16*)(wl + W_WUP); K = D; Nsrc = DFF; Npad = DFF; }
    else { r -= I4; W = in[24] + (size_t)l * DFF * D; WT = (bf16*)(wl + W_WDN); K = DFF; Nsrc = D; Npad = D; }
    const int nblk = Npad / 64; t.W = W; t.WT = WT; t.K = K; t.Nsrc = Nsrc; t.k0 = 64 * (r / nblk); t.n0 = 64 * (r % nblk);
}
DI void p0_item_load(const TItem& t, int lane, f32x4 (&v)[16]) {
    const int nq = lane & 15, kr = lane >> 4, n = t.n0 + 4 * nq; const bool ok = n < t.Nsrc;
#pragma unroll
    for (int i = 0; i < 16; ++i) v[i] = ok ? *(const GAS f32x4*)(t.W + (size_t)(t.k0 + 4 * i + kr) * t.Nsrc + n) : (f32x4){0.f, 0.f, 0.f, 0.f};
}
DI void p0_item_store(const TItem& t, int lane, const f32x4 (&v)[16], LAS float* scr) {
    const int nq = lane & 15, kr = lane >> 4;
#pragma unroll
    for (int i = 0; i < 16; ++i) { LAS float* s = scr + (4 * i + kr) * 65 + 4 * nq; s[0] = v[i].x; s[1] = v[i].y; s[2] = v[i].z; s[3] = v[i].w; }
    LDS_WAIT(); asm volatile("" ::: "memory");
#pragma unroll
    for (int j = 0; j < 8; ++j) { const int pr = lane + 64 * j, nn = pr >> 3, c = pr & 7; const LAS float* s = scr + (8 * c) * 65 + nn;
        u32x4 o; o.x = cvtpk(s[0 * 65], s[1 * 65]); o.y = cvtpk(s[2 * 65], s[3 * 65]); o.z = cvtpk(s[4 * 65], s[5 * 65]); o.w = cvtpk(s[6 * 65], s[7 * 65]);
        *(GAS u32x4*)(t.WT + (size_t)(t.n0 + nn) * t.K + t.k0 + 8 * c) = o; }
    LDS_WAIT(); asm volatile("" ::: "memory");
}

DI void p0_convert_weights(const Ctx& F, int l0, int l1, int w, int nw) {
    LAS float* scr = (LAS float*)(F.lds + F.wave * 16640);
    constexpr int IL = 32 * (NINP / 64) + 3 * 32 * 32 + 32 * 128 + 128 * 32;
    const int first = l0 * IL, NIT = l1 * IL;
    f32x4 va[16], vb[16]; TItem ta, tb;
    int it = first + w;
    if (it < NIT) { p0_item_decode(F, it, ta); p0_item_load(ta, F.lane, va); }
    while (it < NIT) {
        const int itn = it + nw;
        if (itn < NIT) { p0_item_decode(F, itn, tb); p0_item_load(tb, F.lane, vb); }
        p0_item_store(ta, F.lane, va, scr);
        it = itn; if (it >= NIT) break;
        const int itn2 = it + nw;
        if (itn2 < NIT) { p0_item_decode(F, itn2, ta); p0_item_load(ta, F.lane, va); }
        p0_item_store(tb, F.lane, vb, scr);
        it = itn2;
    }
}

DI void p0_prologue(const Ctx& F) {
    const float* const* in = F.in;
    const int gw = F.bid * 8 + F.wave, NGW = F.G * 8;
    const int gt = F.bid * 512 + F.tid, NGT = F.G * 512;
    {
        LAS float* csT = (LAS float*)F.lds;
        LAS float* red = (LAS float*)(F.lds + 98304);
        for (int i = F.tid; i < 12 * D; i += 512) { const int r = i / D, k = i % D; const float c = r < 4 ? in[7][r * D + k] : in[8][(r - 4) * D + k]; csT[k * 12 + r] = c * sigm(c); }
        __syncthreads();
        float* MOD = (float*)(F.ws + WS_MOD);
        for (int u = F.bid; u < DEPTH * (MODW / 256); u += F.G) {
            const int l = u / (MODW / 256), j0 = (u % (MODW / 256)) * 256;
            const float* wp = in[9] + (size_t)l * D * MODW + (size_t)(256 * F.wave) * MODW + j0 + 4 * F.lane;
            f32x4 acc[12];
#pragma unroll
            for (int r = 0; r < 12; ++r) acc[r] = (f32x4){0.f, 0.f, 0.f, 0.f};
#pragma unroll 8
            for (int k = 0; k < 256; ++k) { const f32x4 w = *(const GAS f32x4*)(wp + (size_t)k * MODW); const LAS f32x4* cp = (const LAS f32x4*)(csT + (256 * F.wave + k) * 12);
                const f32x4 c0 = cp[0], c1 = cp[1], c2 = cp[2];
                acc[0] += w * c0[0]; acc[1] += w * c0[1]; acc[2] += w * c0[2]; acc[3] += w * c0[3]; acc[4] += w * c1[0]; acc[5] += w * c1[1]; acc[6] += w * c1[2]; acc[7] += w * c1[3];
                acc[8] += w * c2[0]; acc[9] += w * c2[1]; acc[10] += w * c2[2]; acc[11] += w * c2[3]; }
#pragma unroll
            for (int hf = 0; hf < 2; ++hf) {
#pragma unroll
                for (int r = 0; r < 6; ++r) *(LAS f32x4*)(red + ((F.wave * 6 + r) * 256 + 4 * F.lane)) = acc[6 * hf + r];
                __syncthreads();
                for (int i = F.tid; i < 6 * 256; i += 512) { const int r = i / 256, c = i % 256; float s = 0.f;
#pragma unroll
                    for (int w = 0; w < 8; ++w) s += red[(w * 6 + r) * 256 + c];
                    MOD[((size_t)l * 12 + 6 * hf + r) * MODW + j0 + c] = s + in[10][(size_t)l * MODW + j0 + c]; }
                __syncthreads();
            }
        }
    }
    p0_convert_weights(F, 0, F.G == 256 ? 1 : DEPTH, gw, NGW);
    {
        f32x4* Xs = (f32x4*)(F.ws + WS_X) + (size_t)MPR * D / 4; const f32x4* xs = (const f32x4*)in[1];
        for (size_t i = gt; i < (size_t)MS * D / 4; i += NGT) Xs[i] = xs[i];
        const size_t pad0 = (size_t)M * D * 2 / 16, pad1 = (size_t)MP * D * 2 / 16;
        u32x4* h4 = (u32x4*)(F.ws + WS_H); u32x4* a4 = (u32x4*)(F.ws + WS_QA); u32x4* b4 = (u32x4*)(F.ws + WS_KA);
        for (size_t i = pad0 + gt; i < pad1; i += NGT) { const u32x4 z = {0u, 0u, 0u, 0u}; h4[i] = z; a4[i] = z; b4[i] = z; }
    }
    {
        float* LB = (float*)(F.ws + WS_LB);
        for (int d = gt; d < 2048; d += NGT) { float r[4], mx = -1e30f;
#pragma unroll
            for (int l = 0; l < 4; ++l) { r[l] = in[18][l * 2048 + d]; mx = fmaxf(mx, r[l]); }
            float e[4], s = 0.f;
#pragma unroll
            for (int l = 0; l < 4; ++l) { e[l] = __expf(r[l] - mx); s += e[l]; }
            const float inv = 1.0f / s; float cum = 0.f;
#pragma unroll
            for (int l = 0; l < 4; ++l) { if (l > 0) cum += e[l] * inv; LB[l * 2048 + d] = cum; } }
        float* BIN = (float*)(F.ws + WS_BIN);
        for (int i = gt; i < DEPTH * NINP; i += NGT) { const int l = i / NINP, c = i % NINP; BIN[i] = c < NIN ? in[14][(size_t)l * NIN + c] : 0.f; }
    }
}

DI void norm_phase(const Ctx& F, const float* gain, const float* modl  , int sh_off, int sc_off, const float* Xp  ) {
    const int gw = F.bid * 8 + F.wave, NGW = F.G * 8;
    const float* X = (const float*)(F.ws + WS_X); bf16* H = (bf16*)(F.ws + WS_H);
    f32x4 v[8], nv[8];
#define NM_LOAD(row_, V_) do { const GAS f32x4* xr_ = (const GAS f32x4*)(((row_) < MPR ? Xp : X) + (size_t)(row_) * D) + F.lane; _Pragma("unroll") for (int j = 0; j < 8; ++j) V_[j] = xr_[64 * j]; } while (0)
    int row = gw;
    if (row < M) NM_LOAD(row, v);
    for (; row < M; row += NGW) {
        const int nrow = row + NGW;
        if (nrow < M) NM_LOAD(nrow, nv);
        float ss = 0.f;
#pragma unroll
        for (int j = 0; j < 8; ++j) ss += (v[j].x * v[j].x + v[j].y * v[j].y) + (v[j].z * v[j].z + v[j].w * v[j].w);
        const float rs = rsqrtf(wave_sum(ss) * (1.0f / D) + EPS);
        const float* mb = modl + (size_t)row_batch(row) * MODW;
        GAS u32x2* o8 = (GAS u32x2*)(H + (size_t)row * D) + F.lane;
#pragma unroll
        for (int j = 0; j < 8; ++j) { const int c = 4 * F.lane + 256 * j; const f32x4 g = *(const f32x4*)(gain + c), sc = *(const f32x4*)(mb + sc_off + c), sh = *(const f32x4*)(mb + sh_off + c);
            const f32x4 y = (v[j] * rs) * g * (sc + 1.0f) + sh; u32x2 w; w.x = cvtpk(y.x, y.y); w.y = cvtpk(y.z, y.w); o8[64 * j] = w; }
#pragma unroll
        for (int j = 0; j < 8; ++j) v[j] = nv[j];
    }
#undef NM_LOAD
}
DI void final_norm_phase(const Ctx& F) {
    const int gw = F.bid * 8 + F.wave, NGW = F.G * 8;
    const float* X = (const float*)(F.ws + WS_X); const float* gain = F.in[25];
    for (int row = gw; row < M; row += NGW) {
        const GAS f32x4* xr = (const GAS f32x4*)(X + (size_t)row * D) + F.lane;
        f32x4 v[8]; float ss = 0.f;
#pragma unroll
        for (int j = 0; j < 8; ++j) { v[j] = xr[64 * j]; ss += (v[j].x * v[j].x + v[j].y * v[j].y) + (v[j].z * v[j].z + v[j].w * v[j].w); }
        const float rs = rsqrtf(wave_sum(ss) * (1.0f / D) + EPS);
        GAS f32x4* o = (GAS f32x4*)(F.out + (size_t)row * D) + F.lane;
#pragma unroll
        for (int j = 0; j < 8; ++j) { const f32x4 g = *(const f32x4*)(gain + 4 * F.lane + 256 * j); o[64 * j] = (v[j] * rs) * g; }
    }
}

DI void prep_phase(const Ctx& F, int l) {
    const bf16* Z = (const bf16*)(F.ws + WS_Z);
    bf16* QA = (bf16*)(F.ws + WS_QA); bf16* KA = (bf16*)(F.ws + WS_KA); bf16* QB = (bf16*)(F.ws + WS_QB); bf16* KB = (bf16*)(F.ws + WS_KB);
    float* E1 = (float*)(F.ws + WS_E1); float* E2 = (float*)(F.ws + WS_E2);
    const float* LB = (const float*)(F.ws + WS_LB) + l * 2048;
    constexpr int NGC = 12, CR = 8, NCONV = M / CR, NHG = NCHUNKS * 8;
    const float* G = (const float*)(F.ws + WS_G); float* GP = (float*)(F.ws + WS_GP);
    const bool split = F.G > 2 * NGC;
    if (F.bid < NGC) {
        const int chain = F.bid * 8 + F.wave, lane = F.lane;
        const bool sample = chain >= 32; const int cc = sample ? chain - 32 : chain, b = cc >> 3, h = cc & 7;
        const int row0 = sample ? MPR + b * SSEQ : b * SEQ, nchunk = sample ? 1 : SEQ / 64, Tv = sample ? SSEQ : 64;
        float m_prev = sample ? F.in[5][((size_t)l * NSB + b) * 8 + h] : 0.f;
        float nig = lane < Tv ? G[(size_t)(row0 + lane) * 16 + h] : -1e30f, nfg = lane < Tv ? G[(size_t)(row0 + lane) * 16 + 8 + h] : 0.f;
        for (int c = 0; c < nchunk; ++c) {
            const int r0 = row0 + 64 * c; const float igv = nig, fgv = nfg;
            if (c + 1 < nchunk) { nig = G[(size_t)(r0 + 64 + lane) * 16 + h]; nfg = G[(size_t)(r0 + 64 + lane) * 16 + 8 + h]; }
            const float lfv = lane < Tv ? logsig(fgv) : 0.f;
            float bc = lfv;
#pragma unroll
            for (int o = 1; o < 64; o <<= 1) { const float y = __shfl_up(bc, o); if (lane >= o) bc += y; }
            float gm = igv - bc;
#pragma unroll
            for (int o = 1; o < 64; o <<= 1) { const float y = __shfl_up(gm, o); if (lane >= o) gm = fmaxf(gm, y); }
            const float mt = bc + fmaxf(gm, m_prev);
            const float winter = __expf(bc + m_prev - mt), enm = __expf(-mt);
            const float m_last = __shfl(mt, 63), b_last = __shfl(bc, 63);
            const float wlast = __expf(b_last - bc + igv - m_last);
            if (lane < Tv) { float* gp = GP + ((size_t)(r0 + lane) * 8 + h) * 8; *(f32x4*)gp = (f32x4){bc - mt, igv - bc, winter, enm}; *(f32x4*)(gp + 4) = (f32x4){wlast, mt, 0.f, 0.f}; }
            m_prev = m_last;
        }
        if (split) return;
    }
    const int nb = split ? F.G - NGC : F.G, me = split ? F.bid - NGC : F.bid;
    {
        const int c0 = 8 * F.tid;
        float w[4][8], cb[8];
#pragma unroll
        for (int j = 0; j < 4; ++j) { const f32x4 a = *(const f32x4*)(F.in[15] + ((size_t)l * 4 + j) * 4096 + c0), b = *(const f32x4*)(F.in[15] + ((size_t)l * 4 + j) * 4096 + c0 + 4);
            w[j][0] = a.x; w[j][1] = a.y; w[j][2] = a.z; w[j][3] = a.w; w[j][4] = b.x; w[j][5] = b.y; w[j][6] = b.z; w[j][7] = b.w; }
        { const f32x4 a = *(const f32x4*)(F.in[16] + (size_t)l * 4096 + c0), b = *(const f32x4*)(F.in[16] + (size_t)l * 4096 + c0 + 4);
            cb[0] = a.x; cb[1] = a.y; cb[2] = a.z; cb[3] = a.w; cb[4] = b.x; cb[5] = b.y; cb[6] = b.z; cb[7] = b.w; }
        u32x4 cur[CR + 3], nxt[CR + 3];
#define CV_LOAD(it_, V_) do { const int r0_ = (it_) * CR; const bool hist_ = (r0_ >= MPR) ? (((r0_ - MPR) & (SSEQ - 1)) != 0) : ((r0_ & (SEQ - 1)) != 0); \
        _Pragma("unroll") for (int j = 0; j < CR + 3; ++j) V_[j] = (j >= 3 || hist_) ? *(const GAS u32x4*)(Z + (size_t)(r0_ - 3 + j) * NINP + c0) : (u32x4){0u, 0u, 0u, 0u}; } while (0)
        int it = me;
        if (it < NCONV) CV_LOAD(it, cur);
        for (; it < NCONV; it += nb) {
            const int itn = it + nb;
            if (itn < NCONV) CV_LOAD(itn, nxt);
            const int r0 = it * CR; const bool sample = r0 >= MPR;
            const int t0 = sample ? ((r0 - MPR) & (SSEQ - 1)) : (r0 & (SEQ - 1)); const int bs = sample ? (r0 - MPR) >> 4 : (r0 >> 12);
            float z0[8], z1[8], z2[8];
            if (t0 == 0 && sample) { const float* cc = F.in[2] + (((size_t)l * NSB + bs) * 3) * 4096 + c0;
#pragma unroll
                for (int e = 0; e < 8; ++e) { z0[e] = cc[e]; z1[e] = cc[4096 + e]; z2[e] = cc[8192 + e]; } }
            else { pg8::unpack8(cur[0], z0); pg8::unpack8(cur[1], z1); pg8::unpack8(cur[2], z2); }
            const bool last = sample ? (t0 + CR == SSEQ) : (t0 + CR == SEQ);
            float* cout = F.out + (sample ? O_CONVS + (((size_t)l * NSB + bs) * 3) * 4096 : O_CONVP + (((size_t)l * NB + bs) * 3) * 4096) + c0;
#pragma unroll
            for (int rr = 0; rr < CR; ++rr) {
                float z3[8]; pg8::unpack8(cur[3 + rr], z3);
                float y[8];
#pragma unroll
                for (int e = 0; e < 8; ++e) { const float a = cb[e] + w[0][e] * z0[e] + w[1][e] * z1[e] + w[2][e] * z2[e] + w[3][e] * z3[e]; y[e] = a * sigm(a); }
                if (c0 < 2048) { u32x4 o; o.x = cvtpk(y[0], y[1]); o.y = cvtpk(y[2], y[3]); o.z = cvtpk(y[4], y[5]); o.w = cvtpk(y[6], y[7]); *(GAS u32x4*)(QA + (size_t)(r0 + rr) * D + c0) = o; }
                else { u32x4 o; o.x = cvtpk(y[0] * 0.0625f, y[1] * 0.0625f); o.y = cvtpk(y[2] * 0.0625f, y[3] * 0.0625f); o.z = cvtpk(y[4] * 0.0625f, y[5] * 0.0625f); o.w = cvtpk(y[6] * 0.0625f, y[7] * 0.0625f);
                    *(GAS u32x4*)(KA + (size_t)(r0 + rr) * D + (c0 - 2048)) = o; }
                if (last && rr >= CR - 3) { float* cp = cout + (size_t)(rr - (CR - 3)) * 4096; *(f32x4*)cp = (f32x4){z3[0], z3[1], z3[2], z3[3]}; *(f32x4*)(cp + 4) = (f32x4){z3[4], z3[5], z3[6], z3[7]}; }
#pragma unroll
                for (int e = 0; e < 8; ++e) { z0[e] = z1[e]; z1[e] = z2[e]; z2[e] = z3[e]; }
            }
#pragma unroll
            for (int j = 0; j < CR + 3; ++j) cur[j] = nxt[j];
        }
#undef CV_LOAD
    }
    {
        const int d = F.tid & 255, hf = F.tid >> 8;
        LAS unsigned char* FBs = F.lds; LAS unsigned char* QBs = F.lds + 32768; LAS float* xch = (LAS float*)(F.lds + 65536);
        u32x4 pf[4], pq[4];
#define HG_LOAD(hi_) do { const int ci_ = (hi_) >> 3, cb_ = ((hi_) & 7) * 256; const bool sm_ = ci_ >= NB * 64; const int r0_ = sm_ ? MPR + (ci_ - NB * 64) * 16 : ci_ * 64, Tv_ = sm_ ? 16 : 64; \
        _Pragma("unroll") for (int i = 0; i < 4; ++i) { const int idx = F.tid + 512 * i, rr = idx >> 5, sg = idx & 31; \
            if (rr < Tv_) { pf[i] = *(const GAS u32x4*)(Z + (size_t)(r0_ + rr) * NINP + ZFB + cb_ + 8 * sg); pq[i] = *(const GAS u32x4*)(Z + (size_t)(r0_ + rr) * NINP + ZQB + cb_ + 8 * sg); } } } while (0)
        int hi = (me + 56) % nb;
        if (hi < NHG) HG_LOAD(hi);
        for (; hi < NHG; hi += nb) {
            const int ci = hi >> 3, cbase = (hi & 7) * 256;
            const bool sample = ci >= NB * 64; const int r0 = sample ? MPR + (ci - NB * 64) * 16 : ci * 64; const int Tv = sample ? 16 : 64;
#pragma unroll
            for (int i = 0; i < 4; ++i) { const int idx = F.tid + 512 * i, rr = idx >> 5, sg = idx & 31;
                if (rr < Tv) { *(LAS u32x4*)(FBs + rr * 512 + sg * 16) = pf[i]; *(LAS u32x4*)(QBs + rr * 512 + sg * 16) = pq[i]; } }
            LBAR();
            if (hi + nb < NHG) HG_LOAD(hi + nb);
            const float lb = LB[cbase + d], oml = 1.0f - lb;
            float bc[32], sg[32]; float run = 0.f;
#pragma unroll
            for (int i = 0; i < 32; ++i) { const int t = 32 * hf + i; sg[i] = 0.f;
                if (t < Tv) { const float fb = fminf(fmaxf(bf2f(*(const LAS unsigned short*)(FBs + t * 512 + d * 2)), -30.f), 30.f); sg[i] = __builtin_amdgcn_rcpf(1.0f + __expf(-fb)); const float f = lb + oml * sg[i]; run += fmaxf(__logf(f), -60.0f); }
                bc[i] = run; }
            if (hf == 0) xch[d] = run;
            LBAR();
            const float base = hf ? xch[d] : 0.f; const float bR = hf ? base : run;
            if (hf) { E1[(size_t)ci * 2048 + cbase + d] = __expf(bR); E2[(size_t)ci * 2048 + cbase + d] = __expf(run); }
#pragma unroll
            for (int i = 0; i < 32; ++i) { const int t = 32 * hf + i;
                if (t < Tv) { const float qv = bf2f(*(const LAS unsigned short*)(QBs + t * 512 + d * 2)), bt = base + bc[i];
                    const float ed = __expf(fminf(fmaxf(bt - bR, -80.f), 80.f));
                    const float q = qv * sigm(qv) * ed, k = oml * (1.0f - sg[i]) * __builtin_amdgcn_rcpf(ed);
                    *(LAS unsigned short*)(QBs + t * 512 + d * 2) = (unsigned short)(cvtpk(q, q) & 0xffffu); *(LAS unsigned short*)(FBs + t * 512 + d * 2) = (unsigned short)(cvtpk(k, k) & 0xffffu); } }
            LBAR();
#pragma unroll
            for (int i = 0; i < 4; ++i) { const int idx = F.tid + 512 * i, rr = idx >> 5, sg = idx & 31;
                if (rr < Tv) { *(GAS u32x4*)(QB + (size_t)(r0 + rr) * D + cbase + 8 * sg) = *(const LAS u32x4*)(QBs + rr * 512 + sg * 16);
                               *(GAS u32x4*)(KB + (size_t)(r0 + rr) * D + cbase + 8 * sg) = *(const LAS u32x4*)(FBs + rr * 512 + sg * 16); } }
            LBAR();
        }
#undef HG_LOAD
    }
}

DI void headnorm_phase(const Ctx& F, int l) {
    const int gw = F.bid * 8 + F.wave, NGW = F.G * 8;
    const bf16* Z = (const bf16*)(F.ws + WS_Z); const bf16* HA = (const bf16*)(F.ws + WS_HA); const bf16* HB = (const bf16*)(F.ws + WS_HB);
    bf16* YA = (bf16*)(F.ws + WS_QA); bf16* YB = (bf16*)(F.ws + WS_KA);
    const float* ga = F.in[17] + (size_t)l * 2048; const float* gb = F.in[19] + (size_t)l * 2048;
    u32x4 ha[4], hb[4], oa[4], ob[4], na[4], nb[4], noa[4], nob[4];
#define HN_LOAD(row_, A_, B_, OA_, OB_) do { _Pragma("unroll") for (int j = 0; j < 4; ++j) { const int c_ = 512 * j + 8 * F.lane; \
        A_[j] = *(const GAS u32x4*)(HA + (size_t)(row_) * D + c_); B_[j] = *(const GAS u32x4*)(HB + (size_t)(row_) * D + c_); \
        OA_[j] = *(const GAS u32x4*)(Z + (size_t)(row_) * NINP + ZOA + c_); OB_[j] = *(const GAS u32x4*)(Z + (size_t)(row_) * NINP + ZOGB + c_); } } while (0)
    int row = gw;
    if (row < M) HN_LOAD(row, ha, hb, oa, ob);
    for (; row < M; row += NGW) {
        const int nrow = row + NGW;
        if (nrow < M) HN_LOAD(nrow, na, nb, noa, nob);
#pragma unroll
        for (int j = 0; j < 4; ++j) { const int c = 512 * j + 8 * F.lane;
            { float hv[8], ov[8]; pg8::unpack8(ha[j], hv); pg8::unpack8(oa[j], ov); float ss = 0.f;
#pragma unroll
              for (int e = 0; e < 8; ++e) ss += hv[e] * hv[e];
#pragma unroll
              for (int o = 1; o < 32; o <<= 1) ss += __shfl_xor(ss, o);
              const float rs = rsqrtf(ss * (1.0f / 256.0f) + EPS); const f32x4 g0 = *(const f32x4*)(ga + c), g1 = *(const f32x4*)(ga + c + 4); float y[8];
#pragma unroll
              for (int e = 0; e < 8; ++e) y[e] = hv[e] * rs * (e < 4 ? g0[e] : g1[e - 4]) * sigm(ov[e]);
              u32x4 w; w.x = cvtpk(y[0], y[1]); w.y = cvtpk(y[2], y[3]); w.z = cvtpk(y[4], y[5]); w.w = cvtpk(y[6], y[7]); *(GAS u32x4*)(YA + (size_t)row * D + c) = w; }
            { float hv[8], ov[8]; pg8::unpack8(hb[j], hv); pg8::unpack8(ob[j], ov); float ss = 0.f;
#pragma unroll
              for (int e = 0; e < 8; ++e) ss += hv[e] * hv[e];
#pragma unroll
              for (int o = 1; o < 16; o <<= 1) ss += __shfl_xor(ss, o);
              const float rs = rsqrtf(ss * (1.0f / 128.0f) + EPS); const f32x4 g0 = *(const f32x4*)(gb + c), g1 = *(const f32x4*)(gb + c + 4); float y[8];
#pragma unroll
              for (int e = 0; e < 8; ++e) y[e] = hv[e] * rs * (e < 4 ? g0[e] : g1[e - 4]) * sigm(ov[e]);
              u32x4 w; w.x = cvtpk(y[0], y[1]); w.y = cvtpk(y[2], y[3]); w.z = cvtpk(y[4], y[5]); w.w = cvtpk(y[6], y[7]); *(GAS u32x4*)(YB + (size_t)row * D + c) = w; }
        }
#pragma unroll
        for (int j = 0; j < 4; ++j) { ha[j] = na[j]; hb[j] = nb[j]; oa[j] = noa[j]; ob[j] = nob[j]; }
    }
#undef HN_LOAD
}

DI bf16x8 frag(const LAS unsigned char* base, int row, int ldb, int kbyte) { return *(const LAS bf16x8*)(base + row * ldb + kbyte); }
DI bf16x8 frag_t(const LAS unsigned char* base, int k0, int ldb, int col) {
    const LAS unsigned short* p = (const LAS unsigned short*)(base + k0 * ldb + col * 2); bf16x8 r;
#pragma unroll
    for (int j = 0; j < 8; ++j) r[j] = (short)p[j * (ldb / 2)];
    return r;
}
#ifndef PROBE_ST
#define PROBE_ST 1
#endif
#ifndef PROBE_S2
#define PROBE_S2 1
#endif
#ifndef PROBE_S3
#define PROBE_S3 1
#endif
#ifndef PROBE_S4
#define PROBE_S4 1
#endif
#define PROBE_LOOP(n) int reps_ = (n); asm volatile("" : "+s"(reps_)); _Pragma("nounroll") for (int rp_ = 0; rp_ < reps_; ++rp_)
#define MFMA16(a, b, c) __builtin_amdgcn_mfma_f32_16x16x32_bf16((a), (b), (c), 0, 0, 0)

DI void mlstm_unit(LAS unsigned char* lds, const bf16* QA, const bf16* KA, const bf16* Z, const float* GP, bf16* HA,
                   int row0, int nchunk, int Tv, int h, int vs, const float* C0, const float* n0, const float* m0p, float* Cout, float* nout, float* mout) {
    int tid_ = threadIdx.x; asm volatile("" : "+v"(tid_));
    const int tid = tid_, lane = tid & 63, W = __builtin_amdgcn_readfirstlane(tid >> 6), g = lane >> 4, li = lane & 15;
    LAS unsigned char* Qs = lds + SC_Q; LAS unsigned char* Ks = lds + SC_K; LAS unsigned char* VT = lds + SC_VT; LAS unsigned char* VW = lds + SC_VW;
    LAS unsigned char* CTs = lds + SC_CT; LAS unsigned char* Ps = lds + SC_P; LAS unsigned char* Hs = lds + SC_H;
    f32x4 cacc[2][5];
#pragma unroll
    for (int di = 0; di < 2; ++di)
#pragma unroll
        for (int vi = 0; vi < 5; ++vi)
#pragma unroll
            for (int r = 0; r < 4; ++r) { const int d = 16 * (2 * W + di) + 4 * g + r; float v = 0.f;
                if (C0) { if (vi < 4) v = C0[(size_t)d * 256 + 64 * vs + 16 * vi + li]; else if (li == 0) v = n0[d]; }
                cacc[di][vi][r] = v; }
    float m_prev = m0p ? *m0p : 0.f;
    for (int i = tid; i < 16 * 72; i += 512) { const int rr = 64 + i / 72, cc = i % 72;
        *(LAS unsigned short*)(VT + rr * LVB + cc * 2) = (rr == 64 && cc < 64) ? (unsigned short)0x3F80 : (unsigned short)0; *(LAS unsigned short*)(VW + rr * LVB + cc * 2) = 0; }
    u32x4 pq[4], pk[4]; u32x2 pva, pvb; f32x4 pg0, pg1;
#define ML_PREFETCH(c) do { const int r0_ = row0 + 64 * (c); \
        _Pragma("unroll") for (int i = 0; i < 4; ++i) { const int idx = tid + 512 * i, rr = idx >> 5, sg = idx & 31; \
            if (rr < Tv) { pq[i] = *(const GAS u32x4*)(QA + (size_t)(r0_ + rr) * D + 256 * h + 8 * sg); pk[i] = *(const GAS u32x4*)(KA + (size_t)(r0_ + rr) * D + 256 * h + 8 * sg); } \
            else { pq[i] = (u32x4){0u, 0u, 0u, 0u}; pk[i] = (u32x4){0u, 0u, 0u, 0u}; } } \
        { const int fp = tid & 31, vq = tid >> 5; const bf16* vp_ = Z + (size_t)(r0_ + 2 * fp) * NINP + ZVA + 256 * h + 64 * vs + 4 * vq; \
          pva = 2 * fp < Tv ? *(const GAS u32x2*)vp_ : (u32x2){0u, 0u}; pvb = 2 * fp + 1 < Tv ? *(const GAS u32x2*)(vp_ + NINP) : (u32x2){0u, 0u}; } \
        if (lane < Tv) { const float* gp_ = GP + ((size_t)(r0_ + lane) * 8 + h) * 8; pg0 = *(const GAS f32x4*)gp_; pg1 = *(const GAS f32x4*)(gp_ + 4); } \
        else { pg0 = (f32x4){0.f, -1e30f, 0.f, 1.f}; pg1 = (f32x4){0.f, 0.f, 0.f, 0.f}; } } while (0)
    ML_PREFETCH(0);
    for (int c = 0; c < nchunk; ++c) {
        const int r0 = row0 + 64 * c;
        const float gx = pg0[0], gy = pg0[1], winter = pg0[2], enm = pg0[3], wlast = pg1[0];
        const float m_last = __shfl(pg1[1], Tv - 1), decay = __shfl(winter, Tv - 1);
        { PROBE_LOOP(PROBE_ST) { asm volatile("" ::: "memory");
#pragma unroll
        for (int i = 0; i < 4; ++i) { const int idx = tid + 512 * i, rr = idx >> 5, sg = idx & 31; *(LAS u32x4*)(Qs + rr * LQB + sg * 16) = pq[i]; *(LAS u32x4*)(Ks + rr * LQB + sg * 16) = pk[i]; }
        {
          const int fp = tid & 31, vq = tid >> 5; const float wa = __shfl(wlast, 2 * fp), wb = __shfl(wlast, 2 * fp + 1);
          const unsigned a0 = pva.x, a1 = pva.y, b0 = pvb.x, b1 = pvb.y;
          const unsigned r0w = (a0 & 0xffffu) | (b0 << 16), r1w = (a0 >> 16) | (b0 & 0xffff0000u), r2w = (a1 & 0xffffu) | (b1 << 16), r3w = (a1 >> 16) | (b1 & 0xffff0000u);
          const unsigned s0w = cvtpk(__uint_as_float(a0 << 16) * wa, __uint_as_float(b0 << 16) * wb), s1w = cvtpk(__uint_as_float(a0 & 0xffff0000u) * wa, __uint_as_float(b0 & 0xffff0000u) * wb);
          const unsigned s2w = cvtpk(__uint_as_float(a1 << 16) * wa, __uint_as_float(b1 << 16) * wb), s3w = cvtpk(__uint_as_float(a1 & 0xffff0000u) * wa, __uint_as_float(b1 & 0xffff0000u) * wb);
          LAS unsigned char* vt = VT + (4 * vq) * LVB + 4 * fp; LAS unsigned char* vw = VW + (4 * vq) * LVB + 4 * fp;
          *(LAS unsigned*)(vt) = r0w; *(LAS unsigned*)(vt + LVB) = r1w; *(LAS unsigned*)(vt + 2 * LVB) = r2w; *(LAS unsigned*)(vt + 3 * LVB) = r3w;
          *(LAS unsigned*)(vw) = s0w; *(LAS unsigned*)(vw + LVB) = s1w; *(LAS unsigned*)(vw + 2 * LVB) = s2w; *(LAS unsigned*)(vw + 3 * LVB) = s3w; }
        if (W == 0) *(LAS unsigned short*)(VW + 64 * LVB + lane * 2) = (unsigned short)(cvtpk(wlast, wlast) & 0xffffu);
#pragma unroll
        for (int di = 0; di < 2; ++di)
#pragma unroll
            for (int vi = 0; vi < 5; ++vi) { u32x2 w; w.x = cvtpk(cacc[di][vi][0], cacc[di][vi][1]); w.y = cvtpk(cacc[di][vi][2], cacc[di][vi][3]);
                *(LAS u32x2*)(CTs + (16 * vi + li) * LQB + (16 * (2 * W + di) + 4 * g) * 2) = w; }
        } }
        LBAR();
        if (c + 1 < nchunk) ML_PREFETCH(c + 1);
        { PROBE_LOOP(PROBE_S2)
        { asm volatile("" ::: "memory");
            const int tt = W & 3, sh = W >> 2;
            f32x4 sacc[2] = {{0.f, 0.f, 0.f, 0.f}, {0.f, 0.f, 0.f, 0.f}};
#pragma unroll
            for (int kk = 0; kk < 8; ++kk) { const bf16x8 bq = frag(Qs, 16 * tt + li, LQB, 64 * kk + 16 * g);
#pragma unroll
                for (int i = 0; i < 2; ++i) if (2 * sh + i <= tt) { const bf16x8 ak = frag(Ks, 16 * (2 * sh + i) + li, LQB, 64 * kk + 16 * g); sacc[i] = MFMA16(ak, bq, sacc[i]); } }
            const int t = 16 * tt + li; const float xt = __shfl(gx, t);
#pragma unroll
            for (int i = 0; i < 2; ++i) { float p[4];
#pragma unroll
                for (int r = 0; r < 4; ++r) { const int s = 16 * (2 * sh + i) + 4 * g + r; const float ys = __shfl(gy, s);
                    p[r] = (s <= t) ? sacc[i][r] * __expf(xt + ys) : 0.f; }
                u32x2 w; w.x = cvtpk(p[0], p[1]); w.y = cvtpk(p[2], p[3]); *(LAS u32x2*)(Ps + t * LVB + (16 * (2 * sh + i) + 4 * g) * 2) = w; }
        } }
        LBAR();
        { PROBE_LOOP(PROBE_S3)
        { asm volatile("" ::: "memory");
            const int tt = W & 3, vh = W >> 2; const int vt0 = 2 * vh, vt1 = 2 * vh + 1;
            f32x4 a1[3], a2[3];
#pragma unroll
            for (int i = 0; i < 3; ++i) { a1[i] = (f32x4){0.f, 0.f, 0.f, 0.f}; a2[i] = (f32x4){0.f, 0.f, 0.f, 0.f}; }
#pragma unroll
            for (int kk = 0; kk < 2; ++kk) { const bf16x8 ap = frag(Ps, 16 * tt + li, LVB, 64 * kk + 16 * g);
                a1[0] = MFMA16(ap, frag(VT, 16 * vt0 + li, LVB, 64 * kk + 16 * g), a1[0]); a1[1] = MFMA16(ap, frag(VT, 16 * vt1 + li, LVB, 64 * kk + 16 * g), a1[1]);
                a1[2] = MFMA16(ap, frag(VT, 64 + li, LVB, 64 * kk + 16 * g), a1[2]); }
#pragma unroll
            for (int kk = 0; kk < 8; ++kk) { const bf16x8 aq = frag(Qs, 16 * tt + li, LQB, 64 * kk + 16 * g);
                a2[0] = MFMA16(aq, frag(CTs, 16 * vt0 + li, LQB, 64 * kk + 16 * g), a2[0]); a2[1] = MFMA16(aq, frag(CTs, 16 * vt1 + li, LQB, 64 * kk + 16 * g), a2[1]);
                a2[2] = MFMA16(aq, frag(CTs, 64 + li, LQB, 64 * kk + 16 * g), a2[2]); }
#pragma unroll
            for (int r = 0; r < 4; ++r) { const int t = 16 * tt + 4 * g + r; const float wi = __shfl(winter, t), en = __shfl(enm, t);
                const float o2 = a1[2][r] + wi * a2[2][r]; const float qn = __shfl(o2, lane & 48); const float inv = __builtin_amdgcn_rcpf(fmaxf(fabsf(qn), en));
                const unsigned hw = cvtpk((a1[0][r] + wi * a2[0][r]) * inv, (a1[1][r] + wi * a2[1][r]) * inv);
                *(LAS unsigned short*)(Hs + t * LVB + (16 * vt0 + li) * 2) = (unsigned short)(hw & 0xffffu); *(LAS unsigned short*)(Hs + t * LVB + (16 * vt1 + li) * 2) = (unsigned short)(hw >> 16); }
        } }
#pragma unroll
        for (int di = 0; di < 2; ++di)
#pragma unroll
            for (int vi = 0; vi < 5; ++vi) cacc[di][vi] = cacc[di][vi] * decay;
#pragma unroll
        for (int kk = 0; kk < 2; ++kk) { bf16x8 ak[2];
#pragma unroll
            for (int di = 0; di < 2; ++di) ak[di] = frag_t(Ks, 32 * kk + 8 * g, LQB, 16 * (2 * W + di) + li);
#pragma unroll
            for (int vi = 0; vi < 5; ++vi) { const bf16x8 bv = frag(VW, 16 * vi + li, LVB, 64 * kk + 16 * g);
#pragma unroll
                for (int di = 0; di < 2; ++di) cacc[di][vi] = MFMA16(ak[di], bv, cacc[di][vi]); } }
        if (PROBE_S4 > 1) { PROBE_LOOP(PROBE_S4 - 1) { asm volatile("" ::: "memory"); f32x4 dacc[2][5];
#pragma unroll
            for (int di = 0; di < 2; ++di)
#pragma unroll
                for (int vi = 0; vi < 5; ++vi) dacc[di][vi] = (f32x4){0.f, 0.f, 0.f, 0.f};
#pragma unroll
            for (int kk = 0; kk < 2; ++kk) { bf16x8 ak[2];
#pragma unroll
                for (int di = 0; di < 2; ++di) ak[di] = frag_t(Ks, 32 * kk + 8 * g, LQB, 16 * (2 * W + di) + li);
#pragma unroll
                for (int vi = 0; vi < 5; ++vi) { const bf16x8 bv = frag(VW, 16 * vi + li, LVB, 64 * kk + 16 * g);
#pragma unroll
                    for (int di = 0; di < 2; ++di) dacc[di][vi] = MFMA16(ak[di], bv, dacc[di][vi]); } }
#pragma unroll
            for (int di = 0; di < 2; ++di)
#pragma unroll
                for (int vi = 0; vi < 5; ++vi) asm volatile("" :: "v"(dacc[di][vi])); } }
        m_prev = m_last;
        LBAR();
        { const int rr = tid >> 3, sg = tid & 7; if (rr < Tv) *(GAS u32x4*)(HA + (size_t)(r0 + rr) * D + 256 * h + 64 * vs + 8 * sg) = *(const LAS u32x4*)(Hs + rr * LVB + sg * 16); }
    }
#undef ML_PREFETCH
#pragma unroll
    for (int di = 0; di < 2; ++di)
#pragma unroll
        for (int r = 0; r < 4; ++r) { const int d = 16 * (2 * W + di) + 4 * g + r;
#pragma unroll
            for (int vi = 0; vi < 4; ++vi) Cout[(size_t)d * 256 + 64 * vs + 16 * vi + li] = cacc[di][vi][r];
            if (vs == 0 && li == 0) nout[d] = cacc[di][4][r]; }
    if (vs == 0 && tid == 0) *mout = m_prev;
}

DI void hgrn_unit(LAS unsigned char* lds, const bf16* QB, const bf16* KB, const bf16* Z, const float* E1, const float* E2, bf16* HB,
                  int row0, int nchunk, int Tv, int h, int vs, int ci0, const float* S0, float* Sout) {
    int tid_ = threadIdx.x; asm volatile("" : "+v"(tid_));
    const int tid = tid_, lane = tid & 63, W = __builtin_amdgcn_readfirstlane(tid >> 6), g = lane >> 4, li = lane & 15;
    LAS unsigned char* Qs = lds + HS_Q; LAS unsigned char* Ks = lds + HS_K; LAS unsigned char* VT = lds + HS_VT; LAS unsigned char* STs = lds + HS_ST; LAS unsigned char* Ps = lds + HS_P; LAS unsigned char* Hs = lds + HS_H;
    f32x4 sacc[4];
#pragma unroll
    for (int vi = 0; vi < 4; ++vi)
#pragma unroll
        for (int r = 0; r < 4; ++r) sacc[vi][r] = S0 ? S0[(size_t)(16 * W + 4 * g + r) * 128 + 64 * vs + 16 * vi + li] : 0.f;
    u32x4 pq[2], pk[2]; u32x2 pva, pvb; f32x4 pe1, pe2;
#define HG_PREFETCH(c) do { const int r0_ = row0 + 64 * (c); \
        _Pragma("unroll") for (int i = 0; i < 2; ++i) { const int idx = tid + 512 * i, rr = idx >> 4, sg = idx & 15; \
            if (rr < Tv) { pq[i] = *(const GAS u32x4*)(QB + (size_t)(r0_ + rr) * D + 128 * h + 8 * sg); pk[i] = *(const GAS u32x4*)(KB + (size_t)(r0_ + rr) * D + 128 * h + 8 * sg); } \
            else { pq[i] = (u32x4){0u, 0u, 0u, 0u}; pk[i] = (u32x4){0u, 0u, 0u, 0u}; } } \
        { const int fp = tid & 31, vq = tid >> 5; const bf16* vp_ = Z + (size_t)(r0_ + 2 * fp) * NINP + ZIB + 128 * h + 64 * vs + 4 * vq; \
          pva = 2 * fp < Tv ? *(const GAS u32x2*)vp_ : (u32x2){0u, 0u}; pvb = 2 * fp + 1 < Tv ? *(const GAS u32x2*)(vp_ + NINP) : (u32x2){0u, 0u}; } \
        pe1 = *(const GAS f32x4*)(E1 + (size_t)(ci0 + (c)) * 2048 + 128 * h + 16 * W + 4 * g); pe2 = *(const GAS f32x4*)(E2 + (size_t)(ci0 + (c)) * 2048 + 128 * h + 16 * W + 4 * g); } while (0)
    HG_PREFETCH(0);
    for (int c = 0; c < nchunk; ++c) {
        const int r0 = row0 + 64 * c;
        const f32x4 e2 = pe2;
        f32x4 smid[4];
#pragma unroll
        for (int vi = 0; vi < 4; ++vi) smid[vi] = sacc[vi] * pe1;
#pragma unroll
        for (int i = 0; i < 2; ++i) { const int idx = tid + 512 * i, rr = idx >> 4, sg = idx & 15; *(LAS u32x4*)(Qs + rr * LHB + sg * 16) = pq[i]; *(LAS u32x4*)(Ks + rr * LHB + sg * 16) = pk[i]; }
        { const int fp = tid & 31, vq = tid >> 5; const unsigned a0 = pva.x, a1 = pva.y, b0 = pvb.x, b1 = pvb.y; LAS unsigned char* vt = VT + (4 * vq) * LVB + 4 * fp;
          *(LAS unsigned*)(vt) = (a0 & 0xffffu) | (b0 << 16); *(LAS unsigned*)(vt + LVB) = (a0 >> 16) | (b0 & 0xffff0000u); *(LAS unsigned*)(vt + 2 * LVB) = (a1 & 0xffffu) | (b1 << 16); *(LAS unsigned*)(vt + 3 * LVB) = (a1 >> 16) | (b1 & 0xffff0000u); }
#pragma unroll
        for (int vi = 0; vi < 4; ++vi) { u32x2 w; w.x = cvtpk(smid[vi][0], smid[vi][1]); w.y = cvtpk(smid[vi][2], smid[vi][3]); *(LAS u32x2*)(STs + (16 * vi + li) * LHB + (16 * W + 4 * g) * 2) = w; }
        LBAR();
        if (c + 1 < nchunk) HG_PREFETCH(c + 1);
        {
            const int tt = W & 3, sh = W >> 2;
            f32x4 a[2] = {{0.f, 0.f, 0.f, 0.f}, {0.f, 0.f, 0.f, 0.f}};
#pragma unroll
            for (int kk = 0; kk < 4; ++kk) { const bf16x8 bq = frag(Qs, 16 * tt + li, LHB, 64 * kk + 16 * g);
#pragma unroll
                for (int i = 0; i < 2; ++i) if (2 * sh + i <= tt) a[i] = MFMA16(frag(Ks, 16 * (2 * sh + i) + li, LHB, 64 * kk + 16 * g), bq, a[i]); }
            const int t = 16 * tt + li;
#pragma unroll
            for (int i = 0; i < 2; ++i) { float p[4];
#pragma unroll
                for (int r = 0; r < 4; ++r) { const int s = 16 * (2 * sh + i) + 4 * g + r; p[r] = (s <= t) ? a[i][r] : 0.f; }
                u32x2 w; w.x = cvtpk(p[0], p[1]); w.y = cvtpk(p[2], p[3]); *(LAS u32x2*)(Ps + t * LVB + (16 * (2 * sh + i) + 4 * g) * 2) = w; }
        }
        LBAR();
        {
            const int tt = W & 3, vh = W >> 2;
            f32x4 o[2] = {{0.f, 0.f, 0.f, 0.f}, {0.f, 0.f, 0.f, 0.f}};
#pragma unroll
            for (int kk = 0; kk < 2; ++kk) { const bf16x8 ap = frag(Ps, 16 * tt + li, LVB, 64 * kk + 16 * g);
#pragma unroll
                for (int i = 0; i < 2; ++i) o[i] = MFMA16(ap, frag(VT, 16 * (2 * vh + i) + li, LVB, 64 * kk + 16 * g), o[i]); }
#pragma unroll
            for (int kk = 0; kk < 4; ++kk) { const bf16x8 aq = frag(Qs, 16 * tt + li, LHB, 64 * kk + 16 * g);
#pragma unroll
                for (int i = 0; i < 2; ++i) o[i] = MFMA16(aq, frag(STs, 16 * (2 * vh + i) + li, LHB, 64 * kk + 16 * g), o[i]); }
#pragma unroll
            for (int r = 0; r < 4; ++r) { const int t = 16 * tt + 4 * g + r;
                const unsigned hw = cvtpk(o[0][r], o[1][r]); *(LAS unsigned short*)(Hs + t * LVB + (16 * (2 * vh) + li) * 2) = (unsigned short)(hw & 0xffffu); *(LAS unsigned short*)(Hs + t * LVB + (16 * (2 * vh + 1) + li) * 2) = (unsigned short)(hw >> 16); }
        }
#pragma unroll
        for (int vi = 0; vi < 4; ++vi) sacc[vi] = smid[vi];
#pragma unroll
        for (int kk = 0; kk < 2; ++kk) { const bf16x8 ak = frag_t(Ks, 32 * kk + 8 * g, LHB, 16 * W + li);
#pragma unroll
            for (int vi = 0; vi < 4; ++vi) sacc[vi] = MFMA16(ak, frag(VT, 16 * vi + li, LVB, 64 * kk + 16 * g), sacc[vi]); }
#pragma unroll
        for (int vi = 0; vi < 4; ++vi) sacc[vi] = sacc[vi] * e2;
        LBAR();
        { const int rr = tid >> 3, sg = tid & 7; if (rr < Tv) *(GAS u32x4*)(HB + (size_t)(r0 + rr) * D + 128 * h + 64 * vs + 8 * sg) = *(const LAS u32x4*)(Hs + rr * LVB + sg * 16); }
    }
#undef HG_PREFETCH
#pragma unroll
    for (int vi = 0; vi < 4; ++vi)
#pragma unroll
        for (int r = 0; r < 4; ++r) Sout[(size_t)(16 * W + 4 * g + r) * 128 + 64 * vs + 16 * vi + li] = sacc[vi][r];
}

DI void scan_phase(const Ctx& F, int l) {
    const bf16* Z = (const bf16*)(F.ws + WS_Z);
    const bf16* QA = (const bf16*)(F.ws + WS_QA); const bf16* KA = (const bf16*)(F.ws + WS_KA); const bf16* QB = (const bf16*)(F.ws + WS_QB); const bf16* KB = (const bf16*)(F.ws + WS_KB);
    const float* GP = (const float*)(F.ws + WS_GP); const float* E1 = (const float*)(F.ws + WS_E1); const float* E2 = (const float*)(F.ws + WS_E2);
    bf16* HA = (bf16*)(F.ws + WS_HA); bf16* HB = (bf16*)(F.ws + WS_HB);
    for (int u = F.bid; u < 768; u += F.G) {
        int type, idx, sample;
        if (u < 128) { type = 0; idx = u; sample = 0; } else if (u < 256) { type = 1; idx = u - 128; sample = 0; }
        else if (u < 384) { type = 1; idx = u - 256; sample = 1; } else if (u < 512) { type = 0; idx = u - 384; sample = 1; }
        else if (u < 640) { type = 1; idx = u - 512 + 128; sample = 1; } else { type = 0; idx = u - 640 + 128; sample = 1; }
        if (type == 0) {
            const int b = idx >> 5, h = (idx >> 2) & 7, vs = idx & 3;
            const size_t so = sample ? (size_t)l * NSB + b : (size_t)l * NB + b;
            const float* C0 = sample ? F.in[3] + (so * 8 + h) * 65536 : nullptr; const float* n0 = sample ? F.in[4] + (so * 8 + h) * 256 : nullptr; const float* m0 = sample ? F.in[5] + so * 8 + h : nullptr;
            float* Co = F.out + (sample ? O_CS : O_CP) + (so * 8 + h) * 65536; float* no = F.out + (sample ? O_NS : O_NP) + (so * 8 + h) * 256; float* mo = F.out + (sample ? O_MS : O_MP) + so * 8 + h;
            mlstm_unit(F.lds, QA, KA, Z, GP, HA, sample ? MPR + b * SSEQ : b * SEQ, sample ? 1 : SEQ / 64, sample ? SSEQ : 64, h, vs, C0, n0, m0, Co, no, mo);
        } else {
            const int b = idx >> 5, h = (idx >> 1) & 15, vs = idx & 1;
            const size_t so = sample ? (size_t)l * NSB + b : (size_t)l * NB + b;
            const float* S0 = sample ? F.in[6] + (so * 16 + h) * 16384 : nullptr; float* So = F.out + (sample ? O_SS : O_SP) + (so * 16 + h) * 16384;
            hgrn_unit(F.lds, QB, KB, Z, E1, E2, HB, sample ? MPR + b * SSEQ : b * SEQ, sample ? 1 : SEQ / 64, sample ? SSEQ : 64, h, vs, sample ? NB * 64 + b : b * 64, S0, So);
        }
        __syncthreads();
    }
    if (F.G == 256 && l + 1 < DEPTH && F.bid >= 128) p0_convert_weights(F, l + 1, l + 2, (F.bid - 128) * 8 + F.wave, 128 * 8);
}

constexpr int NPH_LAYER = 10, NPHASES = 1 + DEPTH * NPH_LAYER + 1;
struct Args { const float* in[26]; float* out; unsigned char* ws; int ph_lo, ph_hi; };
static_assert(sizeof(Args) == 26 * 8 + 8 + 8 + 8, "Args has no padding");

__global__ void __launch_bounds__(512, 2) trunk_fwd(Args args) {
    extern __shared__ __attribute__((aligned(16))) unsigned char lds_raw[];
    Ctx F;
    F.lds = (LAS unsigned char*)lds_raw; F.ws = args.ws; F.in = args.in; F.out = args.out;
    F.tid = threadIdx.x; F.lane = F.tid & 63; F.wave = __builtin_amdgcn_readfirstlane(F.tid >> 6); F.G = gridDim.x; F.bid = blockIdx.x;
    volatile LAS unsigned* MISC = (volatile LAS unsigned*)(F.lds + MISC_OFF);
    if (F.tid < 64) MISC[F.tid] = 0u;
    __syncthreads();
    gu32* ctl = (gu32*)(F.ws + WS_CTL);
#if MK_PER_PHASE
#define GRID_BAR() do { } while (0)
#else
    XcdBarrier bar = xcd_barrier_post((unsigned*)(ctl + CW_BAR), MISC + 8);
#define GRID_BAR() xcd_barrier(bar)
#endif
#define LAUNDER() do { unsigned char* w_ = args.ws; float* o_ = args.out; int b_ = blockIdx.x, g_ = gridDim.x; asm volatile("" : "+s"(w_), "+s"(o_), "+s"(b_), "+s"(g_)); F.ws = w_; F.out = o_; F.bid = b_; F.G = g_; } while (0)
    const int lo = args.ph_lo, hi = args.ph_hi;
#ifndef PH_MASK
#define PH_MASK 0xFFFFu
#endif
#define IN(k) (lo <= (k) && (k) < hi)
#define EN(j) ((PH_MASK >> (j)) & 1u)
#ifndef DUP_MASK
#define DUP_MASK 0x0u
#endif
#define DUP(j) ((int)((DUP_MASK >> (j)) & 1u))
#define BOTH(k) (IN(k) && IN((k) + 1))
    if (EN(10) && IN(0)) { for (int rep_ = 0; rep_ <= DUP(10); ++rep_) { LAUNDER(); p0_prologue(F); if (rep_ < DUP(10) || BOTH(0)) GRID_BAR(); } }
    for (int l = 0; l < DEPTH; ++l) {
        const int pb = 1 + NPH_LAYER * l;
        { int t_ = threadIdx.x; asm volatile("" : "+v"(t_)); F.tid = t_; F.lane = t_ & 63; F.wave = __builtin_amdgcn_readfirstlane(t_ >> 6); }
        { unsigned char* w_ = args.ws; float* o_ = args.out; asm volatile("" : "+s"(w_), "+s"(o_)); F.ws = w_; F.out = o_; }
        unsigned char* wl = F.ws + WS_W + (size_t)l * W_LAYER;
        const float* modl = (const float*)(F.ws + WS_MOD) + (size_t)l * 12 * MODW;
        if (EN(0) && IN(pb + 0)) { for (int rep_ = 0; rep_ <= DUP(0); ++rep_) { LAUNDER(); norm_phase(F, F.in[11] + (size_t)l * D, modl, 0, D, l == 0 ? F.in[0] : (const float*)(F.ws + WS_X)); if (rep_ < DUP(0) || BOTH(pb + 0)) GRID_BAR(); } }
        if (EN(1) && IN(pb + 1)) { for (int rep_ = 0; rep_ <= DUP(1); ++rep_) { LAUNDER();
            pg8::Gemm gm{(const pg8::bf16_t*)(F.ws + WS_H), (const pg8::bf16_t*)(wl + W_WIN), MP, NINP, D}; pg8::SplitOrder S; S.init(MPR, NINP, D, 1, F.G, F.bid); S.npn = NINP / 256 - 1;
            pg8::EpiZ E{(pg8::bf16_t*)(F.ws + WS_Z), (const float*)(F.ws + WS_BIN) + (size_t)l * NINP, (float*)(F.ws + WS_G)};
            pg8::gemm_phase<pg8::EpiZ, pg8::SplitOrder, true, true>(F.lds + RING_OFF, gm, S, E);
            if (rep_ < DUP(1) || BOTH(pb + 1)) GRID_BAR();
        } }
        if (EN(2) && IN(pb + 2)) { for (int rep_ = 0; rep_ <= DUP(2); ++rep_) { LAUNDER(); prep_phase(F, l); if (rep_ < DUP(2) || BOTH(pb + 2)) GRID_BAR(); } }
        if (EN(3) && IN(pb + 3)) { for (int rep_ = 0; rep_ <= DUP(3); ++rep_) { LAUNDER(); scan_phase(F, l); if (rep_ < DUP(3) || BOTH(pb + 3)) GRID_BAR(); } }
        if (EN(4) && IN(pb + 4)) { for (int rep_ = 0; rep_ <= DUP(4); ++rep_) { LAUNDER(); headnorm_phase(F, l); if (rep_ < DUP(4) || BOTH(pb + 4)) GRID_BAR(); } }
        if (EN(5) && IN(pb + 5)) { for (int rep_ = 0; rep_ <= DUP(5); ++rep_) { LAUNDER();
            { pg8::Gemm gm{(const pg8::bf16_t*)(F.ws + WS_KA), (const pg8::bf16_t*)(wl + W_WBB), MP, D, D}; pg8::SplitOrder S; S.init(MPR, D, D, 1, F.G, F.bid);
              pg8::EpiGateTmp E{(const pg8::bf16_t*)(F.ws + WS_Z) + ZGB, (pg8::bf16_t*)(F.ws + WS_HB)};
              pg8::gemm_phase<pg8::EpiGateTmp, pg8::SplitOrder, true, true>(F.lds + RING_OFF, gm, S, E); }
            VM_WAIT(); __syncthreads();
            { pg8::Gemm gm{(const pg8::bf16_t*)(F.ws + WS_QA), (const pg8::bf16_t*)(wl + W_WBA), MP, D, D}; pg8::SplitOrder S; S.init(MPR, D, D, 1, F.G, F.bid);
              pg8::EpiMerge E{(const pg8::bf16_t*)(F.ws + WS_Z) + ZGA, (const pg8::bf16_t*)(F.ws + WS_HB), (pg8::bf16_t*)(F.ws + WS_QB)};
              pg8::gemm_phase<pg8::EpiMerge, pg8::SplitOrder, true, true>(F.lds + RING_OFF, gm, S, E); }
            if (rep_ < DUP(5) || BOTH(pb + 5)) GRID_BAR();
        } }
        if (EN(6) && IN(pb + 6)) { for (int rep_ = 0; rep_ <= DUP(6); ++rep_) { LAUNDER();
            pg8::Gemm gm{(const pg8::bf16_t*)(F.ws + WS_QB), (const pg8::bf16_t*)(wl + W_WO), MP, D, D}; pg8::SplitOrder S; S.init(MPR, D, D, 4, F.G, F.bid);
            pg8::EpiResid E{(float*)(F.ws + (rep_ < DUP(6) ? WS_HB : WS_X)), modl + 2 * D, l == 0 ? F.in[0] : (const float*)(F.ws + WS_X)};
            pg8::gemm_phase<pg8::EpiResid, pg8::SplitOrder, true, true>(F.lds + RING_OFF, gm, S, E);
            if (rep_ < DUP(6) || BOTH(pb + 6)) GRID_BAR();
        } }
        if (EN(7) && IN(pb + 7)) { for (int rep_ = 0; rep_ <= DUP(7); ++rep_) { LAUNDER(); norm_phase(F, F.in[12] + (size_t)l * D, modl, 3 * D, 4 * D, (const float*)(F.ws + WS_X)); if (rep_ < DUP(7) || BOTH(pb + 7)) GRID_BAR(); } }
        if (EN(8) && IN(pb + 8)) { for (int rep_ = 0; rep_ <= DUP(8); ++rep_) { LAUNDER();
            pg8::Gemm gm{(const pg8::bf16_t*)(F.ws + WS_H), (const pg8::bf16_t*)(wl + W_WUP), MP, DFF, D}; pg8::SplitOrder S; S.init(MPR, DFF, D, 1, F.G, F.bid);
            pg8::EpiRelu2 E{(pg8::bf16_t*)(F.ws + WS_Z), DFF};
            pg8::gemm_phase<pg8::EpiRelu2, pg8::SplitOrder, true, true>(F.lds + RING_OFF, gm, S, E);
            if (rep_ < DUP(8) || BOTH(pb + 8)) GRID_BAR();
        } }
        if (EN(9) && IN(pb + 9)) { for (int rep_ = 0; rep_ <= DUP(9); ++rep_) { LAUNDER();
            pg8::Gemm gm{(const pg8::bf16_t*)(F.ws + WS_Z), (const pg8::bf16_t*)(wl + W_WDN), MP, D, DFF}; pg8::SplitOrder S; S.init(MPR, D, DFF, 16, F.G, F.bid, 4);
            pg8::EpiResid E{(float*)(F.ws + (rep_ < DUP(9) ? WS_HB : WS_X)), modl + 5 * D, (const float*)(F.ws + WS_X)};
            pg8::gemm_phase<pg8::EpiResid, pg8::SplitOrder, true, true>(F.lds + RING_OFF, gm, S, E);
            if (rep_ < DUP(9) || BOTH(pb + 9)) GRID_BAR();
        } }
    }
    if (EN(11) && IN(NPHASES - 1)) final_norm_phase(F);
#undef IN
#undef BOTH
}

extern "C" void kernel_launch(void* const* d_in, const int* in_sizes, int n_in, void* d_out, int out_size, void* d_ws, size_t ws_size, hipStream_t stream) {
    static int grid = 0;
    if (grid == 0) {
        if (n_in != 26 || (size_t)out_size != O_END || ws_size < WS_END) { fprintf(stderr, "kernel_launch: shape mismatch: n_in %d out %d (want %zu) ws %zu (want %zu)\n", n_in, out_size, (size_t)O_END, ws_size, (size_t)WS_END); grid = -1; return; }
        int dev = 0, cus = 0, per_cu = 0;
        if (hipGetDevice(&dev) != hipSuccess || hipDeviceGetAttribute(&cus, hipDeviceAttributeMultiprocessorCount, dev) != hipSuccess) { grid = -1; return; }
        if (hipFuncSetAttribute((const void*)trunk_fwd, hipFuncAttributeMaxDynamicSharedMemorySize, LDS_BYTES) != hipSuccess) { fprintf(stderr, "kernel_launch: hipFuncSetAttribute failed\n"); grid = -1; return; }
        if (hipOccupancyMaxActiveBlocksPerMultiprocessor(&per_cu, (const void*)trunk_fwd, 512, LDS_BYTES) != hipSuccess || per_cu < 1) fprintf(stderr, "kernel_launch: occupancy query says %d\n", per_cu);
        (void)hipGetLastError();
        grid = cus;
    }
    if (grid < 0) return;
    (void)in_sizes;
    if (hipMemsetAsync((char*)d_ws + WS_CTL, 0, CTL_ZERO_BYTES, stream) != hipSuccess) { fprintf(stderr, "kernel_launch: memset failed\n"); return; }
    Args a{};
    for (int i = 0; i < 26; ++i) a.in[i] = (const float*)d_in[i];
    a.out = (float*)d_out; a.ws = (unsigned char*)d_ws;
#if MK_PER_PHASE
    for (int p = 0; p < NPHASES; ++p) { a.ph_lo = p; a.ph_hi = p + 1; hipLaunchKernelGGL(trunk_fwd, dim3(grid), dim3(512), LDS_BYTES, stream, a); }
#else
    a.ph_lo = 0; a.ph_hi = NPHASES;
    hipLaunchKernelGGL(trunk_fwd, dim3(grid), dim3(512), LDS_BYTES, stream, a);
#endif
    const hipError_t le = hipPeekAtLastError();
    if (le != hipSuccess) fprintf(stderr, "kernel_launch: launch failed: %s\n", hipGetErrorName(le));
}
```

```cpp
#include <hip/hip_runtime.h>
#include <cstdio>
#include <cstdint>
#ifndef MK_PER_PHASE
#define MK_PER_PHASE 0
#endif
namespace pg8 {
#define PG8_LAS __attribute__((address_space(3)))
typedef unsigned short bf16_t;
typedef short bf16x8 __attribute__((ext_vector_type(8)));
typedef float f32x4 __attribute__((ext_vector_type(4)));
typedef unsigned u32x4 __attribute__((ext_vector_type(4)));
constexpr int BM = 256, BK = 64, HALF = 128, HTB = HALF * BK * 2  , STAGE_BYTES = 8 * HTB, NXCD = 8, WGM = 8;

__host__ __device__ __forceinline__ int lds_byte(int r, int c) { const int st = (r >> 4) * 2 + (c >> 5), rr = r & 15, cc = c & 31, ob = rr * 64 + cc * 2; return st * 1024 + (ob ^ (((ob >> 9) & 1) << 5)); }
__host__ __device__ __forceinline__ void stage_rc(int b, int& R, int& C) { const int st = b / 1024, sb = b % 1024, swz = sb ^ (((sb >> 9) & 1) << 5); R = (st >> 1) * 16 + swz / 64; C = (st & 1) * 32 + (swz % 64) / 2; }
__host__ __device__ __forceinline__ int perm32(int rho) { const int n = rho >> 4, i = rho & 15; return 8 * (i >> 2) + 4 * n + (i & 3); }

struct Unit { int pm, pn, k0, nt, half, narrow; };
struct Gemm { const bf16_t* A; const bf16_t* Bt; int M, N, K; };

struct StaticOrder {
    int nM, nN, nwg, G, c;
    __host__ __device__ void init(int M, int N, int G_, int c_) { nM = M / BM; nN = N / BM; nwg = nM * nN; G = G_; c = c_; }
    __host__ __device__ __forceinline__ bool next(int i, Unit& u) const {
        const long L = (long)i * G + c; if (L >= nwg) return false;
        int wgid = (int)L; { const int q = nwg / NXCD, r = nwg % NXCD, xcd = wgid % NXCD, off = wgid / NXCD; wgid = (xcd < r ? xcd * (q + 1) : r * (q + 1) + (xcd - r) * q) + off; }
        const int nig = WGM * nN, gid = wgid / nig, fm = gid * WGM, gsz = (nM - fm) < WGM ? (nM - fm) : WGM;
        u.pm = fm + ((wgid % nig) % gsz); u.pn = (wgid % nig) / gsz; return true;
    }
    __device__ __forceinline__ void a_ready(const Unit&) const {}
    __device__ __forceinline__ void done(const Unit&) const {}
};

struct SplitOrder {
    int nM, nN, nwg, G, c, S, ntK, wgm, npn;
    __device__ __forceinline__ void init(int Mfull, int N, int K, int S_, int G_, int c_, int wgm_ = 4) { nM = Mfull / BM; nN = N / BM; nwg = nM * nN; G = G_; c = c_; S = S_; ntK = K / BK; wgm = wgm_; npn = -1; }
    __device__ __forceinline__ bool next(int i, Unit& u) const {
        const long L = (long)i * G + c; const bool full = L < nwg; const int j = full ? 0 : (int)(L - nwg);
        if (!full && j >= nN * S) return false;
        int wgid = full ? (int)L : 0; { const int q = nwg / NXCD, r = nwg % NXCD, xcd = wgid % NXCD, off = wgid / NXCD; wgid = (xcd < r ? xcd * (q + 1) : r * (q + 1) + (xcd - r) * q) + off; }
        const int nig = wgm * nN, gid = wgid / nig, fm = gid * wgm, gsz = (nM - fm) < wgm ? (nM - fm) : wgm;
        const int pm_f = fm + ((wgid % nig) % gsz), pn_f = (wgid % nig) / gsz;
        const int nts = ntK / S;
        const int pm = full ? pm_f : nM, pn = full ? pn_f : (j % nN), k0 = full ? 0 : (j / nN) * nts, nt = full ? ntK : nts, half = full ? 0 : 1;
        u = Unit{pm, pn, k0, nt, half, pn == npn ? 1 : 0}; return true;
    }
    __device__ __forceinline__ void a_ready(const Unit&) const {}
    __device__ __forceinline__ void done(const Unit&) const {}
};

__device__ __forceinline__ unsigned cvt_pk_bf16(float lo, float hi) { unsigned r; asm volatile("v_cvt_pk_bf16_f32 %0, %1, %2" : "=v"(r) : "v"(lo), "v"(hi)); return r; }
typedef float f32x2 __attribute__((ext_vector_type(2)));
template <class Epi, class Sched, bool ALIGN_EPI = false, bool SP2 = false>
__device__ __forceinline__ void gemm_phase(PG8_LAS unsigned char* lds, const Gemm g, const Sched& S, const Epi& E) {
    int tid_ = threadIdx.x; asm volatile("" : "+v"(tid_));
    const int tid = tid_, wid = __builtin_amdgcn_readfirstlane(tid >> 6), lane = tid & 63, wr = wid >> 2, wc = wid & 3, fr = lane & 15, fq = lane >> 4;
    const int K = g.K;
    unsigned voffA[2], voffB[2];
#pragma unroll
    for (int i = 0; i < 2; ++i) { int R, C; stage_rc(tid * 16 + i * 8192, R, C); const int Rb = Epi::PERM ? ((R & ~31) + perm32(R & 31)) : R;
        voffA[i] = (unsigned)(R * K + C) * 2u; voffB[i] = (unsigned)(Rb * K + C) * 2u; }
    const size_t kstep = (size_t)(BK * 2);
    const size_t hstep = (size_t)HALF * K * 2;
    const size_t tstep = 2 * hstep;
    const unsigned ldsw = (unsigned)wid * 1024u;
    const int aoff = lds_byte(wr * 64 + fr, fq * 8), boff = lds_byte(wc * 32 + fr, fq * 8);
#define PG8_SA(b, h) (((b) * 2 + (h)) * HTB)
#define PG8_SB(b, h) ((4 + (b) * 2 + (h)) * HTB)
#define PG8_STAGE(bufoff, gbase, voff) do { _Pragma("unroll") for (int _i = 0; _i < 2; ++_i) \
        __builtin_amdgcn_global_load_lds((const unsigned*)((const char*)(gbase) + (voff)[_i]), (PG8_LAS unsigned*)(lds + (bufoff) + ldsw + _i * 8192), 16, 0, 0); } while (0)
#define PG8_LDA(dst, b, h) do { _Pragma("unroll") for (int m = 0; m < 4; ++m) _Pragma("unroll") for (int k = 0; k < 2; ++k) dst[m][k] = *(const PG8_LAS bf16x8*)(lds + PG8_SA(b, h) + aoff + m * 2048 + k * 1024); } while (0)
#define PG8_LDB(dst, b, h) do { _Pragma("unroll") for (int n = 0; n < 2; ++n) _Pragma("unroll") for (int k = 0; k < 2; ++k) dst[n][k] = *(const PG8_LAS bf16x8*)(lds + PG8_SB(b, h) + boff + n * 2048 + k * 1024); } while (0)
#define PG8_MMA(ai, bj, At, Bt) do { __builtin_amdgcn_s_setprio(1); _Pragma("unroll") for (int m = 0; m < 4; ++m) _Pragma("unroll") for (int n = 0; n < 2; ++n) _Pragma("unroll") for (int k = 0; k < 2; ++k) \
        acc[ai][bj][m][n] = __builtin_amdgcn_mfma_f32_16x16x32_bf16(Bt[n][k], At[m][k], acc[ai][bj][m][n], 0, 0, 0); __builtin_amdgcn_s_setprio(0); } while (0)
#define PG8_WAIT_V(n) asm volatile("s_waitcnt vmcnt(" #n ")" ::: "memory")
#define PG8_WAIT_L(n) asm volatile("s_waitcnt lgkmcnt(" #n ")" ::: "memory")
#define PG8_BAR __builtin_amdgcn_s_barrier()
#define PG8_SCHED __builtin_amdgcn_sched_barrier(0)
    Unit cur, nxt; int ui = 0;
    if (!S.next(0, cur)) return;
    f32x4 acc[2][2][4][2];
#pragma unroll
    for (int a = 0; a < 2; ++a)
#pragma unroll
        for (int b = 0; b < 2; ++b)
#pragma unroll
            for (int m = 0; m < 4; ++m)
#pragma unroll
                for (int n = 0; n < 2; ++n) acc[a][b][m][n] = (f32x4){0.f, 0.f, 0.f, 0.f};
    bf16x8 At[4][2], B0[2][2], B1[2][2];
    const char* cA = (const char*)g.A + (size_t)cur.pm * tstep + (size_t)cur.k0 * kstep; const char* cB = (const char*)g.Bt + (size_t)cur.pn * tstep + (size_t)cur.k0 * kstep;
    S.a_ready(cur);
    if constexpr (SP2) {
        PG8_STAGE(PG8_SB(0, 0), cB, voffB); PG8_STAGE(PG8_SB(0, 1), cB + hstep, voffB); PG8_STAGE(PG8_SA(0, 0), cA, voffA); PG8_STAGE(PG8_SA(0, 1), cA + hstep, voffA);
        if (wr == 1) PG8_BAR;
        PG8_WAIT_V(2); PG8_BAR;
        PG8_STAGE(PG8_SB(1, 0), cB + kstep, voffB); PG8_STAGE(PG8_SA(1, 0), cA + kstep, voffA); PG8_STAGE(PG8_SB(1, 1), cB + hstep + kstep, voffB);
        PG8_WAIT_V(6); PG8_BAR;
    } else {
        PG8_STAGE(PG8_SB(0, 0), cB, voffB); PG8_STAGE(PG8_SA(0, 0), cA, voffA); PG8_STAGE(PG8_SB(0, 1), cB + hstep, voffB); PG8_STAGE(PG8_SA(0, 1), cA + hstep, voffA);
        if (wr == 1) PG8_BAR;
        PG8_WAIT_V(4); PG8_BAR;
        PG8_STAGE(PG8_SB(1, 0), cB + kstep, voffB); PG8_STAGE(PG8_SA(1, 0), cA + kstep, voffA); PG8_STAGE(PG8_SB(1, 1), cB + hstep + kstep, voffB);
        PG8_WAIT_V(6); PG8_BAR;
    }
    for (;;) {
        const bool has_next = S.next(ui + 1, nxt);
        const char* nA = has_next ? (const char*)g.A + (size_t)nxt.pm * tstep + (size_t)nxt.k0 * kstep : cA; const char* nB = has_next ? (const char*)g.Bt + (size_t)nxt.pn * tstep + (size_t)nxt.k0 * kstep : cB;
        const int nt = cur.nt;
#ifdef PROBE_KTWICE
        _Pragma("nounroll") for (int pass_ = 0; pass_ < 2; ++pass_) { const char* nA_ = pass_ == 0 ? cA : nA; const char* nB_ = pass_ == 0 ? cB : nB;
#else
        { const char* nA_ = nA; const char* nB_ = nB;
#endif
        for (int t = 0; t < nt; t += 2) {
            const bool last = (t == nt - 2);
            const char* a1 = cA + (size_t)(t + 1) * kstep;
            const char* a2 = last ? nA_ : cA + (size_t)(t + 2) * kstep; const char* b2 = last ? nB_ : cB + (size_t)(t + 2) * kstep;
            const char* a3 = a2 + kstep; const char* b3 = b2 + kstep;
            if (last && has_next) S.a_ready(nxt);
            if constexpr (SP2) {
            PG8_LDB(B0, 0, 0); PG8_LDB(B1, 0, 1); PG8_SCHED; PG8_LDA(At, 0, 0); PG8_STAGE(PG8_SA(1, 1), a1 + hstep, voffA);
            PG8_WAIT_V(8); PG8_WAIT_L(0); PG8_BAR; PG8_MMA(0, 0, At, B0); PG8_MMA(0, 1, At, B1); PG8_BAR; PG8_SCHED;
            PG8_LDA(At, 0, 1); PG8_STAGE(PG8_SB(0, 0), b2, voffB); PG8_STAGE(PG8_SB(0, 1), b2 + hstep, voffB); PG8_STAGE(PG8_SA(0, 0), a2, voffA);
            PG8_WAIT_V(8); PG8_WAIT_L(0); PG8_BAR; PG8_MMA(1, 0, At, B0); PG8_MMA(1, 1, At, B1); PG8_BAR; PG8_SCHED;
            PG8_LDB(B0, 1, 0); PG8_LDB(B1, 1, 1); PG8_SCHED; PG8_LDA(At, 1, 0); PG8_STAGE(PG8_SA(0, 1), a2 + hstep, voffA);
            PG8_WAIT_V(8); PG8_WAIT_L(0); PG8_BAR; PG8_MMA(0, 0, At, B0); PG8_MMA(0, 1, At, B1); PG8_BAR; PG8_SCHED;
            PG8_LDA(At, 1, 1); PG8_STAGE(PG8_SB(1, 0), b3, voffB); PG8_STAGE(PG8_SB(1, 1), b3 + hstep, voffB); PG8_STAGE(PG8_SA(1, 0), a3, voffA);
            PG8_WAIT_V(8); PG8_WAIT_L(0); PG8_BAR; PG8_MMA(1, 0, At, B0); PG8_MMA(1, 1, At, B1); PG8_BAR; PG8_SCHED;
            } else {
            PG8_LDB(B0, 0, 0); PG8_SCHED; PG8_LDA(At, 0, 0); PG8_STAGE(PG8_SA(1, 1), a1 + hstep, voffA);
            PG8_WAIT_L(8); PG8_BAR; PG8_WAIT_L(0); PG8_MMA(0, 0, At, B0); PG8_BAR; PG8_SCHED;
            PG8_LDB(B1, 0, 1); PG8_STAGE(PG8_SB(0, 0), b2, voffB);
            PG8_BAR; PG8_WAIT_L(0); PG8_MMA(0, 1, At, B1); PG8_BAR;
            PG8_LDA(At, 0, 1); PG8_STAGE(PG8_SA(0, 0), a2, voffA);
            PG8_BAR; PG8_WAIT_L(0); PG8_MMA(1, 0, At, B0); PG8_BAR; PG8_SCHED;
            PG8_STAGE(PG8_SB(0, 1), b2 + hstep, voffB);
            PG8_WAIT_V(6); PG8_BAR; PG8_MMA(1, 1, At, B1); PG8_BAR;
            PG8_LDB(B0, 1, 0); PG8_SCHED; PG8_LDA(At, 1, 0); PG8_STAGE(PG8_SA(0, 1), a2 + hstep, voffA);
            PG8_WAIT_L(8); PG8_BAR; PG8_WAIT_L(0); PG8_MMA(0, 0, At, B0); PG8_BAR; PG8_SCHED;
            PG8_LDB(B1, 1, 1); PG8_STAGE(PG8_SB(1, 0), b3, voffB);
            PG8_BAR; PG8_WAIT_L(0); PG8_MMA(0, 1, At, B1); PG8_BAR;
            PG8_LDA(At, 1, 1); PG8_STAGE(PG8_SA(1, 0), a3, voffA);
            PG8_BAR; PG8_WAIT_L(0); PG8_MMA(1, 0, At, B0); PG8_BAR; PG8_SCHED;
            PG8_STAGE(PG8_SB(1, 1), b3 + hstep, voffB);
            PG8_WAIT_V(6); PG8_BAR; PG8_MMA(1, 1, At, B1); PG8_BAR;
            }
        }
        }
#ifdef PROBE_KTWICE
        _Pragma("unroll") for (int a_ = 0; a_ < 2; ++a_) _Pragma("unroll") for (int b_ = 0; b_ < 2; ++b_) _Pragma("unroll") for (int m_ = 0; m_ < 4; ++m_) _Pragma("unroll") for (int n_ = 0; n_ < 2; ++n_) acc[a_][b_][m_][n_] = acc[a_][b_][m_][n_] * 0.5f;
#endif
        if constexpr (ALIGN_EPI) { if (wr == 0) PG8_BAR; }
        if constexpr (!Epi::AFTER_DRAIN) { E(acc, cur, wr, wc, fr, fq);
#ifdef PROBE_EPI_TWICE
            if constexpr (Epi::IDEMPOTENT) { asm volatile("" ::: "memory"); E(acc, cur, wr, wc, fr, fq); }
#endif
            S.done(cur); }
        if (!has_next) break;
#pragma unroll
        for (int a = 0; a < 2; ++a)
#pragma unroll
            for (int b = 0; b < 2; ++b)
#pragma unroll
                for (int m = 0; m < 4; ++m)
#pragma unroll
                    for (int n = 0; n < 2; ++n) acc[a][b][m][n] = (f32x4){0.f, 0.f, 0.f, 0.f};
        cur = nxt; cA = nA; cB = nB; ++ui;
        if constexpr (ALIGN_EPI) { if (wr == 1) PG8_BAR; }
    }
    PG8_WAIT_V(0);
    if constexpr (!ALIGN_EPI) { if (wr == 0) PG8_BAR; }
    PG8_BAR;
    if constexpr (Epi::AFTER_DRAIN) { E.fused(acc, cur, wr, wc, fr, fq, lds, wid, lane); S.done(cur); }
#undef PG8_SA
#undef PG8_SB
#undef PG8_STAGE
#undef PG8_LDA
#undef PG8_LDB
#undef PG8_MMA
#undef PG8_WAIT_V
#undef PG8_WAIT_L
#undef PG8_BAR
#undef PG8_SCHED
}
}

constexpr int D = 2048, NB = 4, SEQ = 4096, DEPTH = 4, NSB = 8, SSEQ = 16;
constexpr int MPR = NB * SEQ;
constexpr int MS = NSB * SSEQ;
constexpr int M = MPR + MS;
constexpr int MP = 16640;
constexpr int NIN = 20496, NINP = 20736;
constexpr int DFF = 8192;
constexpr int ZQK = 0, ZVA = 4096, ZOA = 6144, ZQB = 8192, ZFB = 10240, ZIB = 12288, ZOGB = 14336, ZGA = 16384, ZGB = 18432, ZGT = 20480;
constexpr int MODW = 6 * D;
constexpr float EPS = 1e-6f;
constexpr int NCHUNKS = NB * (SEQ / 64) + NSB;

__device__ __forceinline__ int row_batch(int r) { int b = r < MPR ? (r >> 12) : 4 + ((r - MPR) >> 4); return b > 11 ? 11 : b; }
__device__ __forceinline__ float bf2f(unsigned short b) { return __uint_as_float(((unsigned)b) << 16); }
__device__ __forceinline__ float sigm(float x) { return __builtin_amdgcn_rcpf(1.0f + __expf(-x)); }

namespace pg8 {
__device__ __forceinline__ void unpack8(const u32x4 w, float (&f)[8]) {
    f[0] = __uint_as_float(w.x << 16); f[1] = __uint_as_float(w.x & 0xffff0000u); f[2] = __uint_as_float(w.y << 16); f[3] = __uint_as_float(w.y & 0xffff0000u);
    f[4] = __uint_as_float(w.z << 16); f[5] = __uint_as_float(w.z & 0xffff0000u); f[6] = __uint_as_float(w.w << 16); f[7] = __uint_as_float(w.w & 0xffff0000u);
}
struct EpiZ {
    static constexpr bool PERM = true, AFTER_DRAIN = false, IDEMPOTENT = true;
    bf16_t* Z; const float* bias; float* G;
    __device__ __forceinline__ void operator()(const f32x4 (&acc)[2][2][4][2], const Unit& u, int wr, int wc, int fr, int fq) const {
        const int row0 = u.pm * BM + wr * 64 + fr, col0 = u.pn * BM + wc * 32 + 8 * fq;
        const bool gates = (u.pn == 80) && (wc == 0) && (fq < 2);
        const f32x4 bb[2][2] = {{*(const f32x4*)(bias + col0), *(const f32x4*)(bias + col0 + 4)}, {*(const f32x4*)(bias + col0 + HALF), *(const f32x4*)(bias + col0 + HALF + 4)}};
#pragma unroll
        for (int bj = 0; bj < 2; ++bj) {
            const f32x4 b0 = bb[bj][0], b1 = bb[bj][1];
#pragma unroll
            for (int ai = 0; ai < 2; ++ai)
#pragma unroll
                for (int m = 0; m < 4; ++m) { const int row = row0 + ai * HALF + m * 16; bf16_t* rowp = Z + (size_t)row * NINP + col0;
                    const f32x4 v0 = acc[ai][bj][m][0] + b0, v1 = acc[ai][bj][m][1] + b1;
                    u32x4 w; w.x = cvt_pk_bf16(v0[0], v0[1]); w.y = cvt_pk_bf16(v0[2], v0[3]); w.z = cvt_pk_bf16(v1[0], v1[1]); w.w = cvt_pk_bf16(v1[2], v1[3]);
                    *(u32x4*)(rowp + bj * HALF) = w;
                    if (bj == 0 && gates) { float* gp = G + (size_t)row * 16 + 8 * fq; *(f32x4*)gp = v0; *(f32x4*)(gp + 4) = v1; } }
        }
    }
};
struct EpiGateTmp {
    static constexpr bool PERM = true, AFTER_DRAIN = false, IDEMPOTENT = false;
    const bf16_t* Zg; bf16_t* T;
    __device__ __forceinline__ void operator()(const f32x4 (&acc)[2][2][4][2], const Unit& u, int wr, int wc, int fr, int fq) const {
        const int row0 = u.pm * BM + wr * 64 + fr, col0 = u.pn * BM + wc * 32 + 8 * fq;
#pragma unroll
        for (int ai = 0; ai < 2; ++ai) {
            u32x4 gz[4][2];
#pragma unroll
            for (int m = 0; m < 4; ++m)
#pragma unroll
                for (int bj = 0; bj < 2; ++bj) gz[m][bj] = *(const u32x4*)(Zg + (size_t)(row0 + ai * HALF + m * 16) * NINP + col0 + bj * HALF);
#pragma unroll
            for (int m = 0; m < 4; ++m) { const int row = row0 + ai * HALF + m * 16;
#pragma unroll
                for (int bj = 0; bj < 2; ++bj) { const int c = col0 + bj * HALF; float gf[8]; unpack8(gz[m][bj], gf);
                    f32x4 v0 = acc[ai][bj][m][0], v1 = acc[ai][bj][m][1];
#pragma unroll
                    for (int j = 0; j < 4; ++j) { v0[j] *= sigm(gf[j]); v1[j] *= sigm(gf[4 + j]); }
                    u32x4 w; w.x = cvt_pk_bf16(v0[0], v0[1]); w.y = cvt_pk_bf16(v0[2], v0[3]); w.z = cvt_pk_bf16(v1[0], v1[1]); w.w = cvt_pk_bf16(v1[2], v1[3]);
                    *(u32x4*)(T + (size_t)row * D + c) = w; } }
            asm volatile("" ::: "memory");
        }
    }
};
struct EpiMerge {
    static constexpr bool PERM = true, AFTER_DRAIN = false, IDEMPOTENT = false;
    const bf16_t* Zg; const bf16_t* T; bf16_t* O;
    __device__ __forceinline__ void operator()(const f32x4 (&acc)[2][2][4][2], const Unit& u, int wr, int wc, int fr, int fq) const {
        const int row0 = u.pm * BM + wr * 64 + fr, col0 = u.pn * BM + wc * 32 + 8 * fq;
#pragma unroll
        for (int ai = 0; ai < 2; ++ai)
#pragma unroll
            for (int mp = 0; mp < 2; ++mp) {
                u32x4 gz[2][2], tz[2][2];
#pragma unroll
                for (int mm = 0; mm < 2; ++mm)
#pragma unroll
                    for (int bj = 0; bj < 2; ++bj) { const int row = row0 + ai * HALF + (2 * mp + mm) * 16, c = col0 + bj * HALF; gz[mm][bj] = *(const u32x4*)(Zg + (size_t)row * NINP + c);
                        tz[mm][bj] = *(const u32x4*)(T + (size_t)row * D + c); }
#pragma unroll
                for (int mm = 0; mm < 2; ++mm)
#pragma unroll
                    for (int bj = 0; bj < 2; ++bj) { const int m = 2 * mp + mm, row = row0 + ai * HALF + m * 16, c = col0 + bj * HALF; float gf[8]; unpack8(gz[mm][bj], gf);
                        float tf[8]; unpack8(tz[mm][bj], tf); f32x4 v0, v1;
#pragma unroll
                        for (int j = 0; j < 4; ++j) { v0[j] = tf[j] + acc[ai][bj][m][0][j] * sigm(gf[j]); v1[j] = tf[4 + j] + acc[ai][bj][m][1][j] * sigm(gf[4 + j]); }
                        u32x4 w; w.x = cvt_pk_bf16(v0[0], v0[1]); w.y = cvt_pk_bf16(v0[2], v0[3]); w.z = cvt_pk_bf16(v1[0], v1[1]); w.w = cvt_pk_bf16(v1[2], v1[3]);
                        *(u32x4*)(O + (size_t)row * D + c) = w; }
                asm volatile("" ::: "memory");
            }
    }
};
struct EpiResid {
    static constexpr bool PERM = false, AFTER_DRAIN = false, IDEMPOTENT = false;
    float* X; const float* gate; const float* Xsrc;
    __device__ __forceinline__ void operator()(const f32x4 (&acc)[2][2][4][2], const Unit& u, int wr, int wc, int fr, int fq) const {
        const int row0 = u.pm * BM + wr * 64 + fr, col0 = u.pn * BM + wc * 32 + 4 * fq;
        if (!u.half) {
            const float* gp = gate + (size_t)row_batch(u.pm * BM) * MODW + col0;
            const f32x4 gv[2][2] = {{*(const f32x4*)gp, *(const f32x4*)(gp + 16)}, {*(const f32x4*)(gp + HALF), *(const f32x4*)(gp + HALF + 16)}};
#pragma unroll
            for (int ai = 0; ai < 2; ++ai) {
                f32x4 xv[4][2][2];
#pragma unroll
                for (int m = 0; m < 4; ++m)
#pragma unroll
                    for (int bj = 0; bj < 2; ++bj)
#pragma unroll
                        for (int n = 0; n < 2; ++n) xv[m][bj][n] = *(const f32x4*)(Xsrc + (size_t)(row0 + ai * HALF + m * 16) * D + col0 + bj * HALF + n * 16);
#pragma unroll
                for (int m = 0; m < 4; ++m)
#pragma unroll
                    for (int bj = 0; bj < 2; ++bj)
#pragma unroll
                        for (int n = 0; n < 2; ++n) *(f32x4*)(X + (size_t)(row0 + ai * HALF + m * 16) * D + col0 + bj * HALF + n * 16) = xv[m][bj][n] + gv[bj][n] * acc[ai][bj][m][n];
                asm volatile("" ::: "memory");
            }
        } else {
#pragma unroll
            for (int m = 0; m < 4; ++m) { const int row = row0 + m * 16; const float* gp = gate + (size_t)row_batch(row) * MODW + col0; float* xp = X + (size_t)row * D + col0;
#pragma unroll
                for (int bj = 0; bj < 2; ++bj)
#pragma unroll
                    for (int n = 0; n < 2; ++n) { const int o = bj * HALF + n * 16; const f32x4 d = *(const f32x4*)(gp + o) * acc[0][bj][m][n];
#pragma unroll
                        for (int e = 0; e < 4; ++e) __hip_atomic_fetch_add(xp + o + e, d[e], __ATOMIC_RELAXED, __HIP_MEMORY_SCOPE_AGENT); } }
        }
    }
};
struct EpiRelu2 {
    static constexpr bool PERM = true, AFTER_DRAIN = false, IDEMPOTENT = true;
    bf16_t* O; int ldc;
    __device__ __forceinline__ void operator()(const f32x4 (&acc)[2][2][4][2], const Unit& u, int wr, int wc, int fr, int fq) const {
        const int row0 = u.pm * BM + wr * 64 + fr, col0 = u.pn * BM + wc * 32 + 8 * fq;
#pragma unroll
        for (int ai = 0; ai < 2; ++ai)
#pragma unroll
            for (int m = 0; m < 4; ++m) { bf16_t* rowp = O + (size_t)(row0 + ai * HALF + m * 16) * ldc + col0;
#pragma unroll
                for (int bj = 0; bj < 2; ++bj) { f32x4 v0 = acc[ai][bj][m][0], v1 = acc[ai][bj][m][1];
#pragma unroll
                    for (int j = 0; j < 4; ++j) { const float a = fmaxf(v0[j], 0.f), b = fmaxf(v1[j], 0.f); v0[j] = a * a; v1[j] = b * b; }
                    u32x4 w; w.x = cvt_pk_bf16(v0[0], v0[1]); w.y = cvt_pk_bf16(v0[2], v0[3]); w.z = cvt_pk_bf16(v1[0], v1[1]); w.w = cvt_pk_bf16(v1[2], v1[3]);
                    *(u32x4*)(rowp + bj * HALF) = w; } }
    }
};
}

constexpr size_t MiB = 1u << 20;
constexpr size_t WS_CTL = 0, CTL_ZERO_BYTES = 1 * MiB;
constexpr size_t WS_MOD = 1 * MiB;
constexpr size_t WS_LB = 4 * MiB;
constexpr size_t WS_BIN = 4 * MiB + 65536;
constexpr size_t WS_E1 = 5 * MiB, WS_E2 = 8 * MiB;
constexpr size_t WS_G = 11 * MiB;
constexpr size_t WS_W = 16 * MiB;
constexpr size_t W_WIN = 0, W_WBA = 81 * MiB, W_WBB = 89 * MiB, W_WO = 97 * MiB, W_WUP = 105 * MiB, W_WDN = 137 * MiB, W_LAYER = 169 * MiB;
constexpr size_t WS_X = 692 * MiB;
constexpr size_t WS_H = 822 * MiB;
constexpr size_t WS_Z = 887 * MiB;
constexpr size_t WS_QA = 1546 * MiB;
constexpr size_t WS_KA = 1611 * MiB;
constexpr size_t WS_QB = 1676 * MiB;
constexpr size_t WS_KB = 1741 * MiB;
constexpr size_t WS_HA = 1806 * MiB;
constexpr size_t WS_HB = 1936 * MiB;
constexpr size_t WS_GP = 2066 * MiB;
constexpr size_t WS_END = 2072 * MiB;
static_assert((size_t)NINP * D * 2 <= 81 * MiB && (size_t)MP * NINP * 2 <= (WS_QA - WS_Z) && (size_t)MP * D * 2 == 65 * MiB && WS_W + 4 * W_LAYER <= WS_X, "ws map");
#ifndef CONV_SPLIT_V
#define CONV_SPLIT_V 21632
#endif
constexpr int CONV_SPLIT = CONV_SPLIT_V;
constexpr int CW_BAR = 4096;

constexpr size_t O_YP = 0, O_YS = O_YP + (size_t)MPR * D, O_CONVP = O_YS + (size_t)MS * D, O_CP = O_CONVP + (size_t)DEPTH * NB * 3 * 4096,
    O_NP = O_CP + (size_t)DEPTH * NB * 8 * 65536, O_MP = O_NP + (size_t)DEPTH * NB * 8 * 256, O_SP = O_MP + (size_t)DEPTH * NB * 8,
    O_CONVS = O_SP + (size_t)DEPTH * NB * 16 * 16384, O_CS = O_CONVS + (size_t)DEPTH * NSB * 3 * 4096, O_NS = O_CS + (size_t)DEPTH * NSB * 8 * 65536,
    O_MS = O_NS + (size_t)DEPTH * NSB * 8 * 256, O_SS = O_MS + (size_t)DEPTH * NSB * 8, O_END = O_SS + (size_t)DEPTH * NSB * 16 * 16384;

constexpr int RING_OFF = 0, RING_BYTES = 131072;
constexpr int LDS_BYTES = 155648;
constexpr int MISC_OFF = LDS_BYTES - 256;
constexpr int SC_Q = 0, SC_K = 33792, SC_VT = 67584, SC_VW = 79104, SC_CT = 90624, SC_P = 132864, SC_H = 142080, SC_END = 151296;
constexpr int LQB = 528;
constexpr int LVB = 144;
constexpr int HS_Q = 0, HS_K = 17408, HS_VT = 34816, HS_ST = 44032, HS_P = 61440, HS_H = 70656;
constexpr int LHB = 272;
static_assert(SC_END <= MISC_OFF, "LDS map");

#define GAS __attribute__((address_space(1)))
#define LAS __attribute__((address_space(3)))
#define DI __device__ __forceinline__
typedef unsigned short bf16;
typedef float f32x4 __attribute__((ext_vector_type(4)));
typedef unsigned u32x2 __attribute__((ext_vector_type(2)));
typedef unsigned u32x4 __attribute__((ext_vector_type(4)));
typedef short bf16x8 __attribute__((ext_vector_type(8)));
typedef GAS unsigned gu32;
#define RLX_AGENT __ATOMIC_RELAXED, __HIP_MEMORY_SCOPE_AGENT
#define LDS_WAIT() asm volatile("s_waitcnt lgkmcnt(0)" ::: "memory")
#define VM_WAIT() asm volatile("s_waitcnt vmcnt(0)" ::: "memory")
DI unsigned f2bf(float f) { unsigned u = __float_as_uint(f); return (u + 0x7fffu + ((u >> 16) & 1u)) >> 16; }
DI unsigned pk2(float lo, float hi) { return f2bf(lo) | (f2bf(hi) << 16); }
DI float wave_sum(float v) {
#pragma unroll
    for (int o = 1; o < 64; o <<= 1) v += __shfl_xor(v, o);
    return v;
}
#define LBAR() do { asm volatile("s_waitcnt lgkmcnt(0)" ::: "memory"); __builtin_amdgcn_s_barrier(); asm volatile("" ::: "memory"); } while (0)
DI unsigned cvtpk(float lo, float hi) { unsigned r; asm volatile("v_cvt_pk_bf16_f32 %0, %1, %2" : "=v"(r) : "v"(lo), "v"(hi)); return r; }
DI float logsig(float x) { return fminf(x, 0.f) - __logf(1.0f + __expf(-fabsf(x))); }
#define XB_TMO      128
#define XB_XCNT(j)  (256  + 64 * (j))
#define XB_XSUB(j)  (1280 + 64 * (j))
#define XB_XGEN(j)  (2304 + 64 * (j))
#define XB_TOP      3328
#define XB_TOPGEN   3392
#define XCD_BAR_WORDS 3456
#define XB_SPIN_CAP (1u << 18)

__device__ __forceinline__ unsigned xb_ld(unsigned* p)              { return __hip_atomic_load(p, __ATOMIC_RELAXED, __HIP_MEMORY_SCOPE_AGENT); }
__device__ __forceinline__ unsigned xb_add(unsigned* p, unsigned v) { return __hip_atomic_fetch_add(p, v, __ATOMIC_RELAXED, __HIP_MEMORY_SCOPE_AGENT); }
__device__ __forceinline__ unsigned xb_xcc_id() { return (unsigned)__builtin_amdgcn_s_getreg((3 << 11) | 20) & 0xFu; }
#define XB_SPIN(cond, bar) do { unsigned _sp = 0; while (cond) { __builtin_amdgcn_s_sleep(1); \
    if ((++_sp & 255u) == 0u) { if (xb_ld(&(bar)[XB_TMO])) break; if (_sp > XB_SPIN_CAP) { atomicAdd(&(bar)[XB_TMO], 1u); break; } } } } while (0)

__device__ __forceinline__ bool xb_tid0() { int t = threadIdx.x; asm volatile("" : "+v"(t)); return t == 0; }
struct XcdBarrier {
    unsigned* bar; unsigned x;
    volatile LAS unsigned* st;
};

__device__ __forceinline__ XcdBarrier xcd_barrier_post(unsigned* bar, volatile LAS unsigned* st) {
    XcdBarrier b; b.bar = bar; b.x = xb_xcc_id(); b.st = st;
    if (xb_tid0()) (void)xb_add(&bar[XB_XCNT(b.x)], 1u);
    return b;
}
__device__ __forceinline__ void xcd_barrier_complete(unsigned* bar, unsigned x, unsigned& nloc, unsigned& nx) {
    const unsigned G = gridDim.x * gridDim.y * gridDim.z;
    unsigned sum, cnt, mine, sp = 0u;
    for (;;) {
        sum = 0u; cnt = 0u; mine = 0u;
#pragma unroll
        for (unsigned j = 0; j < 16; ++j) { const unsigned c = xb_ld(&bar[XB_XCNT(j)]); sum += c; cnt += (c > 0u) ? 1u : 0u; mine = (j == x) ? c : mine; }
        if (sum == G) break;
        __builtin_amdgcn_s_sleep(1);
        if ((++sp & 255u) == 0u) { if (xb_ld(&bar[XB_TMO])) break; if (sp > XB_SPIN_CAP) { atomicAdd(&bar[XB_TMO], 1u); break; } }
    }
    nloc = mine > 0u ? mine : 1u; nx = cnt > 0u ? cnt : 1u;
}

__device__ __forceinline__ void xcd_barrier(const XcdBarrier& b) {
    asm volatile("s_waitcnt vmcnt(0)" ::: "memory");
    __syncthreads();
    if (xb_tid0()) {
        unsigned* bar = b.bar;
        __builtin_amdgcn_s_waitcnt(0);
        unsigned nloc = b.st[0], nx = b.st[1];
        if (nloc == 0u) { xcd_barrier_complete(bar, b.x, nloc, nx); b.st[0] = nloc; b.st[1] = nx; }
        const unsigned old = xb_add(&bar[XB_XSUB(b.x)], 1u);
        const unsigned gen = old / nloc;
        if (old + 1u == (gen + 1u) * nloc) {
            __builtin_amdgcn_fence(__ATOMIC_RELEASE, "agent");
            asm volatile("s_waitcnt vmcnt(0)" ::: "memory");
            const unsigned og = xb_add(&bar[XB_TOP], 1u);
            const unsigned tg = og / nx;
            if (og + 1u == (tg + 1u) * nx) xb_add(&bar[XB_TOPGEN], 1u);
            else XB_SPIN(xb_ld(&bar[XB_TOPGEN]) == tg, bar);
            __builtin_amdgcn_fence(__ATOMIC_ACQUIRE, "agent");
            xb_add(&bar[XB_XGEN(b.x)], 1u);
            asm volatile("s_waitcnt vmcnt(0)" ::: "memory");
        } else {
            XB_SPIN(xb_ld(&bar[XB_XGEN(b.x)]) == gen, bar);
            __builtin_amdgcn_fence(__ATOMIC_ACQUIRE, "agent");
            asm volatile("s_waitcnt vmcnt(0)" ::: "memory");
        }
    }
    __syncthreads();
}

struct Ctx { LAS unsigned char* lds; unsigned char* ws; const float* const* in; float* out; int tid, lane, wave, G, bid; };

struct TItem { const float* W; bf16* WT; int K, Nsrc, k0, n0; };
DI void p0_item_decode(const Ctx& F, int it, TItem& t) {
    constexpr int I0 = 32 * (NINP / 64), I1 = 32 * 32, I4 = 32 * 128, I5 = 128 * 32, IL = I0 + 3 * I1 + I4 + I5;
    const int l = it / IL; int r = it % IL; unsigned char* wl = F.ws + WS_W + (size_t)l * W_LAYER; const float* const* in = F.in;
    const float* W; bf16* WT; int K, Nsrc, Npad;
    if (r < I0) { W = in[13] + (size_t)l * D * NIN; WT = (bf16*)(wl + W_WIN); K = D; Nsrc = NIN; Npad = NINP; }
    else if ((r -= I0) < I1) { W = in[20] + (size_t)l * D * D; WT = (bf16*)(wl + W_WBA); K = D; Nsrc = D; Npad = D; }
    else if ((r -= I1) < I1) { W = in[21] + (size_t)l * D * D; WT = (bf16*)(wl + W_WBB); K = D; Nsrc = D; Npad = D; }
    else if ((r -= I1) < I1) { W = in[22] + (size_t)l * D * D; WT = (bf16*)(wl + W_WO); K = D; Nsrc = D; Npad = D; }
    else if ((r -= I1) < I4) { W = in[23] + (size_t)l * D * DFF; WT = (bf16*)(wl + W_WUP); K = D; Nsrc = DFF; Npad = DFF; }
    else { r -= I4; W = in[24] + (size_t)l * DFF * D; WT = (bf16*)(wl + W_WDN); K = DFF; Nsrc = D; Npad = D; }
    const int nblk = Npad / 64; t.W = W; t.WT = WT; t.K = K; t.Nsrc = Nsrc; t.k0 = 64 * (r / nblk); t.n0 = 64 * (r % nblk);
}
DI void p0_item_load(const TItem& t, int lane, f32x4 (&v)[16]) {
    const int nq = lane & 15, kr = lane >> 4, n = t.n0 + 4 * nq; const bool ok = n < t.Nsrc;
#pragma unroll
    for (int i = 0; i < 16; ++i) v[i] = ok ? *(const GAS f32x4*)(t.W + (size_t)(t.k0 + 4 * i + kr) * t.Nsrc + n) : (f32x4){0.f, 0.f, 0.f, 0.f};
}
DI void p0_item_store(const TItem& t, int lane, const f32x4 (&v)[16], LAS float* scr) {
    const int nq = lane & 15, kr = lane >> 4;
#pragma unroll
    for (int i = 0; i < 16; ++i) { LAS float* s = scr + (4 * i + kr) * 65 + 4 * nq; s[0] = v[i].x; s[1] = v[i].y; s[2] = v[i].z; s[3] = v[i].w; }
    LDS_WAIT(); asm volatile("" ::: "memory");
#pragma unroll
    for (int j = 0; j < 8; ++j) { const int pr = lane + 64 * j, nn = pr >> 3, c = pr & 7; const LAS float* s = scr + (8 * c) * 65 + nn;
        u32x4 o; o.x = cvtpk(s[0 * 65], s[1 * 65]); o.y = cvtpk(s[2 * 65], s[3 * 65]); o.z = cvtpk(s[4 * 65], s[5 * 65]); o.w = cvtpk(s[6 * 65], s[7 * 65]);
        *(GAS u32x4*)(t.WT + (size_t)(t.n0 + nn) * t.K + t.k0 + 8 * c) = o; }
    LDS_WAIT(); asm volatile("" ::: "memory");
}

DI void p0_convert_weights(const Ctx& F, int first, int NIT, int w, int nw) {
    LAS float* scr = (LAS float*)(F.lds + F.wave * 16640);
    f32x4 va[16], vb[16]; TItem ta, tb;
    int it = first + w;
    if (it < NIT) { p0_item_decode(F, it, ta); p0_item_load(ta, F.lane, va); }
    while (it < NIT) {
        const int itn = it + nw;
        if (itn < NIT) { p0_item_decode(F, itn, tb); p0_item_load(tb, F.lane, vb); }
        p0_item_store(ta, F.lane, va, scr);
        it = itn; if (it >= NIT) break;
        const int itn2 = it + nw;
        if (itn2 < NIT) { p0_item_decode(F, itn2, ta); p0_item_load(ta, F.lane, va); }
        p0_item_store(tb, F.lane, vb, scr);
        it = itn2;
    }
}

DI void p0_prologue(const Ctx& F) {
    const float* const* in = F.in;
    const int gw = F.bid * 8 + F.wave, NGW = F.G * 8;
    const int gt = F.bid * 512 + F.tid, NGT = F.G * 512;
    {
        LAS float* csT = (LAS float*)F.lds;
        LAS float* red = (LAS float*)(F.lds + 98304);
        for (int i = F.tid; i < 12 * D; i += 512) { const int r = i / D, k = i % D; const float c = r < 4 ? in[7][r * D + k] : in[8][(r - 4) * D + k]; csT[k * 12 + r] = c * sigm(c); }
        __syncthreads();
        float* MOD = (float*)(F.ws + WS_MOD);
        for (int u = F.bid; u < DEPTH * (MODW / 256); u += F.G) {
            const int l = u / (MODW / 256), j0 = (u % (MODW / 256)) * 256;
            const float* wp = in[9] + (size_t)l * D * MODW + (size_t)(256 * F.wave) * MODW + j0 + 4 * F.lane;
            f32x4 acc[12];
#pragma unroll
            for (int r = 0; r < 12; ++r) acc[r] = (f32x4){0.f, 0.f, 0.f, 0.f};
#pragma unroll 8
            for (int k = 0; k < 256; ++k) { const f32x4 w = *(const GAS f32x4*)(wp + (size_t)k * MODW); const LAS f32x4* cp = (const LAS f32x4*)(csT + (256 * F.wave + k) * 12);
                const f32x4 c0 = cp[0], c1 = cp[1], c2 = cp[2];
                acc[0] += w * c0[0]; acc[1] += w * c0[1]; acc[2] += w * c0[2]; acc[3] += w * c0[3]; acc[4] += w * c1[0]; acc[5] += w * c1[1]; acc[6] += w * c1[2]; acc[7] += w * c1[3];
                acc[8] += w * c2[0]; acc[9] += w * c2[1]; acc[10] += w * c2[2]; acc[11] += w * c2[3]; }
#pragma unroll
            for (int hf = 0; hf < 2; ++hf) {
#pragma unroll
                for (int r = 0; r < 6; ++r) *(LAS f32x4*)(red + ((F.wave * 6 + r) * 256 + 4 * F.lane)) = acc[6 * hf + r];
                __syncthreads();
                for (int i = F.tid; i < 6 * 256; i += 512) { const int r = i / 256, c = i % 256; float s = 0.f;
#pragma unroll
                    for (int w = 0; w < 8; ++w) s += red[(w * 6 + r) * 256 + c];
                    MOD[((size_t)l * 12 + 6 * hf + r) * MODW + j0 + c] = s + in[10][(size_t)l * MODW + j0 + c]; }
                __syncthreads();
            }
        }
    }
    { constexpr int IL = 32 * (NINP / 64) + 3 * 32 * 32 + 32 * 128 + 128 * 32;
      if (F.G != 256) p0_convert_weights(F, 0, DEPTH * IL, gw, NGW);
      else { p0_convert_weights(F, 0, IL, gw, NGW);
#pragma unroll 1
             for (int l = 1; l < DEPTH; ++l) p0_convert_weights(F, l * IL + CONV_SPLIT, (l + 1) * IL, gw, NGW); } }
    {
        f32x4* Xs = (f32x4*)(F.ws + WS_X) + (size_t)MPR * D / 4; const f32x4* xs = (const f32x4*)in[1];
        for (size_t i = gt; i < (size_t)MS * D / 4; i += NGT) Xs[i] = xs[i];
        const size_t pad0 = (size_t)M * D * 2 / 16, pad1 = (size_t)MP * D * 2 / 16;
        u32x4* h4 = (u32x4*)(F.ws + WS_H); u32x4* a4 = (u32x4*)(F.ws + WS_QA); u32x4* b4 = (u32x4*)(F.ws + WS_KA);
        for (size_t i = pad0 + gt; i < pad1; i += NGT) { const u32x4 z = {0u, 0u, 0u, 0u}; h4[i] = z; a4[i] = z; b4[i] = z; }
    }
    {
        float* LB = (float*)(F.ws + WS_LB);
        for (int d = gt; d < 2048; d += NGT) { float r[4], mx = -1e30f;
#pragma unroll
            for (int l = 0; l < 4; ++l) { r[l] = in[18][l * 2048 + d]; mx = fmaxf(mx, r[l]); }
            float e[4], s = 0.f;
#pragma unroll
            for (int l = 0; l < 4; ++l) { e[l] = __expf(r[l] - mx); s += e[l]; }
            const float inv = 1.0f / s; float cum = 0.f;
#pragma unroll
            for (int l = 0; l < 4; ++l) { if (l > 0) cum += e[l] * inv; LB[l * 2048 + d] = cum; } }
        float* BIN = (float*)(F.ws + WS_BIN);
        for (int i = gt; i < DEPTH * NINP; i += NGT) { const int l = i / NINP, c = i % NINP; BIN[i] = c < NIN ? in[14][(size_t)l * NIN + c] : 0.f; }
    }
}

DI void norm_phase(const Ctx& F, const float* gain, const float* modl  , int sh_off, int sc_off, const float* Xp  ) {
    const int gw = F.bid * 8 + F.wave, NGW = F.G * 8;
    const float* X = (const float*)(F.ws + WS_X); bf16* H = (bf16*)(F.ws + WS_H);
    f32x4 v[8], nv[8];
#define NM_LOAD(row_, V_) do { const GAS f32x4* xr_ = (const GAS f32x4*)(((row_) < MPR ? Xp : X) + (size_t)(row_) * D) + F.lane; _Pragma("unroll") for (int j = 0; j < 8; ++j) V_[j] = xr_[64 * j]; } while (0)
    int row = gw;
    if (row < M) NM_LOAD(row, v);
    for (; row < M; row += NGW) {
        const int nrow = row + NGW;
        if (nrow < M) NM_LOAD(nrow, nv);
        float ss = 0.f;
#pragma unroll
        for (int j = 0; j < 8; ++j) ss += (v[j].x * v[j].x + v[j].y * v[j].y) + (v[j].z * v[j].z + v[j].w * v[j].w);
        const float rs = rsqrtf(wave_sum(ss) * (1.0f / D) + EPS);
        const float* mb = modl + (size_t)row_batch(row) * MODW;
        GAS u32x2* o8 = (GAS u32x2*)(H + (size_t)row * D) + F.lane;
#pragma unroll
        for (int j = 0; j < 8; ++j) { const int c = 4 * F.lane + 256 * j; const f32x4 g = *(const f32x4*)(gain + c), sc = *(const f32x4*)(mb + sc_off + c), sh = *(const f32x4*)(mb + sh_off + c);
            const f32x4 y = (v[j] * rs) * g * (sc + 1.0f) + sh; u32x2 w; w.x = cvtpk(y.x, y.y); w.y = cvtpk(y.z, y.w); o8[64 * j] = w; }
#pragma unroll
        for (int j = 0; j < 8; ++j) v[j] = nv[j];
    }
#undef NM_LOAD
}
DI void final_norm_phase(const Ctx& F) {
    const int gw = F.bid * 8 + F.wave, NGW = F.G * 8;
    const float* X = (const float*)(F.ws + WS_X); const float* gain = F.in[25];
    for (int row = gw; row < M; row += NGW) {
        const GAS f32x4* xr = (const GAS f32x4*)(X + (size_t)row * D) + F.lane;
        f32x4 v[8]; float ss = 0.f;
#pragma unroll
        for (int j = 0; j < 8; ++j) { v[j] = xr[64 * j]; ss += (v[j].x * v[j].x + v[j].y * v[j].y) + (v[j].z * v[j].z + v[j].w * v[j].w); }
        const float rs = rsqrtf(wave_sum(ss) * (1.0f / D) + EPS);
        GAS f32x4* o = (GAS f32x4*)(F.out + (size_t)row * D) + F.lane;
#pragma unroll
        for (int j = 0; j < 8; ++j) { const f32x4 g = *(const f32x4*)(gain + 4 * F.lane + 256 * j); o[64 * j] = (v[j] * rs) * g; }
    }
}

DI void prep_phase(const Ctx& F, int l) {
    const bf16* Z = (const bf16*)(F.ws + WS_Z);
    bf16* QA = (bf16*)(F.ws + WS_QA); bf16* KA = (bf16*)(F.ws + WS_KA); bf16* QB = (bf16*)(F.ws + WS_QB); bf16* KB = (bf16*)(F.ws + WS_KB);
    float* E1 = (float*)(F.ws + WS_E1); float* E2 = (float*)(F.ws + WS_E2);
    const float* LB = (const float*)(F.ws + WS_LB) + l * 2048;
    constexpr int NGC = 12, CR = 8, NCONV = M / CR, NHG = NCHUNKS * 8;
    const float* G = (const float*)(F.ws + WS_G); float* GP = (float*)(F.ws + WS_GP);
    const bool split = F.G > 2 * NGC;
    if (F.bid < NGC) {
        const int chain = F.bid * 8 + F.wave, lane = F.lane;
        const bool sample = chain >= 32; const int cc = sample ? chain - 32 : chain, b = cc >> 3, h = cc & 7;
        const int row0 = sample ? MPR + b * SSEQ : b * SEQ, nchunk = sample ? 1 : SEQ / 64, Tv = sample ? SSEQ : 64;
        float m_prev = sample ? F.in[5][((size_t)l * NSB + b) * 8 + h] : 0.f;
        float nig = lane < Tv ? G[(size_t)(row0 + lane) * 16 + h] : -1e30f, nfg = lane < Tv ? G[(size_t)(row0 + lane) * 16 + 8 + h] : 0.f;
        for (int c = 0; c < nchunk; ++c) {
            const int r0 = row0 + 64 * c; const float igv = nig, fgv = nfg;
            if (c + 1 < nchunk) { nig = G[(size_t)(r0 + 64 + lane) * 16 + h]; nfg = G[(size_t)(r0 + 64 + lane) * 16 + 8 + h]; }
            const float lfv = lane < Tv ? logsig(fgv) : 0.f;
            float bc = lfv;
#pragma unroll
            for (int o = 1; o < 64; o <<= 1) { const float y = __shfl_up(bc, o); if (lane >= o) bc += y; }
            float gm = igv - bc;
#pragma unroll
            for (int o = 1; o < 64; o <<= 1) { const float y = __shfl_up(gm, o); if (lane >= o) gm = fmaxf(gm, y); }
            const float mt = bc + fmaxf(gm, m_prev);
            const float winter = __expf(bc + m_prev - mt), enm = __expf(-mt);
            const float m_last = __shfl(mt, 63), b_last = __shfl(bc, 63);
            const float wlast = __expf(b_last - bc + igv - m_last);
            if (lane < Tv) { float* gp = GP + ((size_t)h * MP + (r0 + lane)) * 8;   *(f32x4*)gp = (f32x4){bc - mt, igv - bc, winter, enm}; *(f32x4*)(gp + 4) = (f32x4){wlast, mt, 0.f, 0.f}; }
            m_prev = m_last;
        }
        if (split) return;
    }
    const int nb = split ? F.G - NGC : F.G, me = split ? F.bid - NGC : F.bid;
    {
        const int c0 = 8 * F.tid;
        float w[4][8], cb[8];
#pragma unroll
        for (int j = 0; j < 4; ++j) { const f32x4 a = *(const f32x4*)(F.in[15] + ((size_t)l * 4 + j) * 4096 + c0), b = *(const f32x4*)(F.in[15] + ((size_t)l * 4 + j) * 4096 + c0 + 4);
            w[j][0] = a.x; w[j][1] = a.y; w[j][2] = a.z; w[j][3] = a.w; w[j][4] = b.x; w[j][5] = b.y; w[j][6] = b.z; w[j][7] = b.w; }
        { const f32x4 a = *(const f32x4*)(F.in[16] + (size_t)l * 4096 + c0), b = *(const f32x4*)(F.in[16] + (size_t)l * 4096 + c0 + 4);
            cb[0] = a.x; cb[1] = a.y; cb[2] = a.z; cb[3] = a.w; cb[4] = b.x; cb[5] = b.y; cb[6] = b.z; cb[7] = b.w; }
        u32x4 cur[CR + 3], nxt[CR + 3];
#define CV_LOAD(it_, V_) do { const int r0_ = (it_) * CR; const bool hist_ = (r0_ >= MPR) ? (((r0_ - MPR) & (SSEQ - 1)) != 0) : ((r0_ & (SEQ - 1)) != 0); \
        _Pragma("unroll") for (int j = 0; j < CR + 3; ++j) V_[j] = (j >= 3 || hist_) ? *(const GAS u32x4*)(Z + (size_t)(r0_ - 3 + j) * NINP + c0) : (u32x4){0u, 0u, 0u, 0u}; } while (0)
        int it = me;
        if (it < NCONV) CV_LOAD(it, cur);
        for (; it < NCONV; it += nb) {
            const int itn = it + nb;
            if (itn < NCONV) CV_LOAD(itn, nxt);
            const int r0 = it * CR; const bool sample = r0 >= MPR;
            const int t0 = sample ? ((r0 - MPR) & (SSEQ - 1)) : (r0 & (SEQ - 1)); const int bs = sample ? (r0 - MPR) >> 4 : (r0 >> 12);
            float z0[8], z1[8], z2[8];
            if (t0 == 0 && sample) { const float* cc = F.in[2] + (((size_t)l * NSB + bs) * 3) * 4096 + c0;
#pragma unroll
                for (int e = 0; e < 8; ++e) { z0[e] = cc[e]; z1[e] = cc[4096 + e]; z2[e] = cc[8192 + e]; } }
            else { pg8::unpack8(cur[0], z0); pg8::unpack8(cur[1], z1); pg8::unpack8(cur[2], z2); }
            const bool last = sample ? (t0 + CR == SSEQ) : (t0 + CR == SEQ);
            float* cout = F.out + (sample ? O_CONVS + (((size_t)l * NSB + bs) * 3) * 4096 : O_CONVP + (((size_t)l * NB + bs) * 3) * 4096) + c0;
#pragma unroll
            for (int rr = 0; rr < CR; ++rr) {
                float z3[8]; pg8::unpack8(cur[3 + rr], z3);
                float y[8];
#pragma unroll
                for (int e = 0; e < 8; ++e) { const float a = cb[e] + w[0][e] * z0[e] + w[1][e] * z1[e] + w[2][e] * z2[e] + w[3][e] * z3[e]; y[e] = a * sigm(a); }
                if (c0 < 2048) { u32x4 o; o.x = cvtpk(y[0], y[1]); o.y = cvtpk(y[2], y[3]); o.z = cvtpk(y[4], y[5]); o.w = cvtpk(y[6], y[7]); *(GAS u32x4*)(QA + (size_t)(r0 + rr) * D + c0) = o; }
                else { u32x4 o; o.x = cvtpk(y[0] * 0.0625f, y[1] * 0.0625f); o.y = cvtpk(y[2] * 0.0625f, y[3] * 0.0625f); o.z = cvtpk(y[4] * 0.0625f, y[5] * 0.0625f); o.w = cvtpk(y[6] * 0.0625f, y[7] * 0.0625f);
                    *(GAS u32x4*)(KA + (size_t)(r0 + rr) * D + (c0 - 2048)) = o; }
                if (last && rr >= CR - 3) { float* cp = cout + (size_t)(rr - (CR - 3)) * 4096; *(f32x4*)cp = (f32x4){z3[0], z3[1], z3[2], z3[3]}; *(f32x4*)(cp + 4) = (f32x4){z3[4], z3[5], z3[6], z3[7]}; }
#pragma unroll
                for (int e = 0; e < 8; ++e) { z0[e] = z1[e]; z1[e] = z2[e]; z2[e] = z3[e]; }
            }
#pragma unroll
            for (int j = 0; j < CR + 3; ++j) cur[j] = nxt[j];
        }
#undef CV_LOAD
    }
    {
        const int d = F.tid & 255, hf = F.tid >> 8;
        LAS unsigned char* FBs = F.lds; LAS unsigned char* QBs = F.lds + 32768; LAS float* xch = (LAS float*)(F.lds + 65536);
        u32x4 pf[4], pq[4];
#define HG_LOAD(hi_) do { const int ci_ = (hi_) >> 3, cb_ = ((hi_) & 7) * 256; const bool sm_ = ci_ >= NB * 64; const int r0_ = sm_ ? MPR + (ci_ - NB * 64) * 16 : ci_ * 64, Tv_ = sm_ ? 16 : 64; \
        _Pragma("unroll") for (int i = 0; i < 4; ++i) { const int idx = F.tid + 512 * i, rr = idx >> 5, sg = idx & 31; \
            if (rr < Tv_) { pf[i] = *(const GAS u32x4*)(Z + (size_t)(r0_ + rr) * NINP + ZFB + cb_ + 8 * sg); pq[i] = *(const GAS u32x4*)(Z + (size_t)(r0_ + rr) * NINP + ZQB + cb_ + 8 * sg); } } } while (0)
        int hi = (me + 56) % nb;
        if (hi < NHG) HG_LOAD(hi);
        for (; hi < NHG; hi += nb) {
            const int ci = hi >> 3, cbase = (hi & 7) * 256;
            const bool sample = ci >= NB * 64; const int r0 = sample ? MPR + (ci - NB * 64) * 16 : ci * 64; const int Tv = sample ? 16 : 64;
#pragma unroll
            for (int i = 0; i < 4; ++i) { const int idx = F.tid + 512 * i, rr = idx >> 5, sg = idx & 31;
                if (rr < Tv) { *(LAS u32x4*)(FBs + rr * 512 + sg * 16) = pf[i]; *(LAS u32x4*)(QBs + rr * 512 + sg * 16) = pq[i]; } }
            LBAR();
            if (hi + nb < NHG) HG_LOAD(hi + nb);
            const float lb = LB[cbase + d], oml = 1.0f - lb;
            float bc[32], sg[32]; float run = 0.f;
#pragma unroll
            for (int i = 0; i < 32; ++i) { const int t = 32 * hf + i; sg[i] = 0.f;
                if (t < Tv) { const float fb = fminf(fmaxf(bf2f(*(const LAS unsigned short*)(FBs + t * 512 + d * 2)), -30.f), 30.f); sg[i] = __builtin_amdgcn_rcpf(1.0f + __expf(-fb)); const float f = lb + oml * sg[i]; run += fmaxf(__logf(f), -60.0f); }
                bc[i] = run; }
            if (hf == 0) xch[d] = run;
            LBAR();
            const float base = hf ? xch[d] : 0.f; const float bR = hf ? base : run;
            if (hf) { E1[(size_t)ci * 2048 + cbase + d] = __expf(bR); E2[(size_t)ci * 2048 + cbase + d] = __expf(run); }
#pragma unroll
            for (int i = 0; i < 32; ++i) { const int t = 32 * hf + i;
                if (t < Tv) { const float qv = bf2f(*(const LAS unsigned short*)(QBs + t * 512 + d * 2)), bt = base + bc[i];
                    const float ed = __expf(fminf(fmaxf(bt - bR, -80.f), 80.f));
                    const float q = qv * sigm(qv) * ed, k = oml * (1.0f - sg[i]) * __builtin_amdgcn_rcpf(ed);
                    *(LAS unsigned short*)(QBs + t * 512 + d * 2) = (unsigned short)(cvtpk(q, q) & 0xffffu); *(LAS unsigned short*)(FBs + t * 512 + d * 2) = (unsigned short)(cvtpk(k, k) & 0xffffu); } }
            LBAR();
#pragma unroll
            for (int i = 0; i < 4; ++i) { const int idx = F.tid + 512 * i, rr = idx >> 5, sg = idx & 31;
                if (rr < Tv) { *(GAS u32x4*)(QB + (size_t)(r0 + rr) * D + cbase + 8 * sg) = *(const LAS u32x4*)(QBs + rr * 512 + sg * 16);
                               *(GAS u32x4*)(KB + (size_t)(r0 + rr) * D + cbase + 8 * sg) = *(const LAS u32x4*)(FBs + rr * 512 + sg * 16); } }
            LBAR();
        }
#undef HG_LOAD
    }
}

DI void headnorm_phase(const Ctx& F, int l) {
    const int gw = F.bid * 8 + F.wave, NGW = F.G * 8;
    const bf16* Z = (const bf16*)(F.ws + WS_Z); const bf16* HA = (const bf16*)(F.ws + WS_HA); const bf16* HB = (const bf16*)(F.ws + WS_HB);
    bf16* YA = (bf16*)(F.ws + WS_QA); bf16* YB = (bf16*)(F.ws + WS_KA);
    const float* ga = F.in[17] + (size_t)l * 2048; const float* gb = F.in[19] + (size_t)l * 2048;
    u32x4 ha[4], hb[4], oa[4], ob[4], na[4], nb[4], noa[4], nob[4];
#define HN_LOAD(row_, A_, B_, OA_, OB_) do { _Pragma("unroll") for (int j = 0; j < 4; ++j) { const int c_ = 512 * j + 8 * F.lane; \
        A_[j] = *(const GAS u32x4*)(HA + (size_t)(row_) * D + c_); B_[j] = *(const GAS u32x4*)(HB + (size_t)(row_) * D + c_); \
        OA_[j] = *(const GAS u32x4*)(Z + (size_t)(row_) * NINP + ZOA + c_); OB_[j] = *(const GAS u32x4*)(Z + (size_t)(row_) * NINP + ZOGB + c_); } } while (0)
    int row = gw;
    if (row < M) HN_LOAD(row, ha, hb, oa, ob);
    for (; row < M; row += NGW) {
        const int nrow = row + NGW;
        if (nrow < M) HN_LOAD(nrow, na, nb, noa, nob);
#pragma unroll
        for (int j = 0; j < 4; ++j) { const int c = 512 * j + 8 * F.lane;
            { float hv[8], ov[8]; pg8::unpack8(ha[j], hv); pg8::unpack8(oa[j], ov); float ss = 0.f;
#pragma unroll
              for (int e = 0; e < 8; ++e) ss += hv[e] * hv[e];
#pragma unroll
              for (int o = 1; o < 32; o <<= 1) ss += __shfl_xor(ss, o);
              const float rs = rsqrtf(ss * (1.0f / 256.0f) + EPS); const f32x4 g0 = *(const f32x4*)(ga + c), g1 = *(const f32x4*)(ga + c + 4); float y[8];
#pragma unroll
              for (int e = 0; e < 8; ++e) y[e] = hv[e] * rs * (e < 4 ? g0[e] : g1[e - 4]) * sigm(ov[e]);
              u32x4 w; w.x = cvtpk(y[0], y[1]); w.y = cvtpk(y[2], y[3]); w.z = cvtpk(y[4], y[5]); w.w = cvtpk(y[6], y[7]); *(GAS u32x4*)(YA + (size_t)row * D + c) = w; }
            { float hv[8], ov[8]; pg8::unpack8(hb[j], hv); pg8::unpack8(ob[j], ov); float ss = 0.f;
#pragma unroll
              for (int e = 0; e < 8; ++e) ss += hv[e] * hv[e];
#pragma unroll
              for (int o = 1; o < 16; o <<= 1) ss += __shfl_xor(ss, o);
              const float rs = rsqrtf(ss * (1.0f / 128.0f) + EPS); const f32x4 g0 = *(const f32x4*)(gb + c), g1 = *(const f32x4*)(gb + c + 4); float y[8];
#pragma unroll
              for (int e = 0; e < 8; ++e) y[e] = hv[e] * rs * (e < 4 ? g0[e] : g1[e - 4]) * sigm(ov[e]);
              u32x4 w; w.x = cvtpk(y[0], y[1]); w.y = cvtpk(y[2], y[3]); w.z = cvtpk(y[4], y[5]); w.w = cvtpk(y[6], y[7]); *(GAS u32x4*)(YB + (size_t)row * D + c) = w; }
        }
#pragma unroll
        for (int j = 0; j < 4; ++j) { ha[j] = na[j]; hb[j] = nb[j]; oa[j] = noa[j]; ob[j] = nob[j]; }
    }
#undef HN_LOAD
}

DI bf16x8 frag(const LAS unsigned char* base, int row, int ldb, int kbyte) { return *(const LAS bf16x8*)(base + row * ldb + kbyte); }
DI bf16x8 frag_t(const LAS unsigned char* base, int k0, int ldb, int col) {
    const LAS unsigned short* p = (const LAS unsigned short*)(base + k0 * ldb + col * 2); bf16x8 r;
#pragma unroll
    for (int j = 0; j < 8; ++j) r[j] = (short)p[j * (ldb / 2)];
    return r;
}
#ifndef PROBE_ST
#define PROBE_ST 1
#endif
#ifndef PROBE_S2
#define PROBE_S2 1
#endif
#ifndef PROBE_S3
#define PROBE_S3 1
#endif
#ifndef PROBE_S4
#define PROBE_S4 1
#endif
#define PROBE_LOOP(n) int reps_ = (n); asm volatile("" : "+s"(reps_)); _Pragma("nounroll") for (int rp_ = 0; rp_ < reps_; ++rp_)
#define MFMA16(a, b, c) __builtin_amdgcn_mfma_f32_16x16x32_bf16((a), (b), (c), 0, 0, 0)

DI void mlstm_unit(LAS unsigned char* lds, const bf16* QA, const bf16* KA, const bf16* Z, const float* GP, bf16* HA,
                   int row0, int nchunk, int Tv, int h, int vs, const float* C0, const float* n0, const float* m0p, float* Cout, float* nout, float* mout) {
    int tid_ = threadIdx.x; asm volatile("" : "+v"(tid_));
    const int tid = tid_, lane = tid & 63, W = __builtin_amdgcn_readfirstlane(tid >> 6), g = lane >> 4, li = lane & 15;
    LAS unsigned char* Qs = lds + SC_Q; LAS unsigned char* Ks = lds + SC_K; LAS unsigned char* VT = lds + SC_VT; LAS unsigned char* VW = lds + SC_VW;
    LAS unsigned char* CTs = lds + SC_CT; LAS unsigned char* Ps = lds + SC_P; LAS unsigned char* Hs = lds + SC_H;
    f32x4 cacc[2][5];
#pragma unroll
    for (int di = 0; di < 2; ++di)
#pragma unroll
        for (int vi = 0; vi < 5; ++vi)
#pragma unroll
            for (int r = 0; r < 4; ++r) { const int d = 16 * (2 * W + di) + 4 * g + r; float v = 0.f;
                if (C0) { if (vi < 4) v = C0[(size_t)d * 256 + 64 * vs + 16 * vi + li]; else if (li == 0) v = n0[d]; }
                cacc[di][vi][r] = v; }
    float m_prev = m0p ? *m0p : 0.f;
    for (int i = tid; i < 16 * 72; i += 512) { const int rr = 64 + i / 72, cc = i % 72;
        *(LAS unsigned short*)(VT + rr * LVB + cc * 2) = (rr == 64 && cc < 64) ? (unsigned short)0x3F80 : (unsigned short)0; *(LAS unsigned short*)(VW + rr * LVB + cc * 2) = 0; }
    u32x4 pq[4], pk[4], pv; f32x4 pg0, pg1;
#define ML_PREFETCH(c) do { const int r0_ = row0 + 64 * (c); \
        _Pragma("unroll") for (int i = 0; i < 4; ++i) { const int idx = tid + 512 * i, rr = idx >> 5, sg = idx & 31; \
            if (rr < Tv) { pq[i] = *(const GAS u32x4*)(QA + (size_t)(r0_ + rr) * D + 256 * h + 8 * sg); pk[i] = *(const GAS u32x4*)(KA + (size_t)(r0_ + rr) * D + 256 * h + 8 * sg); } \
            else { pq[i] = (u32x4){0u, 0u, 0u, 0u}; pk[i] = (u32x4){0u, 0u, 0u, 0u}; } } \
        { const int rr = tid >> 3, sg = tid & 7; pv = rr < Tv ? *(const GAS u32x4*)(Z + (size_t)(r0_ + rr) * NINP + ZVA + 256 * h + 64 * vs + 8 * sg) : (u32x4){0u, 0u, 0u, 0u}; } \
        if (lane < Tv) { const float* gp_ = GP + ((size_t)h * MP + (r0_ + lane)) * 8; pg0 = *(const GAS f32x4*)gp_; pg1 = *(const GAS f32x4*)(gp_ + 4); } \
        else { pg0 = (f32x4){0.f, -1e30f, 0.f, 1.f}; pg1 = (f32x4){0.f, 0.f, 0.f, 0.f}; } } while (0)
    ML_PREFETCH(0);
    for (int c = 0; c < nchunk; ++c) {
        const int r0 = row0 + 64 * c;
        const float gx = pg0[0], gy = pg0[1], winter = pg0[2], enm = pg0[3], wlast = pg1[0];
        const float m_last = __shfl(pg1[1], Tv - 1), decay = __shfl(winter, Tv - 1);
        { PROBE_LOOP(PROBE_ST) { asm volatile("" ::: "memory");
#pragma unroll
        for (int i = 0; i < 4; ++i) { const int idx = tid + 512 * i, rr = idx >> 5, sg = idx & 31; *(LAS u32x4*)(Qs + rr * LQB + sg * 16) = pq[i]; *(LAS u32x4*)(Ks + rr * LQB + sg * 16) = pk[i]; }
        { const int rr = tid >> 3, sg = tid & 7; *(LAS u32x4*)(Ps + rr * LVB + sg * 16) = pv; }
        if (W == 0) *(LAS unsigned short*)(VW + 64 * LVB + lane * 2) = (unsigned short)(cvtpk(wlast, wlast) & 0xffffu);
#pragma unroll
        for (int di = 0; di < 2; ++di)
#pragma unroll
            for (int vi = 0; vi < 5; ++vi) { u32x2 w; w.x = cvtpk(cacc[di][vi][0], cacc[di][vi][1]); w.y = cvtpk(cacc[di][vi][2], cacc[di][vi][3]);
                *(LAS u32x2*)(CTs + (16 * vi + li) * LQB + (16 * (2 * W + di) + 4 * g) * 2) = w; }
        } }
        LBAR();
        {
          const int fp = tid & 31, vq = tid >> 5; const float wa = __shfl(wlast, 2 * fp), wb = __shfl(wlast, 2 * fp + 1);
          const u32x2 pva = *(const LAS u32x2*)(Ps + (2 * fp) * LVB + vq * 8), pvb = *(const LAS u32x2*)(Ps + (2 * fp + 1) * LVB + vq * 8);
          const unsigned a0 = pva.x, a1 = pva.y, b0 = pvb.x, b1 = pvb.y;
          const unsigned r0w = (a0 & 0xffffu) | (b0 << 16), r1w = (a0 >> 16) | (b0 & 0xffff0000u), r2w = (a1 & 0xffffu) | (b1 << 16), r3w = (a1 >> 16) | (b1 & 0xffff0000u);
          const unsigned s0w = cvtpk(__uint_as_float(a0 << 16) * wa, __uint_as_float(b0 << 16) * wb), s1w = cvtpk(__uint_as_float(a0 & 0xffff0000u) * wa, __uint_as_float(b0 & 0xffff0000u) * wb);
          const unsigned s2w = cvtpk(__uint_as_float(a1 << 16) * wa, __uint_as_float(b1 << 16) * wb), s3w = cvtpk(__uint_as_float(a1 & 0xffff0000u) * wa, __uint_as_float(b1 & 0xffff0000u) * wb);
          LAS unsigned char* vt = VT + (4 * vq) * LVB + 4 * fp; LAS unsigned char* vw = VW + (4 * vq) * LVB + 4 * fp;
          *(LAS unsigned*)(vt) = r0w; *(LAS unsigned*)(vt + LVB) = r1w; *(LAS unsigned*)(vt + 2 * LVB) = r2w; *(LAS unsigned*)(vt + 3 * LVB) = r3w;
          *(LAS unsigned*)(vw) = s0w; *(LAS unsigned*)(vw + LVB) = s1w; *(LAS unsigned*)(vw + 2 * LVB) = s2w; *(LAS unsigned*)(vw + 3 * LVB) = s3w; }
        LBAR();
        if (c + 1 < nchunk) ML_PREFETCH(c + 1);
        { PROBE_LOOP(PROBE_S2)
        { asm volatile("" ::: "memory");
            const int tt = W & 3, sh = W >> 2;
            f32x4 sacc[2] = {{0.f, 0.f, 0.f, 0.f}, {0.f, 0.f, 0.f, 0.f}};
#pragma unroll
            for (int kk = 0; kk < 8; ++kk) { const bf16x8 bq = frag(Qs, 16 * tt + li, LQB, 64 * kk + 16 * g);
#pragma unroll
                for (int i = 0; i < 2; ++i) if (2 * sh + i <= tt) { const bf16x8 ak = frag(Ks, 16 * (2 * sh + i) + li, LQB, 64 * kk + 16 * g); sacc[i] = MFMA16(ak, bq, sacc[i]); } }
            const int t = 16 * tt + li; const float xt = __shfl(gx, t);
#pragma unroll
            for (int i = 0; i < 2; ++i) { float p[4];
#pragma unroll
                for (int r = 0; r < 4; ++r) { const int s = 16 * (2 * sh + i) + 4 * g + r; const float ys = __shfl(gy, s);
                    p[r] = (s <= t) ? sacc[i][r] * __expf(xt + ys) : 0.f; }
                u32x2 w; w.x = cvtpk(p[0], p[1]); w.y = cvtpk(p[2], p[3]); *(LAS u32x2*)(Ps + t * LVB + (16 * (2 * sh + i) + 4 * g) * 2) = w; }
        } }
        LBAR();
        { PROBE_LOOP(PROBE_S3)
        { asm volatile("" ::: "memory");
            const int tt = W & 3, vh = W >> 2; const int vt0 = 2 * vh, vt1 = 2 * vh + 1;
            f32x4 a1[3], a2[3];
#pragma unroll
            for (int i = 0; i < 3; ++i) { a1[i] = (f32x4){0.f, 0.f, 0.f, 0.f}; a2[i] = (f32x4){0.f, 0.f, 0.f, 0.f}; }
#pragma unroll
            for (int kk = 0; kk < 2; ++kk) { const bf16x8 ap = frag(Ps, 16 * tt + li, LVB, 64 * kk + 16 * g);
                a1[0] = MFMA16(ap, frag(VT, 16 * vt0 + li, LVB, 64 * kk + 16 * g), a1[0]); a1[1] = MFMA16(ap, frag(VT, 16 * vt1 + li, LVB, 64 * kk + 16 * g), a1[1]);
                a1[2] = MFMA16(ap, frag(VT, 64 + li, LVB, 64 * kk + 16 * g), a1[2]); }
#pragma unroll
            for (int kk = 0; kk < 8; ++kk) { const bf16x8 aq = frag(Qs, 16 * tt + li, LQB, 64 * kk + 16 * g);
                a2[0] = MFMA16(aq, frag(CTs, 16 * vt0 + li, LQB, 64 * kk + 16 * g), a2[0]); a2[1] = MFMA16(aq, frag(CTs, 16 * vt1 + li, LQB, 64 * kk + 16 * g), a2[1]);
                a2[2] = MFMA16(aq, frag(CTs, 64 + li, LQB, 64 * kk + 16 * g), a2[2]); }
#pragma unroll
            for (int r = 0; r < 4; ++r) { const int t = 16 * tt + 4 * g + r; const float wi = __shfl(winter, t), en = __shfl(enm, t);
                const float o2 = a1[2][r] + wi * a2[2][r]; const float qn = __shfl(o2, lane & 48); const float inv = __builtin_amdgcn_rcpf(fmaxf(fabsf(qn), en));
                const unsigned hw = cvtpk((a1[0][r] + wi * a2[0][r]) * inv, (a1[1][r] + wi * a2[1][r]) * inv);
                *(LAS unsigned short*)(Hs + t * LVB + (16 * vt0 + li) * 2) = (unsigned short)(hw & 0xffffu); *(LAS unsigned short*)(Hs + t * LVB + (16 * vt1 + li) * 2) = (unsigned short)(hw >> 16); }
        } }
#pragma unroll
        for (int di = 0; di < 2; ++di)
#pragma unroll
            for (int vi = 0; vi < 5; ++vi) cacc[di][vi] = cacc[di][vi] * decay;
#pragma unroll
        for (int kk = 0; kk < 2; ++kk) { bf16x8 ak[2];
#pragma unroll
            for (int di = 0; di < 2; ++di) ak[di] = frag_t(Ks, 32 * kk + 8 * g, LQB, 16 * (2 * W + di) + li);
#pragma unroll
            for (int vi = 0; vi < 5; ++vi) { const bf16x8 bv = frag(VW, 16 * vi + li, LVB, 64 * kk + 16 * g);
#pragma unroll
                for (int di = 0; di < 2; ++di) cacc[di][vi] = MFMA16(ak[di], bv, cacc[di][vi]); } }
        if (PROBE_S4 > 1) { PROBE_LOOP(PROBE_S4 - 1) { asm volatile("" ::: "memory"); f32x4 dacc[2][5];
#pragma unroll
            for (int di = 0; di < 2; ++di)
#pragma unroll
                for (int vi = 0; vi < 5; ++vi) dacc[di][vi] = (f32x4){0.f, 0.f, 0.f, 0.f};
#pragma unroll
            for (int kk = 0; kk < 2; ++kk) { bf16x8 ak[2];
#pragma unroll
                for (int di = 0; di < 2; ++di) ak[di] = frag_t(Ks, 32 * kk + 8 * g, LQB, 16 * (2 * W + di) + li);
#pragma unroll
                for (int vi = 0; vi < 5; ++vi) { const bf16x8 bv = frag(VW, 16 * vi + li, LVB, 64 * kk + 16 * g);
#pragma unroll
                    for (int di = 0; di < 2; ++di) dacc[di][vi] = MFMA16(ak[di], bv, dacc[di][vi]); } }
#pragma unroll
            for (int di = 0; di < 2; ++di)
#pragma unroll
                for (int vi = 0; vi < 5; ++vi) asm volatile("" :: "v"(dacc[di][vi])); } }
        m_prev = m_last;
        LBAR();
        { const int rr = tid >> 3, sg = tid & 7; if (rr < Tv) *(GAS u32x4*)(HA + (size_t)(r0 + rr) * D + 256 * h + 64 * vs + 8 * sg) = *(const LAS u32x4*)(Hs + rr * LVB + sg * 16); }
    }
#undef ML_PREFETCH
#pragma unroll
    for (int di = 0; di < 2; ++di)
#pragma unroll
        for (int r = 0; r < 4; ++r) { const int d = 16 * (2 * W + di) + 4 * g + r;
#pragma unroll
            for (int vi = 0; vi < 4; ++vi) Cout[(size_t)d * 256 + 64 * vs + 16 * vi + li] = cacc[di][vi][r];
            if (vs == 0 && li == 0) nout[d] = cacc[di][4][r]; }
    if (vs == 0 && tid == 0) *mout = m_prev;
}

DI void hgrn_unit(LAS unsigned char* lds, const bf16* QB, const bf16* KB, const bf16* Z, const float* E1, const float* E2, bf16* HB,
                  int row0, int nchunk, int Tv, int h, int vs, int ci0, const float* S0, float* Sout) {
    int tid_ = threadIdx.x; asm volatile("" : "+v"(tid_));
    const int tid = tid_, lane = tid & 63, W = __builtin_amdgcn_readfirstlane(tid >> 6), g = lane >> 4, li = lane & 15;
    LAS unsigned char* Qs = lds + HS_Q; LAS unsigned char* Ks = lds + HS_K; LAS unsigned char* VT = lds + HS_VT; LAS unsigned char* STs = lds + HS_ST; LAS unsigned char* Ps = lds + HS_P; LAS unsigned char* Hs = lds + HS_H;
    f32x4 sacc[4];
#pragma unroll
    for (int vi = 0; vi < 4; ++vi)
#pragma unroll
        for (int r = 0; r < 4; ++r) sacc[vi][r] = S0 ? S0[(size_t)(16 * W + 4 * g + r) * 128 + 64 * vs + 16 * vi + li] : 0.f;
    u32x4 pq[2], pk[2], pv; f32x4 pe1, pe2;
#define HG_PREFETCH(c) do { const int r0_ = row0 + 64 * (c); \
        _Pragma("unroll") for (int i = 0; i < 2; ++i) { const int idx = tid + 512 * i, rr = idx >> 4, sg = idx & 15; \
            if (rr < Tv) { pq[i] = *(const GAS u32x4*)(QB + (size_t)(r0_ + rr) * D + 128 * h + 8 * sg); pk[i] = *(const GAS u32x4*)(KB + (size_t)(r0_ + rr) * D + 128 * h + 8 * sg); } \
            else { pq[i] = (u32x4){0u, 0u, 0u, 0u}; pk[i] = (u32x4){0u, 0u, 0u, 0u}; } } \
        { const int rr = tid >> 3, sg = tid & 7; pv = rr < Tv ? *(const GAS u32x4*)(Z + (size_t)(r0_ + rr) * NINP + ZIB + 128 * h + 64 * vs + 8 * sg) : (u32x4){0u, 0u, 0u, 0u}; } \
        pe1 = *(const GAS f32x4*)(E1 + (size_t)(ci0 + (c)) * 2048 + 128 * h + 16 * W + 4 * g); pe2 = *(const GAS f32x4*)(E2 + (size_t)(ci0 + (c)) * 2048 + 128 * h + 16 * W + 4 * g); } while (0)
    HG_PREFETCH(0);
    for (int c = 0; c < nchunk; ++c) {
        const int r0 = row0 + 64 * c;
        const f32x4 e2 = pe2;
        f32x4 smid[4];
#pragma unroll
        for (int vi = 0; vi < 4; ++vi) smid[vi] = sacc[vi] * pe1;
#pragma unroll
        for (int i = 0; i < 2; ++i) { const int idx = tid + 512 * i, rr = idx >> 4, sg = idx & 15; *(LAS u32x4*)(Qs + rr * LHB + sg * 16) = pq[i]; *(LAS u32x4*)(Ks + rr * LHB + sg * 16) = pk[i]; }
        { const int rr = tid >> 3, sg = tid & 7; *(LAS u32x4*)(Ps + rr * LVB + sg * 16) = pv; }
#pragma unroll
        for (int vi = 0; vi < 4; ++vi) { u32x2 w; w.x = cvtpk(smid[vi][0], smid[vi][1]); w.y = cvtpk(smid[vi][2], smid[vi][3]); *(LAS u32x2*)(STs + (16 * vi + li) * LHB + (16 * W + 4 * g) * 2) = w; }
        LBAR();
        { const int fp = tid & 31, vq = tid >> 5; const u32x2 pva = *(const LAS u32x2*)(Ps + (2 * fp) * LVB + vq * 8), pvb = *(const LAS u32x2*)(Ps + (2 * fp + 1) * LVB + vq * 8);
          const unsigned a0 = pva.x, a1 = pva.y, b0 = pvb.x, b1 = pvb.y; LAS unsigned char* vt = VT + (4 * vq) * LVB + 4 * fp;
          *(LAS unsigned*)(vt) = (a0 & 0xffffu) | (b0 << 16); *(LAS unsigned*)(vt + LVB) = (a0 >> 16) | (b0 & 0xffff0000u); *(LAS unsigned*)(vt + 2 * LVB) = (a1 & 0xffffu) | (b1 << 16); *(LAS unsigned*)(vt + 3 * LVB) = (a1 >> 16) | (b1 & 0xffff0000u); }
        LBAR();
        if (c + 1 < nchunk) HG_PREFETCH(c + 1);
        {
            const int tt = W & 3, sh = W >> 2;
            f32x4 a[2] = {{0.f, 0.f, 0.f, 0.f}, {0.f, 0.f, 0.f, 0.f}};
#pragma unroll
            for (int kk = 0; kk < 4; ++kk) { const bf16x8 bq = frag(Qs, 16 * tt + li, LHB, 64 * kk + 16 * g);
#pragma unroll
                for (int i = 0; i < 2; ++i) if (2 * sh + i <= tt) a[i] = MFMA16(frag(Ks, 16 * (2 * sh + i) + li, LHB, 64 * kk + 16 * g), bq, a[i]); }
            const int t = 16 * tt + li;
#pragma unroll
            for (int i = 0; i < 2; ++i) { float p[4];
#pragma unroll
                for (int r = 0; r < 4; ++r) { const int s = 16 * (2 * sh + i) + 4 * g + r; p[r] = (s <= t) ? a[i][r] : 0.f; }
                u32x2 w; w.x = cvtpk(p[0], p[1]); w.y = cvtpk(p[2], p[3]); *(LAS u32x2*)(Ps + t * LVB + (16 * (2 * sh + i) + 4 * g) * 2) = w; }
        }
        LBAR();
        {
            const int tt = W & 3, vh = W >> 2;
            f32x4 o[2] = {{0.f, 0.f, 0.f, 0.f}, {0.f, 0.f, 0.f, 0.f}};
#pragma unroll
            for (int kk = 0; kk < 2; ++kk) { const bf16x8 ap = frag(Ps, 16 * tt + li, LVB, 64 * kk + 16 * g);
#pragma unroll
                for (int i = 0; i < 2; ++i) o[i] = MFMA16(ap, frag(VT, 16 * (2 * vh + i) + li, LVB, 64 * kk + 16 * g), o[i]); }
#pragma unroll
            for (int kk = 0; kk < 4; ++kk) { const bf16x8 aq = frag(Qs, 16 * tt + li, LHB, 64 * kk + 16 * g);
#pragma unroll
                for (int i = 0; i < 2; ++i) o[i] = MFMA16(aq, frag(STs, 16 * (2 * vh + i) + li, LHB, 64 * kk + 16 * g), o[i]); }
#pragma unroll
            for (int r = 0; r < 4; ++r) { const int t = 16 * tt + 4 * g + r;
                const unsigned hw = cvtpk(o[0][r], o[1][r]); *(LAS unsigned short*)(Hs + t * LVB + (16 * (2 * vh) + li) * 2) = (unsigned short)(hw & 0xffffu); *(LAS unsigned short*)(Hs + t * LVB + (16 * (2 * vh + 1) + li) * 2) = (unsigned short)(hw >> 16); }
        }
#pragma unroll
        for (int vi = 0; vi < 4; ++vi) sacc[vi] = smid[vi];
#pragma unroll
        for (int kk = 0; kk < 2; ++kk) { const bf16x8 ak = frag_t(Ks, 32 * kk + 8 * g, LHB, 16 * W + li);
#pragma unroll
            for (int vi = 0; vi < 4; ++vi) sacc[vi] = MFMA16(ak, frag(VT, 16 * vi + li, LVB, 64 * kk + 16 * g), sacc[vi]); }
#pragma unroll
        for (int vi = 0; vi < 4; ++vi) sacc[vi] = sacc[vi] * e2;
        LBAR();
        { const int rr = tid >> 3, sg = tid & 7; if (rr < Tv) *(GAS u32x4*)(HB + (size_t)(r0 + rr) * D + 128 * h + 64 * vs + 8 * sg) = *(const LAS u32x4*)(Hs + rr * LVB + sg * 16); }
    }
#undef HG_PREFETCH
#pragma unroll
    for (int vi = 0; vi < 4; ++vi)
#pragma unroll
        for (int r = 0; r < 4; ++r) Sout[(size_t)(16 * W + 4 * g + r) * 128 + 64 * vs + 16 * vi + li] = sacc[vi][r];
}

DI void scan_phase(const Ctx& F, int l) {
    const bf16* Z = (const bf16*)(F.ws + WS_Z);
    const bf16* QA = (const bf16*)(F.ws + WS_QA); const bf16* KA = (const bf16*)(F.ws + WS_KA); const bf16* QB = (const bf16*)(F.ws + WS_QB); const bf16* KB = (const bf16*)(F.ws + WS_KB);
    const float* GP = (const float*)(F.ws + WS_GP); const float* E1 = (const float*)(F.ws + WS_E1); const float* E2 = (const float*)(F.ws + WS_E2);
    bf16* HA = (bf16*)(F.ws + WS_HA); bf16* HB = (bf16*)(F.ws + WS_HB);
    for (int u = F.bid; u < 768; u += F.G) {
        int type, idx, sample;
        if (u < 128) { type = 0; idx = u; sample = 0; } else if (u < 256) { type = 1; idx = u - 128; sample = 0; }
        else if (u < 384) { type = 1; idx = u - 256; sample = 1; } else if (u < 512) { type = 0; idx = u - 384; sample = 1; }
        else if (u < 640) { type = 1; idx = u - 512 + 128; sample = 1; } else { type = 0; idx = u - 640 + 128; sample = 1; }
        if (type == 0) {
            const int b = idx >> 5, h = (idx >> 2) & 7, vs = idx & 3;
            const size_t so = sample ? (size_t)l * NSB + b : (size_t)l * NB + b;
            const float* C0 = sample ? F.in[3] + (so * 8 + h) * 65536 : nullptr; const float* n0 = sample ? F.in[4] + (so * 8 + h) * 256 : nullptr; const float* m0 = sample ? F.in[5] + so * 8 + h : nullptr;
            float* Co = F.out + (sample ? O_CS : O_CP) + (so * 8 + h) * 65536; float* no = F.out + (sample ? O_NS : O_NP) + (so * 8 + h) * 256; float* mo = F.out + (sample ? O_MS : O_MP) + so * 8 + h;
            mlstm_unit(F.lds, QA, KA, Z, GP, HA, sample ? MPR + b * SSEQ : b * SEQ, sample ? 1 : SEQ / 64, sample ? SSEQ : 64, h, vs, C0, n0, m0, Co, no, mo);
        } else {
            const int b = idx >> 5, h = (idx >> 1) & 15, vs = idx & 1;
            const size_t so = sample ? (size_t)l * NSB + b : (size_t)l * NB + b;
            const float* S0 = sample ? F.in[6] + (so * 16 + h) * 16384 : nullptr; float* So = F.out + (sample ? O_SS : O_SP) + (so * 16 + h) * 16384;
            hgrn_unit(F.lds, QB, KB, Z, E1, E2, HB, sample ? MPR + b * SSEQ : b * SEQ, sample ? 1 : SEQ / 64, sample ? SSEQ : 64, h, vs, sample ? NB * 64 + b : b * 64, S0, So);
        }
        __syncthreads();
    }
    if (F.G == 256 && l + 1 < DEPTH && F.bid >= 128) { constexpr int IL = 32 * (NINP / 64) + 3 * 32 * 32 + 32 * 128 + 128 * 32; p0_convert_weights(F, (l + 1) * IL, (l + 1) * IL + CONV_SPLIT, (F.bid - 128) * 8 + F.wave, 128 * 8); }
}

constexpr int NPH_LAYER = 10, NPHASES = 1 + DEPTH * NPH_LAYER + 1;
struct Args { const float* in[26]; float* out; unsigned char* ws; int ph_lo, ph_hi; };
static_assert(sizeof(Args) == 26 * 8 + 8 + 8 + 8, "Args has no padding");

__global__ void __launch_bounds__(512, 2) trunk_fwd(Args args) {
    extern __shared__ __attribute__((aligned(16))) unsigned char lds_raw[];
    Ctx F;
    F.lds = (LAS unsigned char*)lds_raw; F.ws = args.ws; F.in = args.in; F.out = args.out;
    F.tid = threadIdx.x; F.lane = F.tid & 63; F.wave = __builtin_amdgcn_readfirstlane(F.tid >> 6); F.G = gridDim.x; F.bid = blockIdx.x;
    volatile LAS unsigned* MISC = (volatile LAS unsigned*)(F.lds + MISC_OFF);
    if (F.tid < 64) MISC[F.tid] = 0u;
    __syncthreads();
    gu32* ctl = (gu32*)(F.ws + WS_CTL);
#if MK_PER_PHASE
#define GRID_BAR() do { } while (0)
#else
    XcdBarrier bar = xcd_barrier_post((unsigned*)(ctl + CW_BAR), MISC + 8);
#define GRID_BAR() xcd_barrier(bar)
#endif
#define LAUNDER() do { unsigned char* w_ = args.ws; float* o_ = args.out; int b_ = blockIdx.x, g_ = gridDim.x; asm volatile("" : "+s"(w_), "+s"(o_), "+s"(b_), "+s"(g_)); F.ws = w_; F.out = o_; F.bid = b_; F.G = g_; } while (0)
    const int lo = args.ph_lo, hi = args.ph_hi;
#ifndef PH_MASK
#define PH_MASK 0xFFFFu
#endif
#define IN(k) (lo <= (k) && (k) < hi)
#define EN(j) ((PH_MASK >> (j)) & 1u)
#ifndef DUP_MASK
#define DUP_MASK 0x0u
#endif
#define DUP(j) ((int)((DUP_MASK >> (j)) & 1u))
#define BOTH(k) (IN(k) && IN((k) + 1))
    if (EN(10) && IN(0)) { for (int rep_ = 0; rep_ <= DUP(10); ++rep_) { LAUNDER(); p0_prologue(F); if (rep_ < DUP(10) || BOTH(0)) GRID_BAR(); } }
    for (int l = 0; l < DEPTH; ++l) {
        const int pb = 1 + NPH_LAYER * l;
        { int t_ = threadIdx.x; asm volatile("" : "+v"(t_)); F.tid = t_; F.lane = t_ & 63; F.wave = __builtin_amdgcn_readfirstlane(t_ >> 6); }
        { unsigned char* w_ = args.ws; float* o_ = args.out; asm volatile("" : "+s"(w_), "+s"(o_)); F.ws = w_; F.out = o_; }
        unsigned char* wl = F.ws + WS_W + (size_t)l * W_LAYER;
        const float* modl = (const float*)(F.ws + WS_MOD) + (size_t)l * 12 * MODW;
        if (EN(0) && IN(pb + 0)) { for (int rep_ = 0; rep_ <= DUP(0); ++rep_) { LAUNDER(); norm_phase(F, F.in[11] + (size_t)l * D, modl, 0, D, l == 0 ? F.in[0] : (const float*)(F.ws + WS_X)); if (rep_ < DUP(0) || BOTH(pb + 0)) GRID_BAR(); } }
        if (EN(1) && IN(pb + 1)) { for (int rep_ = 0; rep_ <= DUP(1); ++rep_) { LAUNDER();
            pg8::Gemm gm{(const pg8::bf16_t*)(F.ws + WS_H), (const pg8::bf16_t*)(wl + W_WIN), MP, NINP, D}; pg8::SplitOrder S; S.init(MPR, NINP, D, 1, F.G, F.bid); S.npn = NINP / 256 - 1;
            pg8::EpiZ E{(pg8::bf16_t*)(F.ws + WS_Z), (const float*)(F.ws + WS_BIN) + (size_t)l * NINP, (float*)(F.ws + WS_G)};
            pg8::gemm_phase<pg8::EpiZ, pg8::SplitOrder, true, true>(F.lds + RING_OFF, gm, S, E);
            if (rep_ < DUP(1) || BOTH(pb + 1)) GRID_BAR();
        } }
        if (EN(2) && IN(pb + 2)) { for (int rep_ = 0; rep_ <= DUP(2); ++rep_) { LAUNDER(); prep_phase(F, l); if (rep_ < DUP(2) || BOTH(pb + 2)) GRID_BAR(); } }
        if (EN(3) && IN(pb + 3)) { for (int rep_ = 0; rep_ <= DUP(3); ++rep_) { LAUNDER(); scan_phase(F, l); if (rep_ < DUP(3) || BOTH(pb + 3)) GRID_BAR(); } }
        if (EN(4) && IN(pb + 4)) { for (int rep_ = 0; rep_ <= DUP(4); ++rep_) { LAUNDER(); headnorm_phase(F, l); if (rep_ < DUP(4) || BOTH(pb + 4)) GRID_BAR(); } }
        if (EN(5) && IN(pb + 5)) { for (int rep_ = 0; rep_ <= DUP(5); ++rep_) { LAUNDER();
            { pg8::Gemm gm{(const pg8::bf16_t*)(F.ws + WS_KA), (const pg8::bf16_t*)(wl + W_WBB), MP, D, D}; pg8::SplitOrder S; S.init(MPR, D, D, 1, F.G, F.bid);
              pg8::EpiGateTmp E{(const pg8::bf16_t*)(F.ws + WS_Z) + ZGB, (pg8::bf16_t*)(F.ws + WS_HB)};
              pg8::gemm_phase<pg8::EpiGateTmp, pg8::SplitOrder, true, true>(F.lds + RING_OFF, gm, S, E); }
            VM_WAIT(); __syncthreads();
            { pg8::Gemm gm{(const pg8::bf16_t*)(F.ws + WS_QA), (const pg8::bf16_t*)(wl + W_WBA), MP, D, D}; pg8::SplitOrder S; S.init(MPR, D, D, 1, F.G, F.bid);
              pg8::EpiMerge E{(const pg8::bf16_t*)(F.ws + WS_Z) + ZGA, (const pg8::bf16_t*)(F.ws + WS_HB), (pg8::bf16_t*)(F.ws + WS_QB)};
              pg8::gemm_phase<pg8::EpiMerge, pg8::SplitOrder, true, true>(F.lds + RING_OFF, gm, S, E); }
            if (rep_ < DUP(5) || BOTH(pb + 5)) GRID_BAR();
        } }
        if (EN(6) && IN(pb + 6)) { for (int rep_ = 0; rep_ <= DUP(6); ++rep_) { LAUNDER();
            pg8::Gemm gm{(const pg8::bf16_t*)(F.ws + WS_QB), (const pg8::bf16_t*)(wl + W_WO), MP, D, D}; pg8::SplitOrder S; S.init(MPR, D, D, 4, F.G, F.bid);
            pg8::EpiResid E{(float*)(F.ws + (rep_ < DUP(6) ? WS_HB : WS_X)), modl + 2 * D, l == 0 ? F.in[0] : (const float*)(F.ws + WS_X)};
            pg8::gemm_phase<pg8::EpiResid, pg8::SplitOrder, true, true>(F.lds + RING_OFF, gm, S, E);
            if (rep_ < DUP(6) || BOTH(pb + 6)) GRID_BAR();
        } }
        if (EN(7) && IN(pb + 7)) { for (int rep_ = 0; rep_ <= DUP(7); ++rep_) { LAUNDER(); norm_phase(F, F.in[12] + (size_t)l * D, modl, 3 * D, 4 * D, (const float*)(F.ws + WS_X)); if (rep_ < DUP(7) || BOTH(pb + 7)) GRID_BAR(); } }
        if (EN(8) && IN(pb + 8)) { for (int rep_ = 0; rep_ <= DUP(8); ++rep_) { LAUNDER();
            pg8::Gemm gm{(const pg8::bf16_t*)(F.ws + WS_H), (const pg8::bf16_t*)(wl + W_WUP), MP, DFF, D}; pg8::SplitOrder S; S.init(MPR, DFF, D, 1, F.G, F.bid);
            pg8::EpiRelu2 E{(pg8::bf16_t*)(F.ws + WS_Z), DFF};
            pg8::gemm_phase<pg8::EpiRelu2, pg8::SplitOrder, true, true>(F.lds + RING_OFF, gm, S, E);
            if (rep_ < DUP(8) || BOTH(pb + 8)) GRID_BAR();
        } }
        if (EN(9) && IN(pb + 9)) { for (int rep_ = 0; rep_ <= DUP(9); ++rep_) { LAUNDER();
            pg8::Gemm gm{(const pg8::bf16_t*)(F.ws + WS_Z), (const pg8::bf16_t*)(wl + W_WDN), MP, D, DFF}; pg8::SplitOrder S; S.init(MPR, D, DFF, 16, F.G, F.bid, 4);
            pg8::EpiResid E{(float*)(F.ws + (rep_ < DUP(9) ? WS_HB : WS_X)), modl + 5 * D, (const float*)(F.ws + WS_X)};
            pg8::gemm_phase<pg8::EpiResid, pg8::SplitOrder, true, true>(F.lds + RING_OFF, gm, S, E);
            if (rep_ < DUP(9) || BOTH(pb + 9)) GRID_BAR();
        } }
    }
    if (EN(11) && IN(NPHASES - 1)) final_norm_phase(F);
#undef IN
#undef BOTH
}

extern "C" void kernel_launch(void* const* d_in, const int* in_sizes, int n_in, void* d_out, int out_size, void* d_ws, size_t ws_size, hipStream_t stream) {
    static int grid = 0;
    if (grid == 0) {
        if (n_in != 26 || (size_t)out_size != O_END || ws_size < WS_END) { fprintf(stderr, "kernel_launch: shape mismatch: n_in %d out %d (want %zu) ws %zu (want %zu)\n", n_in, out_size, (size_t)O_END, ws_size, (size_t)WS_END); grid = -1; return; }
        int dev = 0, cus = 0, per_cu = 0;
        if (hipGetDevice(&dev) != hipSuccess || hipDeviceGetAttribute(&cus, hipDeviceAttributeMultiprocessorCount, dev) != hipSuccess) { grid = -1; return; }
        if (hipFuncSetAttribute((const void*)trunk_fwd, hipFuncAttributeMaxDynamicSharedMemorySize, LDS_BYTES) != hipSuccess) { fprintf(stderr, "kernel_launch: hipFuncSetAttribute failed\n"); grid = -1; return; }
        if (hipOccupancyMaxActiveBlocksPerMultiprocessor(&per_cu, (const void*)trunk_fwd, 512, LDS_BYTES) != hipSuccess || per_cu < 1) fprintf(stderr, "kernel_launch: occupancy query says %d\n", per_cu);
        (void)hipGetLastError();
        grid = cus;
    }
    if (grid < 0) return;
    (void)in_sizes;
    if (hipMemsetAsync((char*)d_ws + WS_CTL, 0, CTL_ZERO_BYTES, stream) != hipSuccess) { fprintf(stderr, "kernel_launch: memset failed\n"); return; }
    Args a{};
    for (int i = 0; i < 26; ++i) a.in[i] = (const float*)d_in[i];
    a.out = (float*)d_out; a.ws = (unsigned char*)d_ws;
#if MK_PER_PHASE
    for (int p = 0; p < NPHASES; ++p) { a.ph_lo = p; a.ph_hi = p + 1; hipLaunchKernelGGL(trunk_fwd, dim3(grid), dim3(512), LDS_BYTES, stream, a); }
#else
    a.ph_lo = 0; a.ph_hi = NPHASES;
    hipLaunchKernelGGL(trunk_fwd, dim3(grid), dim3(512), LDS_BYTES, stream, a);
#endif
    const hipError_t le = hipPeekAtLastError();
    if (le != hipSuccess) fprintf(stderr, "kernel_launch: launch failed: %s\n", hipGetErrorName(le));
}
```
